# Optimizing an MI355X kernel written in HIP

```python
import math
import jax
import jax.numpy as jnp
from jax import lax
import numpy as np


D_MODEL = 1024
BATCH = 8
SEQ = 4096
DEPTH = 1

GRID_W = 64
CTX_LEN = 256
D_SSD = D_MODEL
SSD_HEADDIM = 64
SSD_HEADS = D_SSD // SSD_HEADDIM
SSD_GROUPS = 4
SSD_HEADS_PER_GROUP = SSD_HEADS // SSD_GROUPS
SSD_STATE = 128
CONV_W = 5
CHUNK = 128
CONV_DIM = D_SSD + 2 * SSD_GROUPS * SSD_STATE
D_FOURIER = D_MODEL // 2
FOURIER_GROUPS = 4
FOURIER_CH = D_FOURIER // FOURIER_GROUPS
D_MIX = D_SSD + D_FOURIER
D_PROJ = D_SSD + CONV_DIM + 2 * SSD_HEADS + D_FOURIER
N_EXPERT_GROUPS = 4
EXPERTS_PER_GROUP = 8
N_EXPERTS = N_EXPERT_GROUPS * EXPERTS_PER_GROUP
TOP_K_INNER = 2
D_EXPERT = D_MODEL // 2
EXPERT_BLOCK = 128
EPS = 1e-6

kernel_name = 'hybrid_ssd_fourier_hmoe_dit_block'


def rmsnorm(u, w):
    uf = u.astype(jnp.float32)
    uf = uf * lax.rsqrt(jnp.mean(uf * uf, axis=-1, keepdims=True) + EPS)
    return uf.astype(u.dtype) * w


def modulate(u, shift, scale):
    return u * (1 + scale) + shift


def depthwise_conv(u, w):
    return lax.conv_general_dilated(u, w[:, None, :], window_strides=(1,), padding='SAME',
                                    dimension_numbers=('NWC', 'WIO', 'NWC'),
                                    feature_group_count=u.shape[-1])


def ssd_scan(xd, da, bm, cm, h0):
    out_dtype = xd.dtype
    b, l = xd.shape[0], xd.shape[1]
    nc = l // CHUNK
    g, r, p, n = SSD_GROUPS, SSD_HEADS_PER_GROUP, SSD_HEADDIM, SSD_STATE
    f32 = jnp.float32
    xd = xd.astype(f32).reshape(b, nc, CHUNK, g, r, p)
    da = da.astype(f32).reshape(b, nc, CHUNK, g, r)
    bm = bm.astype(f32).reshape(b, nc, CHUNK, g, n)
    cm = cm.astype(f32).reshape(b, nc, CHUNK, g, n)
    a_cs = jnp.cumsum(da, axis=2)
    a_lr = jnp.moveaxis(a_cs, 2, -1)
    lower = jnp.tril(jnp.ones((CHUNK, CHUNK), bool))
    seg = jnp.where(lower, a_lr[..., :, None] - a_lr[..., None, :], -jnp.inf)
    cb = jnp.einsum('bclgn,bcsgn->bcgls', cm, bm)
    y_diag = jnp.einsum('bcgrls,bcsgrp->bclgrp', cb[:, :, :, None] * jnp.exp(seg), xd)
    decay_to_end = jnp.exp(a_cs[:, :, -1:] - a_cs)
    chunk_states = jnp.einsum('bcqgn,bcqgrp->bcgrpn', bm, xd * decay_to_end[..., None])
    chunk_decay = jnp.exp(a_cs[:, :, -1])

    def carry_state(h, inp):
        dec, st = inp
        return h * dec[..., None, None] + st, h

    h_final, h_in = lax.scan(carry_state, h0.astype(f32),
                             (jnp.moveaxis(chunk_decay, 1, 0), jnp.moveaxis(chunk_states, 1, 0)))
    h_in = jnp.moveaxis(h_in, 0, 1)
    y_off = jnp.einsum('bcqgn,bcgrpn->bcqgrp', cm, h_in) * jnp.exp(a_cs)[..., None]
    y = (y_diag + y_off).reshape(b, l, SSD_HEADS, p)
    return y.astype(out_dtype), h_final


def ssd_mixer(z, xbc, dt_raw, h0_f, h0_b, conv_w, conv_b, dt_bias, a_log, d_skip, norm_w):
    b, l = xbc.shape[0], xbc.shape[1]
    xbc = jax.nn.silu(depthwise_conv(xbc, conv_w) + conv_b)
    xs, bm, cm = jnp.split(xbc, [D_SSD, D_SSD + SSD_GROUPS * SSD_STATE], axis=-1)
    xs = xs.reshape(b, l, SSD_HEADS, SSD_HEADDIM)
    bm = bm.reshape(b, l, SSD_GROUPS, SSD_STATE)
    cm = cm.reshape(b, l, SSD_GROUPS, SSD_STATE)
    dt = jax.nn.softplus(dt_raw.reshape(b, l, 2, SSD_HEADS) + dt_bias)
    da = dt * -jnp.exp(a_log)
    flip = lambda u: jnp.flip(u, axis=1)
    y_f, h_f = ssd_scan(xs * dt[:, :, 0, :, None], da[:, :, 0], bm, cm, h0_f)
    y_b, h_b = ssd_scan(flip(xs * dt[:, :, 1, :, None]), flip(da[:, :, 1]), flip(bm), flip(cm), h0_b)
    y = y_f + flip(y_b) + d_skip[:, None] * xs
    y = y.reshape(b, l, D_SSD) * jax.nn.silu(z)
    return rmsnorm(y, norm_w), h_f, h_b


def fourier_mixer(f, w_four):
    b, l = f.shape[0], f.shape[1]
    fg = f.reshape(b, l, FOURIER_GROUPS, FOURIER_CH).astype(jnp.float32)
    spec = jnp.fft.fft2(fg, axes=(1, 3), norm='ortho').real.astype(f.dtype)
    return jnp.einsum('blgc,gcd->blgd', spec, w_four).reshape(b, l, D_FOURIER)


def split_proj(proj):
    return jnp.split(proj, [D_SSD, D_SSD + CONV_DIM, D_SSD + CONV_DIM + 2 * SSD_HEADS], axis=-1)


def hier_moe(h, w_rg, b_rg, w_re, b_re, w_eg, w_eu, w_ed):
    bsz, l, d = h.shape
    t = h.reshape(bsz * l, d)
    n_tok = t.shape[0]
    f32 = jnp.float32
    p_grp = jax.nn.softmax((t @ w_rg + b_rg).astype(f32), axis=-1)
    p_top_grp, grp = lax.top_k(p_grp, 1)
    logit_exp = jnp.einsum('td,gde->tge', t, w_re) + b_re
    sel = jnp.broadcast_to(grp[:, :, None], (n_tok, 1, EXPERTS_PER_GROUP))
    logit_sel = jnp.take_along_axis(logit_exp, sel, axis=1)[:, 0]
    p_exp = jax.nn.softmax(logit_sel.astype(f32), axis=-1)
    p_top, j_top = lax.top_k(p_exp, TOP_K_INNER)
    gate = p_top_grp * p_top / jnp.sum(p_top, axis=-1, keepdims=True)
    eid = grp * EXPERTS_PER_GROUP + j_top
    n_assign = n_tok * TOP_K_INNER
    e_flat = eid.reshape(-1)
    g_flat = gate.reshape(-1)
    tok_flat = jnp.repeat(jnp.arange(n_tok, dtype=jnp.int32), TOP_K_INNER)
    order = jnp.argsort(e_flat)
    e_s, tok_s, g_s = e_flat[order], tok_flat[order], g_flat[order]
    counts = jnp.bincount(e_flat, length=N_EXPERTS)
    padded = (counts + EXPERT_BLOCK - 1) // EXPERT_BLOCK * EXPERT_BLOCK
    start = jnp.cumsum(counts) - counts
    end_pad = jnp.cumsum(padded)
    start_pad = end_pad - padded
    dest = start_pad[e_s] + jnp.arange(n_assign, dtype=jnp.int32) - start[e_s]
    n_blocks = -(-(n_assign + N_EXPERTS * (EXPERT_BLOCK - 1)) // EXPERT_BLOCK)
    n_rows = n_blocks * EXPERT_BLOCK
    row_tok = jnp.full((n_rows,), n_tok, jnp.int32).at[dest].set(tok_s)
    row_gate = jnp.zeros((n_rows,), f32).at[dest].set(g_s)
    blk_exp = jnp.minimum(jnp.searchsorted(end_pad, jnp.arange(n_blocks) * EXPERT_BLOCK, side='right'),
                          N_EXPERTS - 1)
    t_pad = jnp.concatenate([t, jnp.zeros((1, d), t.dtype)], axis=0)
    rows = t_pad[row_tok].reshape(n_blocks, EXPERT_BLOCK, d)

    def expert_block(args):
        xb, e = args
        return (jax.nn.silu(xb @ w_eg[e]) * (xb @ w_eu[e])) @ w_ed[e]

    y_rows = lax.map(expert_block, (rows, blk_exp)).reshape(n_rows, d)
    y = jax.ops.segment_sum(y_rows.astype(f32) * row_gate[:, None], row_tok,
                            num_segments=n_tok + 1)[:n_tok]
    return y.astype(h.dtype).reshape(bsz, l, d)


def setup_inputs(seed: int = 0) -> dict:
    key = jax.random.key(seed)
    ks = jax.random.split(key, 26)
    f32 = jnp.float32

    def nrm(k, shape, scale):
        return jax.random.normal(k, shape, f32) * scale

    def gain(k, shape):
        return 1.0 + 0.05 * jax.random.normal(k, shape, f32)

    dt0 = jnp.exp(jax.random.uniform(ks[10], (DEPTH, 2, SSD_HEADS), f32,
                                     math.log(1e-3), math.log(1e-1)))
    dt_bias = dt0 + jnp.log(-jnp.expm1(-dt0))
    a_log = jnp.log(jax.random.uniform(ks[11], (DEPTH, 2, SSD_HEADS), f32, 1.0, 16.0))
    return {
        'x': nrm(ks[0], (BATCH, SEQ, D_MODEL), 1.0),
        'c': nrm(ks[1], (BATCH, D_MODEL), 1.0),
        'ctx': nrm(ks[2], (BATCH, CTX_LEN, D_MODEL), 1.0),
        'c_ctx': nrm(ks[3], (D_MODEL,), 1.0),
        'w_mod': nrm(ks[4], (DEPTH, D_MODEL, 6 * D_MODEL), D_MODEL ** -0.5),
        'b_mod': nrm(ks[5], (DEPTH, 6 * D_MODEL), 0.02),
        'norm1': gain(ks[6], (DEPTH, D_MODEL)),
        'w_in': nrm(ks[7], (DEPTH, D_MODEL, D_PROJ), D_MODEL ** -0.5),
        'conv_w': nrm(ks[8], (DEPTH, CONV_W, CONV_DIM), CONV_W ** -0.5),
        'conv_b': nrm(ks[9], (DEPTH, CONV_DIM), 0.02),
        'dt_bias': dt_bias,
        'a_log': a_log,
        'd_skip': gain(ks[12], (DEPTH, SSD_HEADS)),
        'ssd_norm': gain(ks[13], (DEPTH, D_SSD)),
        'w_four': nrm(ks[14], (DEPTH, FOURIER_GROUPS, FOURIER_CH, FOURIER_CH), FOURIER_CH ** -0.5),
        'w_out': nrm(ks[15], (DEPTH, D_MIX, D_MODEL), D_MIX ** -0.5),
        'norm2': gain(ks[16], (DEPTH, D_MODEL)),
        'w_rg': nrm(ks[17], (DEPTH, D_MODEL, N_EXPERT_GROUPS), D_MODEL ** -0.5),
        'b_rg': nrm(ks[18], (DEPTH, N_EXPERT_GROUPS), 0.01),
        'w_re': nrm(ks[19], (DEPTH, N_EXPERT_GROUPS, D_MODEL, EXPERTS_PER_GROUP), D_MODEL ** -0.5),
        'b_re': nrm(ks[20], (DEPTH, N_EXPERT_GROUPS, EXPERTS_PER_GROUP), 0.01),
        'w_eg': nrm(ks[21], (DEPTH, N_EXPERTS, D_MODEL, D_EXPERT), D_MODEL ** -0.5),
        'w_eu': nrm(ks[22], (DEPTH, N_EXPERTS, D_MODEL, D_EXPERT), D_MODEL ** -0.5),
        'w_ed': nrm(ks[23], (DEPTH, N_EXPERTS, D_EXPERT, D_MODEL), D_EXPERT ** -0.5),
        'final_norm': gain(ks[24], (D_MODEL,)),
    }


def reference(x, c, ctx, c_ctx, w_mod, b_mod, norm1, w_in, conv_w, conv_b, dt_bias, a_log,
              d_skip, ssd_norm, w_four, w_out, norm2, w_rg, b_rg, w_re, b_re, w_eg, w_eu, w_ed,
              final_norm):
    n_lat = x.shape[1]
    rows = n_lat // GRID_W
    assert rows * GRID_W == n_lat
    bsz = x.shape[0]
    h_zero = jnp.zeros((bsz, SSD_GROUPS, SSD_HEADS_PER_GROUP, SSD_HEADDIM, SSD_STATE), jnp.float32)
    for layer in range(DEPTH):
        last = layer == DEPTH - 1
        mod_lat = jax.nn.silu(c) @ w_mod[layer] + b_mod[layer]
        mod_ctx = jax.nn.silu(c_ctx) @ w_mod[layer] + b_mod[layer]
        sh1, sc1, g1, sh2, sc2, g2 = jnp.split(mod_lat[:, None, :], 6, axis=-1)
        sh1c, sc1c, g1c, sh2c, sc2c, g2c = jnp.split(mod_ctx, 6, axis=-1)
        prj_c = modulate(rmsnorm(ctx, norm1[layer]), sh1c, sc1c) @ w_in[layer]
        prj_l = modulate(rmsnorm(x, norm1[layer]), sh1, sc1) @ w_in[layer]
        z_c, xbc_c, dt_c, f_c = split_proj(prj_c)
        z_l, xbc_l, dt_l, f_l = split_proj(prj_l)
        y_c, hf_c, hb_c = ssd_mixer(z_c, xbc_c, dt_c, h_zero, h_zero, conv_w[layer], conv_b[layer],
                                    dt_bias[layer], a_log[layer], d_skip[layer], ssd_norm[layer])
        y_l, _, _ = ssd_mixer(z_l, xbc_l, dt_l, hf_c, hb_c, conv_w[layer], conv_b[layer],
                              dt_bias[layer], a_log[layer], d_skip[layer], ssd_norm[layer])
        mix_l = jnp.concatenate([y_l, fourier_mixer(f_l, w_four[layer])], axis=-1) @ w_out[layer]
        x = x + g1 * mix_l
        if not last:
            mix_c = jnp.concatenate([y_c, fourier_mixer(f_c, w_four[layer])], axis=-1) @ w_out[layer]
            ctx = ctx + g1c * mix_c
            ctx = ctx + g2c * hier_moe(modulate(rmsnorm(ctx, norm2[layer]), sh2c, sc2c), w_rg[layer],
                                       b_rg[layer], w_re[layer], b_re[layer], w_eg[layer],
                                       w_eu[layer], w_ed[layer])
        x = x + g2 * hier_moe(modulate(rmsnorm(x, norm2[layer]), sh2, sc2), w_rg[layer], b_rg[layer],
                              w_re[layer], b_re[layer], w_eg[layer], w_eu[layer], w_ed[layer])
    return rmsnorm(x, final_norm)
```

```cpp
#include <hip/hip_runtime.h>
#include <cstdio>
#include <cstdint>

typedef unsigned short bf16;
#define DEVI __device__ __forceinline__

constexpr int DM = 1024, NB = 8, SEQ = 4096, CTX = 256;
constexpr int TL = NB * SEQ;
constexpr int TC = NB * CTX;
constexpr int TA = TL + TC;
constexpr int NH = 16, HP = 64, NG = 4, NS = 128, CONVD = 2048;
constexpr int DPROJ = 3616;
constexpr int NIN = 4352;
constexpr int C_Z = 0, C_XBC = 1024, C_Y = 3072, C_DT = 4096;
constexpr int FOFF = 3104;
constexpr int DMIX = 1536;
constexpr int NE = 32, DE = 512;
constexpr int RPAD = 65536 + NE * 256;
constexpr float EPS = 1e-6f;

constexpr size_t MiB = 1u << 20;
constexpr size_t WS_CTL = 0;
constexpr size_t WS_WIN = 2 * MiB;
constexpr size_t WS_WOUT = 11 * MiB;
constexpr size_t WS_MOD = 14 * MiB;
constexpr size_t WS_WC = 14 * MiB + 512 * 1024;
constexpr size_t WS_ROUTE = 15 * MiB;
constexpr size_t WS_XN = 17 * MiB;
constexpr size_t WS_YF = 17 * MiB;
constexpr size_t WS_WUP = 17 * MiB;
constexpr size_t WS_ZS = 85 * MiB;
constexpr size_t WS_WDN = 85 * MiB;
constexpr size_t WS_XBC = 149 * MiB;
constexpr size_t WS_MIX = 149 * MiB;
constexpr size_t WS_ACT = 149 * MiB;
constexpr size_t WS_YBUF = 222 * MiB;
constexpr size_t WS_YZ = 285 * MiB;
constexpr size_t WS_H2 = 285 * MiB;
constexpr size_t WS_DTV = 350 * MiB;
constexpr size_t WS_YB = 355 * MiB;
constexpr size_t WS_AP = 419 * MiB;
constexpr size_t WS_HPERM = 355 * MiB;
constexpr size_t WS_END = 512 * MiB;

DEVI float bf2f(bf16 v) { return __uint_as_float(((unsigned)v) << 16); }
DEVI bf16 f2bf(float f) { unsigned u = __float_as_uint(f); return (bf16)((u + 0x7fffu + ((u >> 16) & 1u)) >> 16); }
DEVI float siluf(float v) { return v / (1.f + __expf(-v)); }
DEVI float softplusf(float v) { return v > 20.f ? v : log1pf(__expf(v)); }
DEVI float wave_sum(float v) {
#pragma unroll
    for (int o = 1; o < 64; o <<= 1) v += __shfl_xor(v, o);
    return v;
}

struct Ptrs {
    const float *x, *c, *ctx, *c_ctx, *w_mod, *b_mod, *norm1, *w_in, *conv_w, *conv_b, *dt_bias, *a_log, *d_skip, *ssd_norm, *w_four, *w_out, *norm2,
        *w_rg, *b_rg, *w_re, *b_re, *w_eg, *w_eu, *w_ed, *final_norm;
    float* out; unsigned char* ws;
};

__global__ void k_mod(Ptrs P) {
    const int col = blockIdx.x * 256 + threadIdx.x; const int r = blockIdx.y;
    const float* cv = r < 8 ? P.c + r * DM : P.c_ctx;
    float acc = 0.f;
    for (int k = 0; k < DM; ++k) acc += siluf(cv[k]) * P.w_mod[(size_t)k * 6144 + col];
    ((float*)(P.ws + WS_MOD))[r * 6144 + col] = acc + P.b_mod[col];
}
__global__ void k_wc(Ptrs P) {
    const int g = blockIdx.y, c = blockIdx.x, t = threadIdx.x;
    const int ri = t >> 7, d = t & 127;
    float acc = 0.f;
    for (int m = 0; m < 128; ++m) {
        const float ang = (float)((m * c) & 127) * (2.0f / 128.0f);
        const float tw = ri == 0 ? cospif(ang) : -sinpif(ang);
        acc += tw * P.w_four[((size_t)g * 128 + m) * 128 + d];
    }
    ((float*)(P.ws + WS_WC))[((size_t)g * 128 + c) * 256 + t] = acc * 0.08838834764831845f;
}
__global__ void k_win(Ptrs P) {
    const int n = blockIdx.x, k0 = threadIdx.x;
    bf16* W = (bf16*)(P.ws + WS_WIN);
    const float* Wc = (const float*)(P.ws + WS_WC);
    for (int k = k0; k < DM; k += 256) {
        float v = 0.f;
        if (n < C_Y) v = P.w_in[(size_t)k * DPROJ + n];
        else if (n < C_DT) { const int g = (n - C_Y) >> 8, j = (n - C_Y) & 255;
            for (int c = 0; c < 128; ++c) v += P.w_in[(size_t)k * DPROJ + FOFF + g * 128 + c] * Wc[((size_t)g * 128 + c) * 256 + j]; }
        else if (n < C_DT + 32) v = P.w_in[(size_t)k * DPROJ + 3072 + (n - C_DT)];
        W[(size_t)n * DM + k] = f2bf(v);
    }
}
__global__ void k_wout(Ptrs P) {
    const int n = blockIdx.x; bf16* W = (bf16*)(P.ws + WS_WOUT);
    for (int k = threadIdx.x; k < DMIX; k += 256) W[(size_t)n * DMIX + k] = f2bf(P.w_out[(size_t)k * DM + n]);
}
__global__ void k_wup(Ptrs P) {
    const int e = blockIdx.y, r = blockIdx.x; const int pn = r >> 8, half = (r >> 7) & 1, jj = r & 127;
    const float* src = (half ? P.w_eu : P.w_eg) + (size_t)e * DM * DE + pn * 128 + jj;
    bf16* W = (bf16*)(P.ws + WS_WUP) + ((size_t)e * 1024 + r) * DM;
    for (int k = threadIdx.x; k < DM; k += 256) W[k] = f2bf(src[(size_t)k * DE]);
}
__global__ void k_wdn(Ptrs P) {
    const int e = blockIdx.y, n = blockIdx.x;
    const float* src = P.w_ed + (size_t)e * DE * DM + n;
    bf16* W = (bf16*)(P.ws + WS_WDN) + ((size_t)e * 1024 + n) * DE;
    for (int k = threadIdx.x; k < DE; k += 256) W[k] = f2bf(src[(size_t)k * DM]);
}
__global__ void k_xn(Ptrs P) {
    const int lane = threadIdx.x & 63; const int row = blockIdx.x * 4 + (threadIdx.x >> 6);
    if (row >= TA) return;
    const float* src; int mrow;
    if (row < TL) { src = P.x + (size_t)row * DM; mrow = row / SEQ; } else { src = P.ctx + (size_t)(row - TL) * DM; mrow = 8; }
    const float* mod = (const float*)(P.ws + WS_MOD) + mrow * 6144;
    float4 v[4]; float s = 0.f;
#pragma unroll
    for (int j = 0; j < 4; ++j) { v[j] = ((const float4*)src)[lane + 64 * j]; s += v[j].x * v[j].x + v[j].y * v[j].y + v[j].z * v[j].z + v[j].w * v[j].w; }
    const float rstd = rsqrtf(wave_sum(s) * (1.f / DM) + EPS);
    bf16* dst = (bf16*)(P.ws + WS_XN) + (size_t)row * DM;
#pragma unroll
    for (int j = 0; j < 4; ++j) { const int c0 = (lane + 64 * j) * 4; const float vv[4] = {v[j].x, v[j].y, v[j].z, v[j].w};
        ushort4 o; bf16 ob[4];
#pragma unroll
        for (int i = 0; i < 4; ++i) { const int cidx = c0 + i; const float u = vv[i] * rstd * P.norm1[cidx]; ob[i] = f2bf(u * (1.f + mod[1024 + cidx]) + mod[cidx]); }
        o.x = ob[0]; o.y = ob[1]; o.z = ob[2]; o.w = ob[3]; *(ushort4*)(dst + c0) = o; }
}
template <class Epi, bool DUAL>
__global__ void __launch_bounds__(256) k_ngemm(Epi E, int K) {
    __shared__ float As[32][65]; __shared__ float Bs[32][65]; __shared__ float B2s[DUAL ? 32 : 1][65];
    const int tm = blockIdx.y, tn = blockIdx.x, tid = threadIdx.x;
    const bf16 *Ap, *B0p, *B1p;
    if (!E.setup(tm, tn, Ap, B0p, B1p)) return;
    const int lr = tid >> 2, lk = (tid & 3) * 8;
    const int tx = tid & 15, ty = tid >> 4;
    float acc[4][4] = {}, acc2[4][4] = {};
    for (int k0 = 0; k0 < K; k0 += 32) {
        { const uint4 a = *(const uint4*)(Ap + (size_t)lr * K + k0 + lk); const bf16* ab = (const bf16*)&a;
#pragma unroll
          for (int i = 0; i < 8; ++i) As[lk + i][lr] = bf2f(ab[i]); }
        { const uint4 b = *(const uint4*)(B0p + (size_t)lr * K + k0 + lk); const bf16* bb = (const bf16*)&b;
#pragma unroll
          for (int i = 0; i < 8; ++i) Bs[lk + i][lr] = bf2f(bb[i]); }
        if (DUAL) { const uint4 b = *(const uint4*)(B1p + (size_t)lr * K + k0 + lk); const bf16* bb = (const bf16*)&b;
#pragma unroll
          for (int i = 0; i < 8; ++i) B2s[lk + i][lr] = bf2f(bb[i]); }
        __syncthreads();
#pragma unroll 8
        for (int kk = 0; kk < 32; ++kk) {
            float a[4], b[4], b2[4];
#pragma unroll
            for (int i = 0; i < 4; ++i) { a[i] = As[kk][ty * 4 + i]; b[i] = Bs[kk][tx * 4 + i]; if (DUAL) b2[i] = B2s[kk][tx * 4 + i]; }
#pragma unroll
            for (int i = 0; i < 4; ++i)
#pragma unroll
                for (int j = 0; j < 4; ++j) { acc[i][j] += a[i] * b[j]; if (DUAL) acc2[i][j] += a[i] * b2[j]; }
        }
        __syncthreads();
    }
#pragma unroll
    for (int i = 0; i < 4; ++i)
#pragma unroll
        for (int j = 0; j < 4; ++j) E.store(tm, tn, ty * 4 + i, tx * 4 + j, acc[i][j], acc2[i][j]);
}
struct EpiIn {
    Ptrs P;
    DEVI bool setup(int tm, int tn, const bf16*& A, const bf16*& B0, const bf16*& B1) const {
        const int row0 = tm * 64, col0 = tn * 64;
        if (row0 >= TL && (col0 < C_XBC || (col0 >= C_Y && col0 < C_DT))) return false;
        if (col0 >= C_DT + 64) return false;
        A = (const bf16*)(P.ws + WS_XN) + (size_t)row0 * DM; B0 = (const bf16*)(P.ws + WS_WIN) + (size_t)col0 * DM; B1 = B0; return true; }
    DEVI void store(int tm, int tn, int r, int c, float v, float) const {
        const int row = tm * 64 + r, col = tn * 64 + c;
        if (col < C_XBC) ((bf16*)(P.ws + WS_ZS))[(size_t)row * 1024 + col] = f2bf(siluf(v));
        else if (col < C_Y) ((bf16*)(P.ws + WS_XBC))[(size_t)row * 2048 + col - C_XBC] = f2bf(v);
        else if (col < C_DT) ((bf16*)(P.ws + WS_YZ))[(size_t)row * 1024 + col - C_Y] = f2bf(v);
        else if (col < C_DT + 32) ((float*)(P.ws + WS_DTV))[(size_t)row * 32 + col - C_DT] = softplusf(v + P.dt_bias[col - C_DT]);
    }
};
struct EpiOut {
    Ptrs P;
    DEVI bool setup(int tm, int tn, const bf16*& A, const bf16*& B0, const bf16*& B1) const {
        A = (const bf16*)(P.ws + WS_MIX) + (size_t)tm * 64 * DMIX; B0 = (const bf16*)(P.ws + WS_WOUT) + (size_t)tn * 64 * DMIX; B1 = B0; return true; }
    DEVI void store(int tm, int tn, int r, int c, float v, float) const {
        const int row = tm * 64 + r, col = tn * 64 + c; const float g1 = ((const float*)(P.ws + WS_MOD))[(row / SEQ) * 6144 + 2048 + col];
        P.out[(size_t)row * DM + col] = P.x[(size_t)row * DM + col] + g1 * v; }
};
DEVI void seg_starts(const unsigned* cnt, int e, int& start, int& nrows) {
    int s = 0; for (int i = 0; i < e; ++i) s += (int)((cnt[i] + 255u) & ~255u); start = s; nrows = (int)cnt[e];
}
DEVI int row_expert(const unsigned* cnt, int row) {
    int s = 0; for (int e = 0; e < NE; ++e) { s += (int)((cnt[e] + 255u) & ~255u); if (row < s) return e; } return -1;
}
struct EpiUp {
    Ptrs P;
    DEVI bool setup(int tm, int tn, const bf16*& A, const bf16*& B0, const bf16*& B1) const {
        const int e = row_expert((const unsigned*)(P.ws + WS_CTL), tm * 64); if (e < 0) return false;
        A = (const bf16*)(P.ws + WS_HPERM) + (size_t)tm * 64 * DM;
        const int c0 = tn * 64;
        B0 = (const bf16*)(P.ws + WS_WUP) + ((size_t)e * 1024 + (c0 >> 7) * 256 + (c0 & 127)) * DM; B1 = B0 + (size_t)128 * DM; return true; }
    DEVI void store(int tm, int tn, int r, int c, float g, float u) const {
        ((bf16*)(P.ws + WS_ACT))[(size_t)(tm * 64 + r) * DE + tn * 64 + c] = f2bf(siluf(g) * u); }
};
struct EpiDn {
    Ptrs P;
    DEVI bool setup(int tm, int tn, const bf16*& A, const bf16*& B0, const bf16*& B1) const {
        const int e = row_expert((const unsigned*)(P.ws + WS_CTL), tm * 64); if (e < 0) return false;
        A = (const bf16*)(P.ws + WS_ACT) + (size_t)tm * 64 * DE; B0 = (const bf16*)(P.ws + WS_WDN) + ((size_t)e * 1024 + tn * 64) * DE; B1 = B0; return true; }
    DEVI void store(int tm, int tn, int r, int c, float v, float) const {
        const int row = tm * 64 + r; const int dest = ((const int*)(P.ws + WS_ROUTE + 3 * 262144))[row]; if (dest < 0) return;
        const float gate = ((const float*)(P.ws + WS_ROUTE + 3 * 262144 + 4 * RPAD))[row];
        ((bf16*)(P.ws + WS_YBUF))[(size_t)dest * DM + tn * 64 + c] = f2bf(gate * v); }
};
__global__ void __launch_bounds__(64) k_ssd_naive(Ptrs P) {
    __shared__ float Bs[128], Cs[128];
    const int b = blockIdx.x, h = blockIdx.y, dir = blockIdx.z, p = threadIdx.x, g = h >> 2;
    const bf16* xbc = (const bf16*)(P.ws + WS_XBC); const float* dtv = (const float*)(P.ws + WS_DTV);
    bf16* yout = (bf16*)(P.ws + (dir ? WS_YB : WS_YF));
    const float Aneg = -__expf(P.a_log[dir * 16 + h]); const float Dsk = P.d_skip[h];
    float hs[128];
#pragma unroll
    for (int n = 0; n < 128; ++n) hs[n] = 0.f;
    int ch[5]; ch[0] = h * 64 + p; ch[1] = 1024 + g * 128 + p; ch[2] = 1024 + g * 128 + 64 + p; ch[3] = 1536 + g * 128 + p; ch[4] = 1536 + g * 128 + 64 + p;
    float cw[5][5], cb[5];
#pragma unroll
    for (int i = 0; i < 5; ++i) { cb[i] = P.conv_b[ch[i]];
#pragma unroll
        for (int w = 0; w < 5; ++w) cw[i][w] = P.conv_w[w * CONVD + ch[i]]; }
    for (int seg = 0; seg < 2; ++seg) {
        const int len = seg == 0 ? CTX : SEQ; const size_t rbase = seg == 0 ? (size_t)TL + (size_t)b * CTX : (size_t)b * SEQ;
        for (int st = 0; st < len; ++st) {
            const int t = dir ? len - 1 - st : st;
            float cv[5];
#pragma unroll
            for (int i = 0; i < 5; ++i) { float a = cb[i];
#pragma unroll
                for (int w = 0; w < 5; ++w) { const int tt = t + w - 2; if (tt >= 0 && tt < len) a += bf2f(xbc[(rbase + tt) * 2048 + ch[i]]) * cw[i][w]; }
                cv[i] = siluf(a); }
            __syncthreads();
            Bs[p] = cv[1]; Bs[64 + p] = cv[2]; Cs[p] = cv[3]; Cs[64 + p] = cv[4];
            __syncthreads();
            const float dt = dtv[(rbase + t) * 32 + dir * 16 + h]; const float dec = __expf(dt * Aneg); const float xd = cv[0] * dt;
            float y = 0.f;
#pragma unroll
            for (int n = 0; n < 128; ++n) { hs[n] = hs[n] * dec + Bs[n] * xd; y += Cs[n] * hs[n]; }
            if (seg == 1) { if (dir == 0) y += Dsk * cv[0]; yout[(rbase + t) * 1024 + h * 64 + p] = f2bf(y); }
        }
    }
}
__global__ void __launch_bounds__(256) k_four_naive(Ptrs P) {
    __shared__ float2 tab[4096];
    const int b = blockIdx.z, g = blockIdx.y, k0 = blockIdx.x * 16, tid = threadIdx.x, d = tid & 127, ks = tid >> 7;
    for (int i = tid; i < 4096; i += 256) { const float a = (float)i * (2.0f / 4096.0f); tab[i] = make_float2(cospif(a), sinpif(a)); }
    __syncthreads();
    const bf16* Y = (const bf16*)(P.ws + WS_YZ) + (size_t)b * SEQ * 1024 + g * 256 + d;
    float acc[8] = {}; int kk[8];
#pragma unroll
    for (int i = 0; i < 8; ++i) kk[i] = k0 + ks * 8 + i;
    for (int l = 0; l < SEQ; ++l) {
        const float yr = bf2f(Y[(size_t)l * 1024]), yi = bf2f(Y[(size_t)l * 1024 + 128]);
#pragma unroll
        for (int i = 0; i < 8; ++i) { const float2 cs = tab[(kk[i] * l) & 4095]; acc[i] += cs.x * yr + cs.y * yi; }
    }
    bf16* out = (bf16*)(P.ws + WS_MIX);
#pragma unroll
    for (int i = 0; i < 8; ++i) out[((size_t)b * SEQ + kk[i]) * DMIX + 1024 + g * 128 + d] = f2bf(acc[i] * (1.f / 64.f));
}
__global__ void k_combine(Ptrs P) {
    const int lane = threadIdx.x & 63; const int row = blockIdx.x * 4 + (threadIdx.x >> 6);
    const bf16* yf = (const bf16*)(P.ws + WS_YF) + (size_t)row * 1024; const bf16* yb = (const bf16*)(P.ws + WS_YB) + (size_t)row * 1024; const bf16* zs = (const bf16*)(P.ws + WS_ZS) + (size_t)row * 1024;
    float v[16]; float s = 0.f;
#pragma unroll
    for (int j = 0; j < 2; ++j) { const int c0 = (lane + 64 * j) * 8; const uint4 a = *(const uint4*)(yf + c0), bb = *(const uint4*)(yb + c0), z = *(const uint4*)(zs + c0);
        const bf16 *ap = (const bf16*)&a, *bp = (const bf16*)&bb, *zp = (const bf16*)&z;
#pragma unroll
        for (int i = 0; i < 8; ++i) { const float y = (bf2f(ap[i]) + bf2f(bp[i])) * bf2f(zp[i]); v[j * 8 + i] = y; s += y * y; } }
    const float rstd = rsqrtf(wave_sum(s) * (1.f / 1024.f) + EPS);
    bf16* dst = (bf16*)(P.ws + WS_MIX) + (size_t)row * DMIX;
#pragma unroll
    for (int j = 0; j < 2; ++j) { const int c0 = (lane + 64 * j) * 8; bf16 ob[8];
#pragma unroll
        for (int i = 0; i < 8; ++i) ob[i] = f2bf(v[j * 8 + i] * rstd * P.ssd_norm[c0 + i]);
        *(uint4*)(dst + c0) = *(const uint4*)ob; }
}
__global__ void k_route(Ptrs P) {
    const int lane = threadIdx.x & 63; const int row = blockIdx.x * 4 + (threadIdx.x >> 6);
    const float* src = P.out + (size_t)row * DM; const float* mod = (const float*)(P.ws + WS_MOD) + (row / SEQ) * 6144;
    float4 v[4]; float s = 0.f;
#pragma unroll
    for (int j = 0; j < 4; ++j) { v[j] = ((const float4*)src)[lane + 64 * j]; s += v[j].x * v[j].x + v[j].y * v[j].y + v[j].z * v[j].z + v[j].w * v[j].w; }
    const float rstd = rsqrtf(wave_sum(s) * (1.f / DM) + EPS);
    float t[16];
    bf16* dst = (bf16*)(P.ws + WS_H2) + (size_t)row * DM;
#pragma unroll
    for (int j = 0; j < 4; ++j) { const int c0 = (lane + 64 * j) * 4; const float vv[4] = {v[j].x, v[j].y, v[j].z, v[j].w}; bf16 ob[4];
#pragma unroll
        for (int i = 0; i < 4; ++i) { const int cidx = c0 + i; const float u = vv[i] * rstd * P.norm2[cidx]; const float hv = u * (1.f + mod[4096 + cidx]) + mod[3072 + cidx]; t[j * 4 + i] = hv; ob[i] = f2bf(hv); }
        *(ushort4*)(dst + c0) = *(const ushort4*)ob; }
    float lg[4];
#pragma unroll
    for (int q = 0; q < 4; ++q) { float a = 0.f;
#pragma unroll
        for (int j = 0; j < 4; ++j)
#pragma unroll
            for (int i = 0; i < 4; ++i) a += t[j * 4 + i] * P.w_rg[(size_t)((lane + 64 * j) * 4 + i) * 4 + q];
        lg[q] = wave_sum(a) + P.b_rg[q]; }
    int grp = 0; float mx = lg[0];
#pragma unroll
    for (int q = 1; q < 4; ++q) if (lg[q] > mx) { mx = lg[q]; grp = q; }
    float den = 0.f;
#pragma unroll
    for (int q = 0; q < 4; ++q) den += __expf(lg[q] - mx);
    const float pgrp = 1.f / den;
    float le[8];
#pragma unroll
    for (int q = 0; q < 8; ++q) { float a = 0.f;
#pragma unroll
        for (int j = 0; j < 4; ++j)
#pragma unroll
            for (int i = 0; i < 4; ++i) a += t[j * 4 + i] * P.w_re[((size_t)grp * DM + (lane + 64 * j) * 4 + i) * 8 + q];
        le[q] = wave_sum(a) + P.b_re[grp * 8 + q]; }
    int j0 = 0; float m0 = le[0];
#pragma unroll
    for (int q = 1; q < 8; ++q) if (le[q] > m0) { m0 = le[q]; j0 = q; }
    int j1 = -1; float m1 = -3.0e38f;
#pragma unroll
    for (int q = 0; q < 8; ++q) if (q != j0 && le[q] > m1) { m1 = le[q]; j1 = q; }
    const float e1 = __expf(m1 - m0);
    const float g0 = pgrp / (1.f + e1), g1 = pgrp * e1 / (1.f + e1);
    if (lane == 0) {
        int* eid = (int*)(P.ws + WS_ROUTE); int* pos = eid + 65536; float* gate = (float*)(pos + 65536);
        unsigned* cnt = (unsigned*)(P.ws + WS_CTL);
        const int e0 = grp * 8 + j0, e1i = grp * 8 + j1;
        eid[row * 2] = e0; eid[row * 2 + 1] = e1i; gate[row * 2] = g0; gate[row * 2 + 1] = g1;
        pos[row * 2] = (int)atomicAdd(cnt + e0, 1u); pos[row * 2 + 1] = (int)atomicAdd(cnt + e1i, 1u);
    }
}
__global__ void k_rowinit(Ptrs P) { int* rowdest = (int*)(P.ws + WS_ROUTE + 3 * 262144); const int i = blockIdx.x * 256 + threadIdx.x; if (i < RPAD) rowdest[i] = -1; }
__global__ void k_gather(Ptrs P) {
    const int lane = threadIdx.x & 63; const int a = blockIdx.x * 4 + (threadIdx.x >> 6);
    const int* eid = (const int*)(P.ws + WS_ROUTE); const int* pos = eid + 65536; const float* gate = (const float*)(pos + 65536);
    int* rowdest = (int*)(P.ws + WS_ROUTE + 3 * 262144); float* rowgate = (float*)(rowdest + RPAD);
    int start, n; seg_starts((const unsigned*)(P.ws + WS_CTL), eid[a], start, n);
    const int row = start + pos[a];
    const uint4* src = (const uint4*)((const bf16*)(P.ws + WS_H2) + (size_t)(a >> 1) * DM); uint4* dst = (uint4*)((bf16*)(P.ws + WS_HPERM) + (size_t)row * DM);
    dst[lane] = src[lane]; dst[lane + 64] = src[lane + 64];
    if (lane == 0) { rowdest[row] = a; rowgate[row] = gate[a]; }
}
__global__ void k_final(Ptrs P) {
    const int lane = threadIdx.x & 63; const int row = blockIdx.x * 4 + (threadIdx.x >> 6);
    float* xr = P.out + (size_t)row * DM; const float* mod = (const float*)(P.ws + WS_MOD) + (row / SEQ) * 6144 + 5120;
    const bf16* y0 = (const bf16*)(P.ws + WS_YBUF) + (size_t)row * 2 * DM; const bf16* y1 = y0 + DM;
    float v[16]; float s = 0.f;
#pragma unroll
    for (int j = 0; j < 4; ++j) { const int c0 = (lane + 64 * j) * 4; const float4 xv = *(const float4*)(xr + c0); const ushort4 a = *(const ushort4*)(y0 + c0), b = *(const ushort4*)(y1 + c0);
        const float xx[4] = {xv.x, xv.y, xv.z, xv.w}; const bf16 aa[4] = {a.x, a.y, a.z, a.w}, bb[4] = {b.x, b.y, b.z, b.w};
#pragma unroll
        for (int i = 0; i < 4; ++i) { const float o = xx[i] + mod[c0 + i] * (bf2f(aa[i]) + bf2f(bb[i])); v[j * 4 + i] = o; s += o * o; } }
    const float rstd = rsqrtf(wave_sum(s) * (1.f / DM) + EPS);
#pragma unroll
    for (int j = 0; j < 4; ++j) { const int c0 = (lane + 64 * j) * 4; float4 o;
        o.x = v[j * 4 + 0] * rstd * P.final_norm[c0 + 0]; o.y = v[j * 4 + 1] * rstd * P.final_norm[c0 + 1]; o.z = v[j * 4 + 2] * rstd * P.final_norm[c0 + 2]; o.w = v[j * 4 + 3] * rstd * P.final_norm[c0 + 3];
        *(float4*)(xr + c0) = o; }
}

extern "C" void kernel_launch(void* const* d_in, const int* in_sizes, int n_in, void* d_out, int out_size, void* d_ws, size_t ws_size, hipStream_t stream) {
    if (n_in != 25 || ws_size < WS_END) { fprintf(stderr, "kernel_launch: unexpected n_in %d or ws_size %zu\n", n_in, ws_size); return; }
    Ptrs P{};
    const float** pp = (const float**)&P;
    for (int i = 0; i < 25; ++i) pp[i] = (const float*)d_in[i];
    P.out = (float*)d_out; P.ws = (unsigned char*)d_ws;
    hipMemsetAsync((char*)d_ws + WS_CTL, 0, 4096, stream);
    k_mod<<<dim3(24, 9), 256, 0, stream>>>(P);
    k_wc<<<dim3(128, 4), 256, 0, stream>>>(P);
    k_win<<<NIN, 256, 0, stream>>>(P);
    k_wout<<<1024, 256, 0, stream>>>(P);
    k_xn<<<TA / 4, 256, 0, stream>>>(P);
    k_ngemm<EpiIn, false><<<dim3(NIN / 64, TA / 64), 256, 0, stream>>>(EpiIn{P}, DM);
    k_ssd_naive<<<dim3(8, 16, 2), 64, 0, stream>>>(P);
    k_four_naive<<<dim3(256, 4, 8), 256, 0, stream>>>(P);
    k_combine<<<TL / 4, 256, 0, stream>>>(P);
    k_ngemm<EpiOut, false><<<dim3(DM / 64, TL / 64), 256, 0, stream>>>(EpiOut{P}, DMIX);
    k_wup<<<dim3(1024, 32), 256, 0, stream>>>(P);
    k_wdn<<<dim3(1024, 32), 256, 0, stream>>>(P);
    k_route<<<TL / 4, 256, 0, stream>>>(P);
    k_rowinit<<<RPAD / 256, 256, 0, stream>>>(P);
    k_gather<<<65536 / 4, 256, 0, stream>>>(P);
    k_ngemm<EpiUp, true><<<dim3(DE / 64, RPAD / 64), 256, 0, stream>>>(EpiUp{P}, DM);
    k_ngemm<EpiDn, false><<<dim3(DM / 64, RPAD / 64), 256, 0, stream>>>(EpiDn{P}, DE);
    k_final<<<TL / 4, 256, 0, stream>>>(P);
}
```

```cpp
#include <hip/hip_runtime.h>
#include <cstdio>
#include <cstdint>
namespace pg8 {
#define PG8_LAS __attribute__((address_space(3)))
typedef unsigned short bf16_t;
typedef short bf16x8 __attribute__((ext_vector_type(8)));
typedef float f32x4 __attribute__((ext_vector_type(4)));
typedef unsigned u32x4 __attribute__((ext_vector_type(4)));
constexpr int BM = 256, BK = 64, HALF = 128, HTB = HALF * BK * 2  , STAGE_BYTES = 8 * HTB, NXCD = 8, WGM = 8;

__host__ __device__ __forceinline__ int lds_byte(int r, int c) { const int st = (r >> 4) * 2 + (c >> 5), rr = r & 15, cc = c & 31, ob = rr * 64 + cc * 2; return st * 1024 + (ob ^ (((ob >> 9) & 1) << 5)); }
__host__ __device__ __forceinline__ void stage_rc(int b, int& R, int& C) { const int st = b / 1024, sb = b % 1024, swz = sb ^ (((sb >> 9) & 1) << 5); R = (st >> 1) * 16 + swz / 64; C = (st & 1) * 32 + (swz % 64) / 2; }
__host__ __device__ __forceinline__ int perm32(int rho) { const int n = rho >> 4, i = rho & 15; return 8 * (i >> 2) + 4 * n + (i & 3); }

struct Unit { int pm, pn; };
struct Gemm { const bf16_t* A; const bf16_t* Bt; int M, N, K; };

struct StaticOrder {
    int nM, nN, nwg, G, c;
    __host__ __device__ void init(int M, int N, int G_, int c_) { nM = M / BM; nN = N / BM; nwg = nM * nN; G = G_; c = c_; }
    __host__ __device__ bool next(int i, Unit& u) const {
        const long L = (long)i * G + c; if (L >= nwg) return false;
        int wgid = (int)L; { const int q = nwg / NXCD, r = nwg % NXCD, xcd = wgid % NXCD, off = wgid / NXCD; wgid = (xcd < r ? xcd * (q + 1) : r * (q + 1) + (xcd - r) * q) + off; }
        const int nig = WGM * nN, gid = wgid / nig, fm = gid * WGM, gsz = (nM - fm) < WGM ? (nM - fm) : WGM;
        u.pm = fm + ((wgid % nig) % gsz); u.pn = (wgid % nig) / gsz; return true;
    }
    __device__ __forceinline__ void a_ready(const Unit&) const {}
    __device__ __forceinline__ void done(const Unit&) const {}
};

__device__ __forceinline__ unsigned cvt_pk_bf16(float lo, float hi) { unsigned r; asm volatile("v_cvt_pk_bf16_f32 %0, %1, %2" : "=v"(r) : "v"(lo), "v"(hi)); return r; }
typedef float f32x2 __attribute__((ext_vector_type(2)));
__device__ __forceinline__ float silu_f(float v) { return v * __builtin_amdgcn_rcpf(1.f + __expf(-v)); }
__device__ __forceinline__ float softplus_f(float v) { return v > 20.f ? v : log1pf(__expf(v)); }
struct EpiInProj {
    static constexpr bool PERM = true, AFTER_DRAIN = false;
    bf16_t* zs; bf16_t* xbc; bf16_t* yz; float* dtv; const float* dt_bias;
    __device__ __forceinline__ void operator()(const f32x4 (&acc)[2][2][4][2], const Unit& u, int wr, int wc, int fr, int fq) const {
        const int row0 = u.pm * BM + wr * 64 + fr; const int pn = u.pn;
        if (pn == 16) {
            if (wc == 0) {
                f32x4 bv[2];
#pragma unroll
                for (int n = 0; n < 2; ++n) bv[n] = *(const f32x4*)(dt_bias + 8 * fq + 4 * n);
#pragma unroll
                for (int ai = 0; ai < 2; ++ai)
#pragma unroll
                    for (int m = 0; m < 4; ++m) { float* rp = dtv + (size_t)(row0 + ai * HALF + m * 16) * 32 + 8 * fq;
#pragma unroll
                        for (int n = 0; n < 2; ++n) { const f32x4 v = acc[ai][0][m][n] + bv[n]; f32x4 o; o[0] = softplus_f(v[0]); o[1] = softplus_f(v[1]); o[2] = softplus_f(v[2]); o[3] = softplus_f(v[3]); *(f32x4*)(rp + 4 * n) = o; } }
            }
            return;
        }
        bf16_t* base; int ldc, colt; bool act = false;
        if (pn < 4) { base = zs; ldc = 1024; colt = pn * 256; act = true; } else if (pn < 12) { base = xbc; ldc = 2048; colt = (pn - 4) * 256; } else { base = yz; ldc = 1024; colt = (pn - 12) * 256; }
        const int col0 = colt + wc * 32 + 8 * fq;
#pragma unroll
        for (int ai = 0; ai < 2; ++ai)
#pragma unroll
            for (int m = 0; m < 4; ++m) { bf16_t* rowp = base + (size_t)(row0 + ai * HALF + m * 16) * ldc + col0;
#pragma unroll
                for (int bj = 0; bj < 2; ++bj) { f32x4 v0 = acc[ai][bj][m][0], v1 = acc[ai][bj][m][1];
                    if (act) { v0[0] = silu_f(v0[0]); v0[1] = silu_f(v0[1]); v0[2] = silu_f(v0[2]); v0[3] = silu_f(v0[3]); v1[0] = silu_f(v1[0]); v1[1] = silu_f(v1[1]); v1[2] = silu_f(v1[2]); v1[3] = silu_f(v1[3]); }
                    u32x4 w; w.x = cvt_pk_bf16(v0[0], v0[1]); w.y = cvt_pk_bf16(v0[2], v0[3]); w.z = cvt_pk_bf16(v1[0], v1[1]); w.w = cvt_pk_bf16(v1[2], v1[3]);
                    *(u32x4*)(rowp + bj * HALF) = w; } }
    }
};
struct EpiOutProj {
    static constexpr bool PERM = false, AFTER_DRAIN = false;
    const float* x; float* out; const float* mod;
    __device__ __forceinline__ void operator()(const f32x4 (&acc)[2][2][4][2], const Unit& u, int wr, int wc, int fr, int fq) const {
        const int row0 = u.pm * BM + wr * 64 + fr, col0 = u.pn * BM + wc * 32 + 4 * fq;
        const float* g1 = mod + (size_t)(u.pm >> 4) * 6144 + 2048 + col0;
        f32x4 gv[2][2];
#pragma unroll
        for (int bj = 0; bj < 2; ++bj)
#pragma unroll
            for (int n = 0; n < 2; ++n) gv[bj][n] = *(const f32x4*)(g1 + bj * HALF + n * 16);
#pragma unroll
        for (int ai = 0; ai < 2; ++ai)
#pragma unroll
            for (int m = 0; m < 4; ++m) { const size_t off = (size_t)(row0 + ai * HALF + m * 16) * 1024 + col0;
#pragma unroll
                for (int bj = 0; bj < 2; ++bj)
#pragma unroll
                    for (int n = 0; n < 2; ++n) { const f32x4 xv = *(const f32x4*)(x + off + bj * HALF + n * 16); *(f32x4*)(out + off + bj * HALF + n * 16) = xv + gv[bj][n] * acc[ai][bj][m][n]; } }
    }
};
struct EpiUp {
    static constexpr bool PERM = true, AFTER_DRAIN = false;
    bf16_t* act;
    __device__ __forceinline__ void operator()(const f32x4 (&acc)[2][2][4][2], const Unit& u, int wr, int wc, int fr, int fq) const {
        const int row0 = u.pm * BM + wr * 64 + fr, col0 = (u.pn & 3) * 128 + wc * 32 + 8 * fq;
#pragma unroll
        for (int ai = 0; ai < 2; ++ai)
#pragma unroll
            for (int m = 0; m < 4; ++m) { float a[8];
#pragma unroll
                for (int n = 0; n < 2; ++n)
#pragma unroll
                    for (int i = 0; i < 4; ++i) a[n * 4 + i] = silu_f(acc[ai][0][m][n][i]) * acc[ai][1][m][n][i];
                u32x4 w; w.x = cvt_pk_bf16(a[0], a[1]); w.y = cvt_pk_bf16(a[2], a[3]); w.z = cvt_pk_bf16(a[4], a[5]); w.w = cvt_pk_bf16(a[6], a[7]);
                *(u32x4*)(act + (size_t)(row0 + ai * HALF + m * 16) * 512 + col0) = w; }
    }
};
struct EpiDown {
    static constexpr bool PERM = true, AFTER_DRAIN = false;
    bf16_t* ybuf; const int* rowdest; const float* rowgate;
    __device__ __forceinline__ void operator()(const f32x4 (&acc)[2][2][4][2], const Unit& u, int wr, int wc, int fr, int fq) const {
        const int row0 = u.pm * BM + wr * 64 + fr, col0 = (u.pn & 3) * 256 + wc * 32 + 8 * fq;
#pragma unroll
        for (int ai = 0; ai < 2; ++ai)
#pragma unroll
            for (int m = 0; m < 4; ++m) { const int row = row0 + ai * HALF + m * 16; const int dest = rowdest[row]; const float gt = rowgate[row];
                if (dest >= 0) {
#pragma unroll
                    for (int bj = 0; bj < 2; ++bj) { const f32x4 v0 = acc[ai][bj][m][0] * gt, v1 = acc[ai][bj][m][1] * gt;
                        u32x4 w; w.x = cvt_pk_bf16(v0[0], v0[1]); w.y = cvt_pk_bf16(v0[2], v0[3]); w.z = cvt_pk_bf16(v1[0], v1[1]); w.w = cvt_pk_bf16(v1[2], v1[3]);
                        *(u32x4*)(ybuf + (size_t)dest * 1024 + col0 + bj * HALF) = w; } } }
    }
};
struct InProjOrder {
    int G, c;
    __device__ __forceinline__ bool next(int i, Unit& u) const {
        const int L = i * G + c;
        if (L < 2176) { const int wgid = (L % NXCD) * 272 + L / NXCD; const int r = wgid % 136; u.pm = (wgid / 136) * 8 + (r & 7); u.pn = r >> 3; return true; }
        const int L2 = L - 2176; if (L2 >= 72) return false;
        u.pm = 128 + L2 / 9; const int j = L2 % 9; u.pn = j < 8 ? 4 + j : 16; return true;
    }
    __device__ __forceinline__ void a_ready(const Unit&) const {}
    __device__ __forceinline__ void done(const Unit&) const {}
};
struct MoeOrder {
    const PG8_LAS int* tile_e; int ntiles, G, c;
    __device__ __forceinline__ bool next(int i, Unit& u) const {
        const int L = i * G + c; if (L >= ntiles * 4) return false;
        const int rt = L >> 2; u.pm = rt; u.pn = tile_e[rt] * 4 + (L & 3); return true;
    }
    __device__ __forceinline__ void a_ready(const Unit&) const {}
    __device__ __forceinline__ void done(const Unit&) const {}
};
template <class Epi, class Sched, bool ALIGN_EPI = false, bool SP2 = false>
__device__ __forceinline__ void gemm_phase(PG8_LAS unsigned char* lds, const Gemm g, const Sched& S, const Epi& E) {
    const int tid = threadIdx.x, wid = __builtin_amdgcn_readfirstlane(tid >> 6), lane = tid & 63, wr = wid >> 2, wc = wid & 3, fr = lane & 15, fq = lane >> 4;
    const int K = g.K, nt = K / BK;
    unsigned voffA[2], voffB[2];
#pragma unroll
    for (int i = 0; i < 2; ++i) { int R, C; stage_rc(tid * 16 + i * 8192, R, C); const int Rb = Epi::PERM ? ((R & ~31) + perm32(R & 31)) : R;
        voffA[i] = (unsigned)(R * K + C) * 2u; voffB[i] = (unsigned)(Rb * K + C) * 2u; }
    const size_t kstep = (size_t)(BK * 2);
    const size_t hstep = (size_t)HALF * K * 2;
    const size_t tstep = 2 * hstep;
    const unsigned ldsw = (unsigned)wid * 1024u;
    const int aoff = lds_byte(wr * 64 + fr, fq * 8), boff = lds_byte(wc * 32 + fr, fq * 8);
#define PG8_SA(b, h) (((b) * 2 + (h)) * HTB)
#define PG8_SB(b, h) ((4 + (b) * 2 + (h)) * HTB)
#define PG8_STAGE(bufoff, gbase, voff) do { _Pragma("unroll") for (int _i = 0; _i < 2; ++_i) \
        __builtin_amdgcn_global_load_lds((const unsigned*)((const char*)(gbase) + (voff)[_i]), (PG8_LAS unsigned*)(lds + (bufoff) + ldsw + _i * 8192), 16, 0, 0); } while (0)
#define PG8_LDA(dst, b, h) do { _Pragma("unroll") for (int m = 0; m < 4; ++m) _Pragma("unroll") for (int k = 0; k < 2; ++k) dst[m][k] = *(const PG8_LAS bf16x8*)(lds + PG8_SA(b, h) + aoff + m * 2048 + k * 1024); } while (0)
#define PG8_LDB(dst, b, h) do { _Pragma("unroll") for (int n = 0; n < 2; ++n) _Pragma("unroll") for (int k = 0; k < 2; ++k) dst[n][k] = *(const PG8_LAS bf16x8*)(lds + PG8_SB(b, h) + boff + n * 2048 + k * 1024); } while (0)
#define PG8_MMA(ai, bj, At, Bt) do { __builtin_amdgcn_s_setprio(1); _Pragma("unroll") for (int m = 0; m < 4; ++m) _Pragma("unroll") for (int n = 0; n < 2; ++n) _Pragma("unroll") for (int k = 0; k < 2; ++k) \
        acc[ai][bj][m][n] = __builtin_amdgcn_mfma_f32_16x16x32_bf16(Bt[n][k], At[m][k], acc[ai][bj][m][n], 0, 0, 0); __builtin_amdgcn_s_setprio(0); } while (0)
#define PG8_WAIT_V(n) asm volatile("s_waitcnt vmcnt(" #n ")" ::: "memory")
#define PG8_WAIT_L(n) asm volatile("s_waitcnt lgkmcnt(" #n ")" ::: "memory")
#define PG8_BAR __builtin_amdgcn_s_barrier()
#define PG8_SCHED __builtin_amdgcn_sched_barrier(0)
    Unit cur, nxt; int ui = 0;
    if (!S.next(0, cur)) return;
    f32x4 acc[2][2][4][2];
#pragma unroll
    for (int a = 0; a < 2; ++a)
#pragma unroll
        for (int b = 0; b < 2; ++b)
#pragma unroll
            for (int m = 0; m < 4; ++m)
#pragma unroll
                for (int n = 0; n < 2; ++n) acc[a][b][m][n] = (f32x4){0.f, 0.f, 0.f, 0.f};
    bf16x8 At[4][2], B0[2][2], B1[2][2];
    const char* cA = (const char*)g.A + (size_t)cur.pm * tstep; const char* cB = (const char*)g.Bt + (size_t)cur.pn * tstep;
    S.a_ready(cur);
    if constexpr (SP2) {
        PG8_STAGE(PG8_SB(0, 0), cB, voffB); PG8_STAGE(PG8_SB(0, 1), cB + hstep, voffB); PG8_STAGE(PG8_SA(0, 0), cA, voffA); PG8_STAGE(PG8_SA(0, 1), cA + hstep, voffA);
        if (wr == 1) PG8_BAR;
        PG8_WAIT_V(2); PG8_BAR;
        PG8_STAGE(PG8_SB(1, 0), cB + kstep, voffB); PG8_STAGE(PG8_SA(1, 0), cA + kstep, voffA); PG8_STAGE(PG8_SB(1, 1), cB + hstep + kstep, voffB);
        PG8_WAIT_V(6); PG8_BAR;
    } else {
        PG8_STAGE(PG8_SB(0, 0), cB, voffB); PG8_STAGE(PG8_SA(0, 0), cA, voffA); PG8_STAGE(PG8_SB(0, 1), cB + hstep, voffB); PG8_STAGE(PG8_SA(0, 1), cA + hstep, voffA);
        if (wr == 1) PG8_BAR;
        PG8_WAIT_V(4); PG8_BAR;
        PG8_STAGE(PG8_SB(1, 0), cB + kstep, voffB); PG8_STAGE(PG8_SA(1, 0), cA + kstep, voffA); PG8_STAGE(PG8_SB(1, 1), cB + hstep + kstep, voffB);
        PG8_WAIT_V(6); PG8_BAR;
    }
    for (;;) {
        const bool has_next = S.next(ui + 1, nxt);
        const char* nA = has_next ? (const char*)g.A + (size_t)nxt.pm * tstep : cA; const char* nB = has_next ? (const char*)g.Bt + (size_t)nxt.pn * tstep : cB;
        for (int t = 0; t < nt; t += 2) {
            const bool last = (t == nt - 2);
            const char* a1 = cA + (size_t)(t + 1) * kstep;
            const char* a2 = last ? nA : cA + (size_t)(t + 2) * kstep; const char* b2 = last ? nB : cB + (size_t)(t + 2) * kstep;
            const char* a3 = a2 + kstep; const char* b3 = b2 + kstep;
            if (last && has_next) S.a_ready(nxt);
            if constexpr (SP2) {
            PG8_LDB(B0, 0, 0); PG8_LDB(B1, 0, 1); PG8_SCHED; PG8_LDA(At, 0, 0); PG8_STAGE(PG8_SA(1, 1), a1 + hstep, voffA);
            PG8_WAIT_V(8); PG8_WAIT_L(0); PG8_BAR; PG8_MMA(0, 0, At, B0); PG8_MMA(0, 1, At, B1); PG8_BAR; PG8_SCHED;
            PG8_LDA(At, 0, 1); PG8_STAGE(PG8_SB(0, 0), b2, voffB); PG8_STAGE(PG8_SB(0, 1), b2 + hstep, voffB); PG8_STAGE(PG8_SA(0, 0), a2, voffA);
            PG8_WAIT_V(8); PG8_WAIT_L(0); PG8_BAR; PG8_MMA(1, 0, At, B0); PG8_MMA(1, 1, At, B1); PG8_BAR; PG8_SCHED;
            PG8_LDB(B0, 1, 0); PG8_LDB(B1, 1, 1); PG8_SCHED; PG8_LDA(At, 1, 0); PG8_STAGE(PG8_SA(0, 1), a2 + hstep, voffA);
            PG8_WAIT_V(8); PG8_WAIT_L(0); PG8_BAR; PG8_MMA(0, 0, At, B0); PG8_MMA(0, 1, At, B1); PG8_BAR; PG8_SCHED;
            PG8_LDA(At, 1, 1); PG8_STAGE(PG8_SB(1, 0), b3, voffB); PG8_STAGE(PG8_SB(1, 1), b3 + hstep, voffB); PG8_STAGE(PG8_SA(1, 0), a3, voffA);
            PG8_WAIT_V(8); PG8_WAIT_L(0); PG8_BAR; PG8_MMA(1, 0, At, B0); PG8_MMA(1, 1, At, B1); PG8_BAR; PG8_SCHED;
            } else {
            PG8_LDB(B0, 0, 0); PG8_SCHED; PG8_LDA(At, 0, 0); PG8_STAGE(PG8_SA(1, 1), a1 + hstep, voffA);
            PG8_WAIT_L(8); PG8_BAR; PG8_WAIT_L(0); PG8_MMA(0, 0, At, B0); PG8_BAR; PG8_SCHED;
            PG8_LDB(B1, 0, 1); PG8_STAGE(PG8_SB(0, 0), b2, voffB);
            PG8_BAR; PG8_WAIT_L(0); PG8_MMA(0, 1, At, B1); PG8_BAR;
            PG8_LDA(At, 0, 1); PG8_STAGE(PG8_SA(0, 0), a2, voffA);
            PG8_BAR; PG8_WAIT_L(0); PG8_MMA(1, 0, At, B0); PG8_BAR; PG8_SCHED;
            PG8_STAGE(PG8_SB(0, 1), b2 + hstep, voffB);
            PG8_WAIT_V(6); PG8_BAR; PG8_MMA(1, 1, At, B1); PG8_BAR;
            PG8_LDB(B0, 1, 0); PG8_SCHED; PG8_LDA(At, 1, 0); PG8_STAGE(PG8_SA(0, 1), a2 + hstep, voffA);
            PG8_WAIT_L(8); PG8_BAR; PG8_WAIT_L(0); PG8_MMA(0, 0, At, B0); PG8_BAR; PG8_SCHED;
            PG8_LDB(B1, 1, 1); PG8_STAGE(PG8_SB(1, 0), b3, voffB);
            PG8_BAR; PG8_WAIT_L(0); PG8_MMA(0, 1, At, B1); PG8_BAR;
            PG8_LDA(At, 1, 1); PG8_STAGE(PG8_SA(1, 0), a3, voffA);
            PG8_BAR; PG8_WAIT_L(0); PG8_MMA(1, 0, At, B0); PG8_BAR; PG8_SCHED;
            PG8_STAGE(PG8_SB(1, 1), b3 + hstep, voffB);
            PG8_WAIT_V(6); PG8_BAR; PG8_MMA(1, 1, At, B1); PG8_BAR;
            }
        }
        if constexpr (ALIGN_EPI) { if (wr == 0) PG8_BAR; }
        if constexpr (!Epi::AFTER_DRAIN) { E(acc, cur, wr, wc, fr, fq); S.done(cur); }
        if (!has_next) break;
#pragma unroll
        for (int a = 0; a < 2; ++a)
#pragma unroll
            for (int b = 0; b < 2; ++b)
#pragma unroll
                for (int m = 0; m < 4; ++m)
#pragma unroll
                    for (int n = 0; n < 2; ++n) acc[a][b][m][n] = (f32x4){0.f, 0.f, 0.f, 0.f};
        cur = nxt; cA = nA; cB = nB; ++ui;
        if constexpr (ALIGN_EPI) { if (wr == 1) PG8_BAR; }
    }
    PG8_WAIT_V(0);
    if constexpr (!ALIGN_EPI) { if (wr == 0) PG8_BAR; }
    PG8_BAR;
    if constexpr (Epi::AFTER_DRAIN) { E.fused(acc, cur, wr, wc, fr, fq, lds, wid, lane); S.done(cur); }
#undef PG8_SA
#undef PG8_SB
#undef PG8_STAGE
#undef PG8_LDA
#undef PG8_LDB
#undef PG8_MMA
#undef PG8_WAIT_V
#undef PG8_WAIT_L
#undef PG8_BAR
#undef PG8_SCHED
}
}
typedef unsigned short bf16;
#define DEVI __device__ __forceinline__
#define LAS __attribute__((address_space(3)))
#define GAS __attribute__((address_space(1)))
typedef unsigned v4u __attribute__((ext_vector_type(4)));
typedef float f32x4 __attribute__((ext_vector_type(4)));
#define RLX_AGENT __ATOMIC_RELAXED, __HIP_MEMORY_SCOPE_AGENT
#define LDS_WAIT() asm volatile("s_waitcnt lgkmcnt(0)" ::: "memory")
#define VM_WAIT() asm volatile("s_waitcnt vmcnt(0)" ::: "memory")

constexpr int NWAVES = 8;
constexpr int DM = 1024, NB = 8, SEQ = 4096, CTX = 256;
constexpr int TL = NB * SEQ, TC = NB * CTX, TA = TL + TC;
constexpr int CONVD = 2048, DPROJ = 3616, NIN = 4352, C_XBC = 1024, C_Y = 3072, C_DT = 4096, FOFF = 3104, DMIX = 1536, NE = 32, DE = 512;
constexpr int RPAD = 65536 + NE * 256;
constexpr float EPS = 1e-6f;
constexpr size_t MiB = 1u << 20;
constexpr size_t WS_CTL = 0, CTL_ZERO_BYTES = 64 * 1024;
constexpr size_t WS_WIN = 2 * MiB, WS_WOUT = 11 * MiB, WS_MODP = 14 * MiB, WS_WC = 15 * MiB, WS_ROUTE = 15 * MiB + 512 * 1024, WS_MOD = 1 * MiB;
constexpr size_t WS_XN = 17 * MiB, WS_YF = 17 * MiB, WS_WUP = 17 * MiB, WS_ZS = 85 * MiB, WS_WDN = 85 * MiB, WS_XBC = 149 * MiB, WS_MIX = 149 * MiB, WS_ACT = 149 * MiB;
constexpr size_t WS_YBUF = 222 * MiB, WS_YZ = 285 * MiB, WS_H2 = 285 * MiB, WS_DTV = 350 * MiB, WS_YB = 355 * MiB, WS_AP = 419 * MiB, WS_HPERM = 355 * MiB, WS_END = 512 * MiB;
constexpr int CW_CNT = 0, CW_BAR = 4096;
constexpr int RING_BYTES = 131072, LDSCTL_OFF = RING_BYTES, LDS_BYTES = 147456;
constexpr int LC_MISC = 0  , LC_TILE = 256  , LC_CNT = 2048  , LC_RT = 4096  ;

DEVI float bf2f(bf16 v) { return __uint_as_float(((unsigned)v) << 16); }
DEVI unsigned f2bf(float f) { unsigned u = __float_as_uint(f); return (u + 0x7fffu + ((u >> 16) & 1u)) >> 16; }
DEVI unsigned pk2(float lo, float hi) { return f2bf(lo) | (f2bf(hi) << 16); }
DEVI float siluf(float v) { return v / (1.f + __expf(-v)); }
DEVI float wave_sum(float v) {
#pragma unroll
    for (int o = 1; o < 64; o <<= 1) v += __shfl_xor(v, o);
    return v;
}
struct Ptrs {
    const float *x, *c, *ctx, *c_ctx, *w_mod, *b_mod, *norm1, *w_in, *conv_w, *conv_b, *dt_bias, *a_log, *d_skip, *ssd_norm, *w_four, *w_out, *norm2,
        *w_rg, *b_rg, *w_re, *b_re, *w_eg, *w_eu, *w_ed, *final_norm;
    float* out; unsigned char* ws;
};
struct Frame { LAS unsigned char* lds; int tid, lane, wave, vcu, G; };
#define XB_TMO      128
#define XB_XCNT(j)  (256  + 64 * (j))
#define XB_XSUB(j)  (1280 + 64 * (j))
#define XB_XGEN(j)  (2304 + 64 * (j))
#define XB_TOP      3328
#define XB_TOPGEN   3392
#define XCD_BAR_WORDS 3456
#define XB_SPIN_CAP (1u << 18)

__device__ __forceinline__ unsigned xb_ld(unsigned* p)              { return __hip_atomic_load(p, __ATOMIC_RELAXED, __HIP_MEMORY_SCOPE_AGENT); }
__device__ __forceinline__ unsigned xb_add(unsigned* p, unsigned v) { return __hip_atomic_fetch_add(p, v, __ATOMIC_RELAXED, __HIP_MEMORY_SCOPE_AGENT); }
__device__ __forceinline__ unsigned xb_xcc_id() { return (unsigned)__builtin_amdgcn_s_getreg((3 << 11) | 20) & 0xFu; }
#define XB_SPIN(cond, bar) do { unsigned _sp = 0; while (cond) { __builtin_amdgcn_s_sleep(1); \
    if ((++_sp & 255u) == 0u) { if (xb_ld(&(bar)[XB_TMO])) break; if (_sp > XB_SPIN_CAP) { atomicAdd(&(bar)[XB_TMO], 1u); break; } } } } while (0)

struct XcdBarrier {
    unsigned* bar; unsigned x;
    volatile LAS unsigned* st;
};

__device__ __forceinline__ XcdBarrier xcd_barrier_post(unsigned* bar, volatile LAS unsigned* st) {
    XcdBarrier b; b.bar = bar; b.x = xb_xcc_id(); b.st = st;
    if (threadIdx.x == 0) (void)xb_add(&bar[XB_XCNT(b.x)], 1u);
    return b;
}
__device__ __forceinline__ void xcd_barrier_complete(unsigned* bar, unsigned x, unsigned& nloc, unsigned& nx) {
    const unsigned G = gridDim.x * gridDim.y * gridDim.z;
    unsigned sum, cnt, mine, sp = 0u;
    for (;;) {
        sum = 0u; cnt = 0u; mine = 0u;
#pragma unroll
        for (unsigned j = 0; j < 16; ++j) { const unsigned c = xb_ld(&bar[XB_XCNT(j)]); sum += c; cnt += (c > 0u) ? 1u : 0u; mine = (j == x) ? c : mine; }
        if (sum == G) break;
        __builtin_amdgcn_s_sleep(1);
        if ((++sp & 255u) == 0u) { if (xb_ld(&bar[XB_TMO])) break; if (sp > XB_SPIN_CAP) { atomicAdd(&bar[XB_TMO], 1u); break; } }
    }
    nloc = mine > 0u ? mine : 1u; nx = cnt > 0u ? cnt : 1u;
}

__device__ __forceinline__ void xcd_barrier(const XcdBarrier& b) {
    asm volatile("s_waitcnt vmcnt(0)" ::: "memory");
    __syncthreads();
    if (threadIdx.x == 0) {
        unsigned* bar = b.bar;
        __builtin_amdgcn_s_waitcnt(0);
        unsigned nloc = b.st[0], nx = b.st[1];
        if (nloc == 0u) { xcd_barrier_complete(bar, b.x, nloc, nx); b.st[0] = nloc; b.st[1] = nx; }
        const unsigned old = xb_add(&bar[XB_XSUB(b.x)], 1u);
        const unsigned gen = old / nloc;
        if (old + 1u == (gen + 1u) * nloc) {
            __builtin_amdgcn_fence(__ATOMIC_RELEASE, "agent");
            asm volatile("s_waitcnt vmcnt(0)" ::: "memory");
            const unsigned og = xb_add(&bar[XB_TOP], 1u);
            const unsigned tg = og / nx;
            if (og + 1u == (tg + 1u) * nx) xb_add(&bar[XB_TOPGEN], 1u);
            else XB_SPIN(xb_ld(&bar[XB_TOPGEN]) == tg, bar);
            __builtin_amdgcn_fence(__ATOMIC_ACQUIRE, "agent");
            xb_add(&bar[XB_XGEN(b.x)], 1u);
            asm volatile("s_waitcnt vmcnt(0)" ::: "memory");
        } else {
            XB_SPIN(xb_ld(&bar[XB_XGEN(b.x)]) == gen, bar);
            __builtin_amdgcn_fence(__ATOMIC_ACQUIRE, "agent");
            asm volatile("s_waitcnt vmcnt(0)" ::: "memory");
        }
    }
    __syncthreads();
}
DEVI void transpose_item(const float* W, int N, bf16* WT, int Kt, int row_off, int k0, int n0, LAS float* scr, int lane) {
#pragma unroll 8
    for (int i = 0; i < 32; ++i) { const int kk = 2 * i + (lane >> 5); scr[kk * 33 + (lane & 31)] = W[(size_t)(k0 + kk) * N + n0 + (lane & 31)]; }
    LDS_WAIT(); asm volatile("" ::: "memory");
    const int c = lane & 7;
#pragma unroll
    for (int j = 0; j < 4; ++j) { const int n = (lane >> 3) + 8 * j; const LAS float* s = scr + (8 * c) * 33 + n;
        v4u o; o.x = pk2(s[0 * 33], s[1 * 33]); o.y = pk2(s[2 * 33], s[3 * 33]); o.z = pk2(s[4 * 33], s[5 * 33]); o.w = pk2(s[6 * 33], s[7 * 33]);
        *(v4u*)(WT + (size_t)(row_off + n0 + n) * Kt + k0 + 8 * c) = o; }
    LDS_WAIT(); asm volatile("" ::: "memory");
}
DEVI void phase0a(const Ptrs& P, const Frame& F) {
    const int gt = F.vcu * 512 + F.tid, NT = F.G * 512;
    { int* rowdest = (int*)(P.ws + WS_ROUTE + 3 * 262144); for (int i = gt; i < RPAD; i += NT) rowdest[i] = -1; }
    for (int o = gt; o < 4 * 128 * 256; o += NT) { const int g = o >> 15, c = (o >> 8) & 127, t = o & 255, ri = t >> 7, d = t & 127; float acc = 0.f;
        for (int m = 0; m < 128; ++m) { const float ang = (float)((m * c) & 127) * (2.0f / 128.0f); const float tw = ri == 0 ? cospif(ang) : -sinpif(ang); acc += tw * P.w_four[((size_t)g * 128 + m) * 128 + d]; }
        ((float*)(P.ws + WS_WC))[o] = acc * 0.08838834764831845f; }
    { LAS float* svec = (LAS float*)F.lds; LAS float* red = svec + 9 * 256;
      float* modp = (float*)(P.ws + WS_MODP);
      for (int u = F.vcu; u < 384; u += F.G) { const int cc = u % 96, kc = u / 96;
        __syncthreads();
        for (int i = F.tid; i < 9 * 256; i += 512) { const int r = i >> 8, k = kc * 256 + (i & 255); svec[i] = siluf(r < 8 ? P.c[r * DM + k] : P.c_ctx[k]); }
        __syncthreads();
        const int col = cc * 64 + F.lane; float acc[9];
#pragma unroll
        for (int r = 0; r < 9; ++r) acc[r] = 0.f;
#pragma unroll 8
        for (int i = 0; i < 32; ++i) { const int kl = F.wave * 32 + i; const float w = P.w_mod[(size_t)(kc * 256 + kl) * 6144 + col];
#pragma unroll
            for (int r = 0; r < 9; ++r) acc[r] += svec[r * 256 + kl] * w; }
#pragma unroll
        for (int r = 0; r < 9; ++r) red[(F.wave * 9 + r) * 64 + F.lane] = acc[r];
        __syncthreads();
        for (int i = F.tid; i < 576; i += 512) { float s = 0.f;
#pragma unroll
            for (int w = 0; w < 8; ++w) s += red[w * 576 + i];
            modp[((size_t)kc * 9 + (i >> 6)) * 6144 + cc * 64 + (i & 63)] = s; }
      }
      __syncthreads(); }
    { LAS float* scr = (LAS float*)(F.lds + F.wave * 16384); const int gw = F.vcu * NWAVES + F.wave, NGW = F.G * NWAVES;
      bf16* Win = (bf16*)(P.ws + WS_WIN); bf16* Wout = (bf16*)(P.ws + WS_WOUT);
      constexpr int I_IN = 16 * 97, I_OUT = 24 * 32;
      for (int it = gw; it < I_IN + I_OUT; it += NGW) {
          if (it < I_IN) { const int kb = it / 97, nb = it % 97; transpose_item(P.w_in, DPROJ, Win, DM, nb == 96 ? 1024 : 0, kb * 64, nb * 32, scr, F.lane); }
          else { const int r = it - I_IN, kb = r / 32, nb = r % 32; transpose_item(P.w_out, DM, Wout, DMIX, 0, kb * 64, nb * 32, scr, F.lane); } }
      for (int i = gt; i < (NIN - C_DT - 32) * DM / 8; i += NT) ((v4u*)(Win + (size_t)(C_DT + 32) * DM))[i] = (v4u){0u, 0u, 0u, 0u}; }
}
DEVI float modp_sum(const Ptrs& P, int r, int idx) { const float* mp = (const float*)(P.ws + WS_MODP) + (size_t)r * 6144 + idx; return P.b_mod[idx] + ((mp[0] + mp[9 * 6144]) + (mp[2 * 9 * 6144] + mp[3 * 9 * 6144])); }
DEVI void xn_row(const float* src, bf16* dst, const float* norm1, const LAS float* mrow, int lane) {
    f32x4 v[4]; float s = 0.f;
#pragma unroll
    for (int j = 0; j < 4; ++j) { v[j] = ((const f32x4*)src)[lane + 64 * j]; s += (v[j][0] * v[j][0] + v[j][1] * v[j][1]) + (v[j][2] * v[j][2] + v[j][3] * v[j][3]); }
    const float rstd = rsqrtf(wave_sum(s) * (1.f / DM) + EPS);
#pragma unroll
    for (int j = 0; j < 4; ++j) { const int c0 = (lane + 64 * j) * 4; const f32x4 nw = *(const f32x4*)(norm1 + c0); float o[4];
#pragma unroll
        for (int i = 0; i < 4; ++i) o[i] = v[j][i] * rstd * nw[i] * (1.f + mrow[1024 + c0 + i]) + mrow[c0 + i];
        uint2 w; w.x = pk2(o[0], o[1]); w.y = pk2(o[2], o[3]); *(uint2*)(dst + c0) = w; }
}
DEVI void phase0b(const Ptrs& P, const Frame& F) {
    const int gt = F.vcu * 512 + F.tid, NT = F.G * 512;
    { float* mod = (float*)(P.ws + WS_MOD); for (int i = gt; i < 9 * 6144; i += NT) mod[i] = modp_sum(P, i / 6144, i % 6144); }
    LAS float* mrow = (LAS float*)F.lds;
    for (int rb = F.vcu; rb < 256; rb += F.G) {
        __syncthreads();
        for (int i = F.tid; i < 2048; i += 512) mrow[i] = modp_sum(P, rb >> 5, i);
        __syncthreads();
        for (int r = F.wave; r < 128; r += NWAVES) { const int row = rb * 128 + r; xn_row(P.x + (size_t)row * DM, (bf16*)(P.ws + WS_XN) + (size_t)row * DM, P.norm1, mrow, F.lane); }
        __syncthreads();
        for (int i = F.tid; i < 2048; i += 512) mrow[i] = modp_sum(P, 8, i);
        __syncthreads();
        { const int row = rb * 8 + F.wave; xn_row(P.ctx + (size_t)row * DM, (bf16*)(P.ws + WS_XN) + (size_t)(TL + row) * DM, P.norm1, mrow, F.lane); }
    }
    { LAS float* wi = (LAS float*)F.lds; LAS float* wc = wi + 64 * 128; const float* Wc = (const float*)(P.ws + WS_WC); bf16* Win = (bf16*)(P.ws + WS_WIN);
      for (int u = F.vcu; u < 256; u += F.G) { const int g = u >> 6, kb = (u >> 2) & 15, jb = u & 3;
        __syncthreads();
        for (int i = F.tid; i < 64 * 128; i += 512) { const int kk = i >> 7, c = i & 127; wi[i] = P.w_in[(size_t)(kb * 64 + kk) * DPROJ + FOFF + g * 128 + c]; }
        for (int i = F.tid; i < 128 * 64; i += 512) { const int c = i >> 6, j = i & 63; wc[i] = Wc[((size_t)g * 128 + c) * 256 + jb * 64 + j]; }
        __syncthreads();
        float acc[8];
#pragma unroll
        for (int i = 0; i < 8; ++i) acc[i] = 0.f;
        for (int c = 0; c < 128; ++c) { const float wv = wc[c * 64 + F.lane];
#pragma unroll
            for (int i = 0; i < 8; ++i) acc[i] += wi[(F.wave * 8 + i) * 128 + c] * wv; }
        v4u o; o.x = pk2(acc[0], acc[1]); o.y = pk2(acc[2], acc[3]); o.z = pk2(acc[4], acc[5]); o.w = pk2(acc[6], acc[7]);
        *(v4u*)(Win + (size_t)(C_Y + g * 256 + jb * 64 + F.lane) * DM + kb * 64 + F.wave * 8) = o; }
      __syncthreads(); }
}
DEVI void phase_ssd_naive(const Ptrs& P, const Frame& F) {
    LAS float* Bs = (LAS float*)F.lds; LAS float* Cs = Bs + 128;
    for (int id = F.vcu; id < 256; id += F.G) {
    const int dir = id & 1, h = (id >> 1) & 15, b = id >> 5, p = F.tid & 63, g = h >> 2; const bool act = F.tid < 64;
    const bf16* xbc = (const bf16*)(P.ws + WS_XBC); const float* dtv = (const float*)(P.ws + WS_DTV);
    bf16* yout = (bf16*)(P.ws + (dir ? WS_YB : WS_YF));
    const float Aneg = -__expf(P.a_log[dir * 16 + h]); const float Dsk = P.d_skip[h];
    float hs[128];
#pragma unroll
    for (int n = 0; n < 128; ++n) hs[n] = 0.f;
    int ch[5]; ch[0] = h * 64 + p; ch[1] = 1024 + g * 128 + p; ch[2] = 1024 + g * 128 + 64 + p; ch[3] = 1536 + g * 128 + p; ch[4] = 1536 + g * 128 + 64 + p;
    float cw[5][5], cb[5];
#pragma unroll
    for (int i = 0; i < 5; ++i) { cb[i] = P.conv_b[ch[i]];
#pragma unroll
        for (int w = 0; w < 5; ++w) cw[i][w] = P.conv_w[w * CONVD + ch[i]]; }
    for (int seg = 0; seg < 2; ++seg) {
        const int len = seg == 0 ? CTX : SEQ; const size_t rbase = seg == 0 ? (size_t)TL + (size_t)b * CTX : (size_t)b * SEQ;
        for (int st = 0; st < len; ++st) {
            const int t = dir ? len - 1 - st : st;
            float cv[5];
#pragma unroll
            for (int i = 0; i < 5; ++i) { float a = cb[i];
#pragma unroll
                for (int w = 0; w < 5; ++w) { const int tt = t + w - 2; if (tt >= 0 && tt < len) a += bf2f(xbc[(rbase + tt) * 2048 + ch[i]]) * cw[i][w]; }
                cv[i] = siluf(a); }
            __syncthreads();
            if (act) { Bs[p] = cv[1]; Bs[64 + p] = cv[2]; Cs[p] = cv[3]; Cs[64 + p] = cv[4]; }
            __syncthreads();
            if (act) {
            const float dt = dtv[(rbase + t) * 32 + dir * 16 + h]; const float dec = __expf(dt * Aneg); const float xd = cv[0] * dt;
            float y = 0.f;
#pragma unroll
            for (int n = 0; n < 128; ++n) { hs[n] = hs[n] * dec + Bs[n] * xd; y += Cs[n] * hs[n]; }
            if (seg == 1) { if (dir == 0) y += Dsk * cv[0]; yout[(rbase + t) * 1024 + h * 64 + p] = (bf16)f2bf(y); }
            }
        }
    }
    }
}
DEVI void phase_four_naive(const Ptrs& P, const Frame& F) {
    LAS float* tab = (LAS float*)F.lds;
    for (int i = F.tid; i < 4096; i += 512) { const float a = (float)i * (2.0f / 4096.0f); tab[2 * i] = cospif(a); tab[2 * i + 1] = sinpif(a); }
    __syncthreads();
    const int d = F.tid & 127, ks = F.tid >> 7;
    for (int u = F.vcu; u < 8 * 4 * 128; u += F.G) { const int b = u >> 9, g = (u >> 7) & 3, k0 = (u & 127) * 32;
        const bf16* Y = (const bf16*)(P.ws + WS_YZ) + (size_t)b * SEQ * 1024 + g * 256 + d;
        float acc[8]; int kk[8];
#pragma unroll
        for (int i = 0; i < 8; ++i) { kk[i] = k0 + ks * 8 + i; acc[i] = 0.f; }
        for (int l = 0; l < SEQ; ++l) { const float yr = bf2f(Y[(size_t)l * 1024]), yi = bf2f(Y[(size_t)l * 1024 + 128]);
#pragma unroll
            for (int i = 0; i < 8; ++i) { const int ti = ((kk[i] * l) & 4095) * 2; acc[i] += tab[ti] * yr + tab[ti + 1] * yi; } }
        bf16* out = (bf16*)(P.ws + WS_MIX);
#pragma unroll
        for (int i = 0; i < 8; ++i) out[((size_t)b * SEQ + kk[i]) * DMIX + 1024 + g * 128 + d] = (bf16)f2bf(acc[i] * (1.f / 64.f)); }
    __syncthreads();
}
DEVI void phase_combine(const Ptrs& P, const Frame& F) {
    const int gw = F.vcu * NWAVES + F.wave, NGW = F.G * NWAVES, lane = F.lane;
    for (int row = gw; row < TL; row += NGW) {
        const bf16* yf = (const bf16*)(P.ws + WS_YF) + (size_t)row * 1024; const bf16* yb = (const bf16*)(P.ws + WS_YB) + (size_t)row * 1024; const bf16* zs = (const bf16*)(P.ws + WS_ZS) + (size_t)row * 1024;
        float v[16]; float s = 0.f;
#pragma unroll
        for (int j = 0; j < 2; ++j) { const int c0 = (lane + 64 * j) * 8; const v4u a = *(const v4u*)(yf + c0), bb = *(const v4u*)(yb + c0), z = *(const v4u*)(zs + c0);
#pragma unroll
            for (int i = 0; i < 4; ++i) { const float y0 = (__uint_as_float(a[i] << 16) + __uint_as_float(bb[i] << 16)) * __uint_as_float(z[i] << 16);
                const float y1 = (__uint_as_float(a[i] & 0xffff0000u) + __uint_as_float(bb[i] & 0xffff0000u)) * __uint_as_float(z[i] & 0xffff0000u);
                v[j * 8 + 2 * i] = y0; v[j * 8 + 2 * i + 1] = y1; s += y0 * y0 + y1 * y1; } }
        const float rstd = rsqrtf(wave_sum(s) * (1.f / 1024.f) + EPS);
        bf16* dst = (bf16*)(P.ws + WS_MIX) + (size_t)row * DMIX;
#pragma unroll
        for (int j = 0; j < 2; ++j) { const int c0 = (lane + 64 * j) * 8; const f32x4 n0 = *(const f32x4*)(P.ssd_norm + c0), n1 = *(const f32x4*)(P.ssd_norm + c0 + 4);
            v4u o; o.x = pk2(v[j * 8 + 0] * rstd * n0[0], v[j * 8 + 1] * rstd * n0[1]); o.y = pk2(v[j * 8 + 2] * rstd * n0[2], v[j * 8 + 3] * rstd * n0[3]);
            o.z = pk2(v[j * 8 + 4] * rstd * n1[0], v[j * 8 + 5] * rstd * n1[1]); o.w = pk2(v[j * 8 + 6] * rstd * n1[2], v[j * 8 + 7] * rstd * n1[3]);
            *(v4u*)(dst + c0) = o; }
    }
}
DEVI void phase_expert_weights(const Ptrs& P, const Frame& F) {
    LAS float* scr = (LAS float*)(F.lds + F.wave * 16384); const int gw = F.vcu * NWAVES + F.wave, NGW = F.G * NWAVES;
    bf16* Wup = (bf16*)(P.ws + WS_WUP); bf16* Wdn = (bf16*)(P.ws + WS_WDN);
    constexpr int I_UP = 32 * 2 * 256, I_DN = 32 * 256;
    for (int it = gw; it < I_UP + I_DN; it += NGW) {
        if (it < I_UP) { const int e = it >> 9, half = (it >> 8) & 1, r = it & 255, kb = r >> 4, nb = r & 15, n0 = nb * 32;
            const float* W = (half ? P.w_eu : P.w_eg) + (size_t)e * DM * DE;
            transpose_item(W, DE, Wup, DM, e * 1024 + (n0 >> 7) * 256 + half * 128 + (n0 & 127) - n0, kb * 64, n0, scr, F.lane); }
        else { const int r2 = it - I_UP, e = r2 >> 8, r = r2 & 255, kb = r >> 5, nb = r & 31;
            transpose_item(P.w_ed + (size_t)e * DE * DM, DM, Wdn, DE, e * 1024, kb * 64, nb * 32, scr, F.lane); } }
}
DEVI void phase_route(const Ptrs& P, const Frame& F) {
    const int gw = F.vcu * NWAVES + F.wave, NGW = F.G * NWAVES, lane = F.lane;
    LAS unsigned* lcnt = (LAS unsigned*)(F.lds + LDSCTL_OFF + LC_CNT);
    if (F.tid < 64) lcnt[F.tid] = 0u;
    __syncthreads();
    int* eid = (int*)(P.ws + WS_ROUTE); int* pos = eid + 65536; float* gate = (float*)(pos + 65536);
    const float* modall = (const float*)(P.ws + WS_MOD);
    for (int row = gw; row < TL; row += NGW) {
        const float* src = P.out + (size_t)row * DM; const float* mod = modall + (row / SEQ) * 6144;
        f32x4 v[4]; float s = 0.f;
#pragma unroll
        for (int j = 0; j < 4; ++j) { v[j] = ((const f32x4*)src)[lane + 64 * j]; s += (v[j][0] * v[j][0] + v[j][1] * v[j][1]) + (v[j][2] * v[j][2] + v[j][3] * v[j][3]); }
        const float rstd = rsqrtf(wave_sum(s) * (1.f / DM) + EPS);
        float t[16]; bf16* dst = (bf16*)(P.ws + WS_H2) + (size_t)row * DM;
#pragma unroll
        for (int j = 0; j < 4; ++j) { const int c0 = (lane + 64 * j) * 4; const f32x4 nw = *(const f32x4*)(P.norm2 + c0), sh = *(const f32x4*)(mod + 3072 + c0), sc = *(const f32x4*)(mod + 4096 + c0);
#pragma unroll
            for (int i = 0; i < 4; ++i) t[j * 4 + i] = v[j][i] * rstd * nw[i] * (1.f + sc[i]) + sh[i];
            uint2 w; w.x = pk2(t[j * 4], t[j * 4 + 1]); w.y = pk2(t[j * 4 + 2], t[j * 4 + 3]); *(uint2*)(dst + c0) = w; }
        float lg[4] = {0.f, 0.f, 0.f, 0.f};
#pragma unroll
        for (int j = 0; j < 4; ++j)
#pragma unroll
            for (int i = 0; i < 4; ++i) { const f32x4 w = *(const f32x4*)(P.w_rg + (size_t)((lane + 64 * j) * 4 + i) * 4);
#pragma unroll
                for (int q = 0; q < 4; ++q) lg[q] += t[j * 4 + i] * w[q]; }
#pragma unroll
        for (int q = 0; q < 4; ++q) lg[q] = wave_sum(lg[q]) + P.b_rg[q];
        int grp = 0; float mx = lg[0];
#pragma unroll
        for (int q = 1; q < 4; ++q) if (lg[q] > mx) { mx = lg[q]; grp = q; }
        float den = 0.f;
#pragma unroll
        for (int q = 0; q < 4; ++q) den += __expf(lg[q] - mx);
        const float pgrp = 1.f / den;
        float le[8] = {0.f, 0.f, 0.f, 0.f, 0.f, 0.f, 0.f, 0.f};
#pragma unroll
        for (int j = 0; j < 4; ++j)
#pragma unroll
            for (int i = 0; i < 4; ++i) { const float* wp = P.w_re + ((size_t)grp * DM + (lane + 64 * j) * 4 + i) * 8; const f32x4 w0 = *(const f32x4*)wp, w1 = *(const f32x4*)(wp + 4);
#pragma unroll
                for (int q = 0; q < 4; ++q) { le[q] += t[j * 4 + i] * w0[q]; le[4 + q] += t[j * 4 + i] * w1[q]; } }
#pragma unroll
        for (int q = 0; q < 8; ++q) le[q] = wave_sum(le[q]) + P.b_re[grp * 8 + q];
        int j0 = 0; float m0 = le[0];
#pragma unroll
        for (int q = 1; q < 8; ++q) if (le[q] > m0) { m0 = le[q]; j0 = q; }
        int j1 = 0; float m1 = -3.0e38f;
#pragma unroll
        for (int q = 0; q < 8; ++q) if (q != j0 && le[q] > m1) { m1 = le[q]; j1 = q; }
        const float e1 = __expf(m1 - m0);
        if (lane == 0) { const int ea = grp * 8 + j0, eb = grp * 8 + j1;
            eid[row * 2] = ea; eid[row * 2 + 1] = eb; gate[row * 2] = pgrp / (1.f + e1); gate[row * 2 + 1] = pgrp * e1 / (1.f + e1);
            const int it = (row - gw) / NGW; LAS int* rt = (LAS int*)(F.lds + LDSCTL_OFF + LC_RT) + (F.wave * 16 + (it & 15)) * 4;
            rt[0] = ea; rt[1] = eb; rt[2] = (int)__hip_atomic_fetch_add(&lcnt[ea], 1u, __ATOMIC_RELAXED, __HIP_MEMORY_SCOPE_WORKGROUP); rt[3] = (int)__hip_atomic_fetch_add(&lcnt[eb], 1u, __ATOMIC_RELAXED, __HIP_MEMORY_SCOPE_WORKGROUP); }
    }
    __syncthreads();
    if (F.tid < 32) lcnt[32 + F.tid] = __hip_atomic_fetch_add((unsigned*)(P.ws + WS_CTL) + CW_CNT + F.tid, lcnt[F.tid], RLX_AGENT);
    __syncthreads();
    for (int row = gw; row < TL; row += NGW) if (lane < 2) { const int it = (row - gw) / NGW; const LAS int* rt = (const LAS int*)(F.lds + LDSCTL_OFF + LC_RT) + (F.wave * 16 + (it & 15)) * 4;
        pos[row * 2 + lane] = rt[2 + lane] + (int)lcnt[32 + rt[lane]]; }
    __syncthreads();
}
DEVI int build_tile_table(const Ptrs& P, const Frame& F) {
    LAS int* tile_e = (LAS int*)(F.lds + LDSCTL_OFF + LC_TILE); LAS unsigned* lcnt = (LAS unsigned*)(F.lds + LDSCTL_OFF + LC_CNT);
    __syncthreads();
    if (F.tid < 32) lcnt[F.tid] = __hip_atomic_load((unsigned*)(P.ws + WS_CTL) + CW_CNT + F.tid, RLX_AGENT);
    __syncthreads();
    if (F.tid == 0) { int s = 0; for (int e = 0; e < NE; ++e) { const int nt = (int)((lcnt[e] + 255u) >> 8); lcnt[64 + e] = (unsigned)(s * 256); for (int i = 0; i < nt; ++i) tile_e[s + i] = e; s += nt; } lcnt[96] = (unsigned)s; }
    __syncthreads();
    return (int)lcnt[96];
}
DEVI void phase_gather(const Ptrs& P, const Frame& F) {
    build_tile_table(P, F);
    const LAS unsigned* lcnt = (const LAS unsigned*)(F.lds + LDSCTL_OFF + LC_CNT);
    const int gw = F.vcu * NWAVES + F.wave, NGW = F.G * NWAVES, lane = F.lane;
    const int* eid = (const int*)(P.ws + WS_ROUTE); const int* pos = eid + 65536; const float* gate = (const float*)(pos + 65536);
    int* rowdest = (int*)(P.ws + WS_ROUTE + 3 * 262144); float* rowgate = (float*)(rowdest + RPAD);
    for (int a = gw; a < 65536; a += NGW) {
        const int row = (int)lcnt[64 + eid[a]] + pos[a];
        const v4u* src = (const v4u*)((const bf16*)(P.ws + WS_H2) + (size_t)(a >> 1) * DM); v4u* dst = (v4u*)((bf16*)(P.ws + WS_HPERM) + (size_t)row * DM);
        dst[lane] = src[lane]; dst[lane + 64] = src[lane + 64];
        if (lane == 0) { rowdest[row] = a; rowgate[row] = gate[a]; }
    }
}
DEVI void phase_final(const Ptrs& P, const Frame& F) {
    const int gw = F.vcu * NWAVES + F.wave, NGW = F.G * NWAVES, lane = F.lane;
    for (int row = gw; row < TL; row += NGW) {
        float* xr = P.out + (size_t)row * DM; const float* g2 = (const float*)(P.ws + WS_MOD) + (row / SEQ) * 6144 + 5120;
        const bf16* y0 = (const bf16*)(P.ws + WS_YBUF) + (size_t)row * 2 * DM; const bf16* y1 = y0 + DM;
        float v[16]; float s = 0.f;
#pragma unroll
        for (int j = 0; j < 4; ++j) { const int c0 = (lane + 64 * j) * 4; const f32x4 xv = *(const f32x4*)(xr + c0), gv = *(const f32x4*)(g2 + c0); const uint2 a = *(const uint2*)(y0 + c0), b = *(const uint2*)(y1 + c0);
            const float ya[4] = {__uint_as_float(a.x << 16), __uint_as_float(a.x & 0xffff0000u), __uint_as_float(a.y << 16), __uint_as_float(a.y & 0xffff0000u)};
            const float yb[4] = {__uint_as_float(b.x << 16), __uint_as_float(b.x & 0xffff0000u), __uint_as_float(b.y << 16), __uint_as_float(b.y & 0xffff0000u)};
#pragma unroll
            for (int i = 0; i < 4; ++i) { const float o = xv[i] + gv[i] * (ya[i] + yb[i]); v[j * 4 + i] = o; s += o * o; } }
        const float rstd = rsqrtf(wave_sum(s) * (1.f / DM) + EPS);
#pragma unroll
        for (int j = 0; j < 4; ++j) { const int c0 = (lane + 64 * j) * 4; const f32x4 fn = *(const f32x4*)(P.final_norm + c0); f32x4 o;
#pragma unroll
            for (int i = 0; i < 4; ++i) o[i] = v[j * 4 + i] * rstd * fn[i];
            *(f32x4*)(xr + c0) = o; }
    }
}
#ifndef MK_N_LAUNCHES
#define MK_N_LAUNCHES 1
#endif
constexpr int NPHASE = 10;
struct Args { Ptrs P; int ph_lo, ph_hi; };
__global__ void __launch_bounds__(NWAVES * 64, 2) fwd_megakernel(Args args) {
    extern __shared__ __attribute__((aligned(16))) unsigned char lds_raw[];
    Frame F; F.lds = (LAS unsigned char*)lds_raw;
    F.tid = threadIdx.x; F.lane = F.tid & 63; F.wave = __builtin_amdgcn_readfirstlane(F.tid >> 6);
    F.G = gridDim.x; { const int bx = blockIdx.x; F.vcu = (F.G % 8 == 0) ? (bx % 8) * (F.G / 8) + bx / 8 : bx; }
    const Ptrs& P = args.P;
    for (int u = F.tid; u < (LDS_BYTES - LDSCTL_OFF) / 4; u += NWAVES * 64) ((LAS unsigned*)(F.lds + LDSCTL_OFF))[u] = 0u;
    __syncthreads();
    XcdBarrier bar; bar.bar = (unsigned*)(P.ws + WS_CTL) + CW_BAR; bar.x = 0; bar.st = nullptr;
    const bool one = (args.ph_hi - args.ph_lo) > 1;
    if (one) bar = xcd_barrier_post((unsigned*)(P.ws + WS_CTL) + CW_BAR, (volatile LAS unsigned*)(F.lds + LDSCTL_OFF + LC_MISC) + 8);
    const int lo = args.ph_lo, hi = args.ph_hi;
#define IN(k) (lo <= (k) && (k) < hi)
#define SEAM(k) do { if (IN(k) && IN((k) + 1)) xcd_barrier(bar); } while (0)
    if (IN(0)) { phase0a(P, F); } SEAM(0);
    if (IN(1)) { phase0b(P, F); } SEAM(1);
    if (IN(2)) {
        pg8::Gemm g{(const bf16*)(P.ws + WS_XN), (const bf16*)(P.ws + WS_WIN), TA, NIN, DM}; pg8::InProjOrder S{F.G, (int)blockIdx.x};
        pg8::EpiInProj E{(bf16*)(P.ws + WS_ZS), (bf16*)(P.ws + WS_XBC), (bf16*)(P.ws + WS_YZ), (float*)(P.ws + WS_DTV), P.dt_bias};
        pg8::gemm_phase<pg8::EpiInProj, pg8::InProjOrder, true, true>(F.lds, g, S, E);
    } SEAM(2);
    if (IN(3)) { phase_ssd_naive(P, F); } SEAM(3);
    if (IN(4)) { phase_four_naive(P, F); phase_combine(P, F); } SEAM(4);
    if (IN(5)) {
        pg8::Gemm g{(const bf16*)(P.ws + WS_MIX), (const bf16*)(P.ws + WS_WOUT), TL, DM, DMIX}; pg8::StaticOrder S; S.init(TL, DM, F.G, (int)blockIdx.x);
        pg8::EpiOutProj E{P.x, P.out, (const float*)(P.ws + WS_MOD)};
        pg8::gemm_phase<pg8::EpiOutProj, pg8::StaticOrder, true, true>(F.lds, g, S, E);
        phase_expert_weights(P, F);
    } SEAM(5);
    if (IN(6)) { phase_route(P, F); } SEAM(6);
    if (IN(7)) { phase_gather(P, F); } SEAM(7);
    if (IN(8)) {
        const int nt = build_tile_table(P, F);
        pg8::MoeOrder S{(const LAS int*)(F.lds + LDSCTL_OFF + LC_TILE), nt, F.G, (int)blockIdx.x};
        pg8::Gemm g{(const bf16*)(P.ws + WS_HPERM), (const bf16*)(P.ws + WS_WUP), RPAD, NE * 1024, DM};
        pg8::EpiUp E{(bf16*)(P.ws + WS_ACT)};
        pg8::gemm_phase<pg8::EpiUp, pg8::MoeOrder, true, true>(F.lds, g, S, E);
    } SEAM(8);
    if (IN(9)) {
        const int nt = build_tile_table(P, F);
        pg8::MoeOrder S{(const LAS int*)(F.lds + LDSCTL_OFF + LC_TILE), nt, F.G, (int)blockIdx.x};
        pg8::Gemm g{(const bf16*)(P.ws + WS_ACT), (const bf16*)(P.ws + WS_WDN), RPAD, NE * 1024, DE};
        pg8::EpiDown E{(bf16*)(P.ws + WS_YBUF), (const int*)(P.ws + WS_ROUTE + 3 * 262144), (const float*)(P.ws + WS_ROUTE + 3 * 262144 + 4 * RPAD)};
        pg8::gemm_phase<pg8::EpiDown, pg8::MoeOrder, true, true>(F.lds, g, S, E);
    } SEAM(9);
    if (IN(10)) { phase_final(P, F); }
#undef IN
#undef SEAM
}

extern "C" void kernel_launch(void* const* d_in, const int* in_sizes, int n_in, void* d_out, int out_size, void* d_ws, size_t ws_size, hipStream_t stream) {
    static int grid = 0;
    if (grid == 0) {
        if (n_in != 25 || in_sizes[0] != TL * DM || out_size != TL * DM || ws_size < WS_END) { fprintf(stderr, "kernel_launch: unexpected shapes (n_in %d, ws %zu)\n", n_in, ws_size); grid = -1; return; }
        int dev = 0, cus = 0, per_cu = 0;
        if (hipGetDevice(&dev) != hipSuccess || hipDeviceGetAttribute(&cus, hipDeviceAttributeMultiprocessorCount, dev) != hipSuccess) { grid = -1; return; }
        if (hipFuncSetAttribute((const void*)fwd_megakernel, hipFuncAttributeMaxDynamicSharedMemorySize, LDS_BYTES) != hipSuccess) { fprintf(stderr, "kernel_launch: hipFuncSetAttribute failed\n"); grid = -1; return; }
        if (hipOccupancyMaxActiveBlocksPerMultiprocessor(&per_cu, (const void*)fwd_megakernel, NWAVES * 64, LDS_BYTES) != hipSuccess || per_cu < 1) fprintf(stderr, "kernel_launch: occupancy query reports %d\n", per_cu);
        (void)hipGetLastError();
        grid = cus;
        if (grid != 256) fprintf(stderr, "kernel_launch: built for 256 CUs, got %d\n", grid);
    }
    if (grid < 0) return;
    (void)hipMemsetAsync((char*)d_ws + WS_CTL, 0, CTL_ZERO_BYTES, stream);
    Args a{};
    const float** pp = (const float**)&a.P;
    for (int i = 0; i < 25; ++i) pp[i] = (const float*)d_in[i];
    a.P.out = (float*)d_out; a.P.ws = (unsigned char*)d_ws;
#if MK_N_LAUNCHES == 1
    a.ph_lo = 0; a.ph_hi = NPHASE + 1;
    hipLaunchKernelGGL(fwd_megakernel, dim3(grid), dim3(NWAVES * 64), LDS_BYTES, stream, a);
#else
    for (int ph = 0; ph <= NPHASE; ++ph) { a.ph_lo = ph; a.ph_hi = ph + 1; hipLaunchKernelGGL(fwd_megakernel, dim3(grid), dim3(NWAVES * 64), LDS_BYTES, stream, a); }
#endif
}
```

```cpp
#include <hip/hip_runtime.h>
#include <cstdio>
#include <cstdint>
namespace pg8 {
#define PG8_LAS __attribute__((address_space(3)))
typedef unsigned short bf16_t;
typedef short bf16x8 __attribute__((ext_vector_type(8)));
typedef float f32x4 __attribute__((ext_vector_type(4)));
typedef unsigned u32x4 __attribute__((ext_vector_type(4)));
constexpr int BM = 256, BK = 64, HALF = 128, HTB = HALF * BK * 2  , STAGE_BYTES = 8 * HTB, NXCD = 8, WGM = 8;

__host__ __device__ __forceinline__ int lds_byte(int r, int c) { const int st = (r >> 4) * 2 + (c >> 5), rr = r & 15, cc = c & 31, ob = rr * 64 + cc * 2; return st * 1024 + (ob ^ (((ob >> 9) & 1) << 5)); }
__host__ __device__ __forceinline__ void stage_rc(int b, int& R, int& C) { const int st = b / 1024, sb = b % 1024, swz = sb ^ (((sb >> 9) & 1) << 5); R = (st >> 1) * 16 + swz / 64; C = (st & 1) * 32 + (swz % 64) / 2; }
__host__ __device__ __forceinline__ int perm32(int rho) { const int n = rho >> 4, i = rho & 15; return 8 * (i >> 2) + 4 * n + (i & 3); }

struct Unit { int pm, pn; };
struct Gemm { const bf16_t* A; const bf16_t* Bt; int M, N, K; };

struct StaticOrder {
    int nM, nN, nwg, G, c;
    __host__ __device__ void init(int M, int N, int G_, int c_) { nM = M / BM; nN = N / BM; nwg = nM * nN; G = G_; c = c_; }
    __host__ __device__ bool next(int i, Unit& u) const {
        const long L = (long)i * G + c; if (L >= nwg) return false;
        int wgid = (int)L; { const int q = nwg / NXCD, r = nwg % NXCD, xcd = wgid % NXCD, off = wgid / NXCD; wgid = (xcd < r ? xcd * (q + 1) : r * (q + 1) + (xcd - r) * q) + off; }
        const int nig = WGM * nN, gid = wgid / nig, fm = gid * WGM, gsz = (nM - fm) < WGM ? (nM - fm) : WGM;
        u.pm = fm + ((wgid % nig) % gsz); u.pn = (wgid % nig) / gsz; return true;
    }
    __device__ __forceinline__ void a_ready(const Unit&) const {}
    __device__ __forceinline__ void done(const Unit&) const {}
};

__device__ __forceinline__ unsigned cvt_pk_bf16(float lo, float hi) { unsigned r; asm volatile("v_cvt_pk_bf16_f32 %0, %1, %2" : "=v"(r) : "v"(lo), "v"(hi)); return r; }
typedef float f32x2 __attribute__((ext_vector_type(2)));
__device__ __forceinline__ float silu_f(float v) { return v * __builtin_amdgcn_rcpf(1.f + __expf(-v)); }
__device__ __forceinline__ float softplus_f(float v) { return v > 20.f ? v : log1pf(__expf(v)); }
struct EpiInProj {
    static constexpr bool PERM = true, AFTER_DRAIN = false;
    bf16_t* zs; bf16_t* xbc; bf16_t* yz; float* dtv; const float* dt_bias;
    __device__ __forceinline__ void operator()(const f32x4 (&acc)[2][2][4][2], const Unit& u, int wr, int wc, int fr, int fq) const {
        const int row0 = u.pm * BM + wr * 64 + fr; const int pn = u.pn;
        if (pn == 16) {
            if (wc == 0) {
                f32x4 bv[2];
#pragma unroll
                for (int n = 0; n < 2; ++n) bv[n] = *(const f32x4*)(dt_bias + 8 * fq + 4 * n);
#pragma unroll
                for (int ai = 0; ai < 2; ++ai)
#pragma unroll
                    for (int m = 0; m < 4; ++m) { float* rp = dtv + (size_t)(row0 + ai * HALF + m * 16) * 32 + 8 * fq;
#pragma unroll
                        for (int n = 0; n < 2; ++n) { const f32x4 v = acc[ai][0][m][n] + bv[n]; f32x4 o; o[0] = softplus_f(v[0]); o[1] = softplus_f(v[1]); o[2] = softplus_f(v[2]); o[3] = softplus_f(v[3]); *(f32x4*)(rp + 4 * n) = o; } }
            }
            return;
        }
        bf16_t* base; int ldc, colt; bool act = false;
        if (pn < 4) { base = zs; ldc = 1024; colt = pn * 256; act = true; } else if (pn < 12) { base = xbc; ldc = 2048; colt = (pn - 4) * 256; } else { base = yz; ldc = 1024; colt = (pn - 12) * 256; }
        const int col0 = colt + wc * 32 + 8 * fq;
#pragma unroll
        for (int ai = 0; ai < 2; ++ai)
#pragma unroll
            for (int m = 0; m < 4; ++m) { bf16_t* rowp = base + (size_t)(row0 + ai * HALF + m * 16) * ldc + col0;
#pragma unroll
                for (int bj = 0; bj < 2; ++bj) { f32x4 v0 = acc[ai][bj][m][0], v1 = acc[ai][bj][m][1];
                    if (act) { v0[0] = silu_f(v0[0]); v0[1] = silu_f(v0[1]); v0[2] = silu_f(v0[2]); v0[3] = silu_f(v0[3]); v1[0] = silu_f(v1[0]); v1[1] = silu_f(v1[1]); v1[2] = silu_f(v1[2]); v1[3] = silu_f(v1[3]); }
                    u32x4 w; w.x = cvt_pk_bf16(v0[0], v0[1]); w.y = cvt_pk_bf16(v0[2], v0[3]); w.z = cvt_pk_bf16(v1[0], v1[1]); w.w = cvt_pk_bf16(v1[2], v1[3]);
                    *(u32x4*)(rowp + bj * HALF) = w; } }
    }
};
struct EpiOutProj {
    static constexpr bool PERM = false, AFTER_DRAIN = false;
    const float* x; float* out; const float* mod;
    __device__ __forceinline__ void operator()(const f32x4 (&acc)[2][2][4][2], const Unit& u, int wr, int wc, int fr, int fq) const {
        const int row0 = u.pm * BM + wr * 64 + fr, col0 = u.pn * BM + wc * 32 + 4 * fq;
        const float* g1 = mod + (size_t)(u.pm >> 4) * 6144 + 2048 + col0;
        f32x4 gv[2][2];
#pragma unroll
        for (int bj = 0; bj < 2; ++bj)
#pragma unroll
            for (int n = 0; n < 2; ++n) gv[bj][n] = *(const f32x4*)(g1 + bj * HALF + n * 16);
#pragma unroll
        for (int ai = 0; ai < 2; ++ai)
#pragma unroll
            for (int m = 0; m < 4; ++m) { const size_t off = (size_t)(row0 + ai * HALF + m * 16) * 1024 + col0;
#pragma unroll
                for (int bj = 0; bj < 2; ++bj)
#pragma unroll
                    for (int n = 0; n < 2; ++n) { const f32x4 xv = *(const f32x4*)(x + off + bj * HALF + n * 16); *(f32x4*)(out + off + bj * HALF + n * 16) = xv + gv[bj][n] * acc[ai][bj][m][n]; } }
    }
};
struct EpiUp {
    static constexpr bool PERM = true, AFTER_DRAIN = false;
    bf16_t* act;
    __device__ __forceinline__ void operator()(const f32x4 (&acc)[2][2][4][2], const Unit& u, int wr, int wc, int fr, int fq) const {
        const int row0 = u.pm * BM + wr * 64 + fr, col0 = (u.pn & 3) * 128 + wc * 32 + 8 * fq;
#pragma unroll
        for (int ai = 0; ai < 2; ++ai)
#pragma unroll
            for (int m = 0; m < 4; ++m) { float a[8];
#pragma unroll
                for (int n = 0; n < 2; ++n)
#pragma unroll
                    for (int i = 0; i < 4; ++i) a[n * 4 + i] = silu_f(acc[ai][0][m][n][i]) * acc[ai][1][m][n][i];
                u32x4 w; w.x = cvt_pk_bf16(a[0], a[1]); w.y = cvt_pk_bf16(a[2], a[3]); w.z = cvt_pk_bf16(a[4], a[5]); w.w = cvt_pk_bf16(a[6], a[7]);
                *(u32x4*)(act + (size_t)(row0 + ai * HALF + m * 16) * 512 + col0) = w; }
    }
};
struct EpiDown {
    static constexpr bool PERM = true, AFTER_DRAIN = false;
    bf16_t* ybuf; const int* rowdest; const float* rowgate;
    __device__ __forceinline__ void operator()(const f32x4 (&acc)[2][2][4][2], const Unit& u, int wr, int wc, int fr, int fq) const {
        const int row0 = u.pm * BM + wr * 64 + fr, col0 = (u.pn & 3) * 256 + wc * 32 + 8 * fq;
#pragma unroll
        for (int ai = 0; ai < 2; ++ai)
#pragma unroll
            for (int m = 0; m < 4; ++m) { const int row = row0 + ai * HALF + m * 16; const int dest = rowdest[row]; const float gt = rowgate[row];
                if (dest >= 0) {
#pragma unroll
                    for (int bj = 0; bj < 2; ++bj) { const f32x4 v0 = acc[ai][bj][m][0] * gt, v1 = acc[ai][bj][m][1] * gt;
                        u32x4 w; w.x = cvt_pk_bf16(v0[0], v0[1]); w.y = cvt_pk_bf16(v0[2], v0[3]); w.z = cvt_pk_bf16(v1[0], v1[1]); w.w = cvt_pk_bf16(v1[2], v1[3]);
                        *(u32x4*)(ybuf + (size_t)dest * 1024 + col0 + bj * HALF) = w; } } }
    }
};
struct InProjOrder {
    int G, c;
    __device__ __forceinline__ bool next(int i, Unit& u) const {
        const int L = i * G + c;
        if (L < 2176) { const int wgid = (L % NXCD) * 272 + L / NXCD; const int r = wgid % 136; u.pm = (wgid / 136) * 8 + (r & 7); u.pn = r >> 3; return true; }
        const int L2 = L - 2176; if (L2 >= 72) return false;
        u.pm = 128 + L2 / 9; const int j = L2 % 9; u.pn = j < 8 ? 4 + j : 16; return true;
    }
    __device__ __forceinline__ void a_ready(const Unit&) const {}
    __device__ __forceinline__ void done(const Unit&) const {}
};
struct MoeOrder {
    const PG8_LAS int* tile_e; int ntiles, G, c;
    __device__ __forceinline__ bool next(int i, Unit& u) const {
        const int L = i * G + c; if (L >= ntiles * 4) return false;
        const int rt = L >> 2; u.pm = rt; u.pn = tile_e[rt] * 4 + (L & 3); return true;
    }
    __device__ __forceinline__ void a_ready(const Unit&) const {}
    __device__ __forceinline__ void done(const Unit&) const {}
};
template <class Epi, class Sched, bool ALIGN_EPI = false, bool SP2 = false>
__device__ __forceinline__ void gemm_phase(PG8_LAS unsigned char* lds, const Gemm g, const Sched& S, const Epi& E) {
    const int tid = threadIdx.x, wid = __builtin_amdgcn_readfirstlane(tid >> 6), lane = tid & 63, wr = wid >> 2, wc = wid & 3, fr = lane & 15, fq = lane >> 4;
    const int K = g.K, nt = K / BK;
    unsigned voffA[2], voffB[2];
#pragma unroll
    for (int i = 0; i < 2; ++i) { int R, C; stage_rc(tid * 16 + i * 8192, R, C); const int Rb = Epi::PERM ? ((R & ~31) + perm32(R & 31)) : R;
        voffA[i] = (unsigned)(R * K + C) * 2u; voffB[i] = (unsigned)(Rb * K + C) * 2u; }
    const size_t kstep = (size_t)(BK * 2);
    const size_t hstep = (size_t)HALF * K * 2;
    const size_t tstep = 2 * hstep;
    const unsigned ldsw = (unsigned)wid * 1024u;
    const int aoff = lds_byte(wr * 64 + fr, fq * 8), boff = lds_byte(wc * 32 + fr, fq * 8);
#define PG8_SA(b, h) (((b) * 2 + (h)) * HTB)
#define PG8_SB(b, h) ((4 + (b) * 2 + (h)) * HTB)
#define PG8_STAGE(bufoff, gbase, voff) do { _Pragma("unroll") for (int _i = 0; _i < 2; ++_i) \
        __builtin_amdgcn_global_load_lds((const unsigned*)((const char*)(gbase) + (voff)[_i]), (PG8_LAS unsigned*)(lds + (bufoff) + ldsw + _i * 8192), 16, 0, 0); } while (0)
#define PG8_LDA(dst, b, h) do { _Pragma("unroll") for (int m = 0; m < 4; ++m) _Pragma("unroll") for (int k = 0; k < 2; ++k) dst[m][k] = *(const PG8_LAS bf16x8*)(lds + PG8_SA(b, h) + aoff + m * 2048 + k * 1024); } while (0)
#define PG8_LDB(dst, b, h) do { _Pragma("unroll") for (int n = 0; n < 2; ++n) _Pragma("unroll") for (int k = 0; k < 2; ++k) dst[n][k] = *(const PG8_LAS bf16x8*)(lds + PG8_SB(b, h) + boff + n * 2048 + k * 1024); } while (0)
#define PG8_MMA(ai, bj, At, Bt) do { __builtin_amdgcn_s_setprio(1); _Pragma("unroll") for (int m = 0; m < 4; ++m) _Pragma("unroll") for (int n = 0; n < 2; ++n) _Pragma("unroll") for (int k = 0; k < 2; ++k) \
        acc[ai][bj][m][n] = __builtin_amdgcn_mfma_f32_16x16x32_bf16(Bt[n][k], At[m][k], acc[ai][bj][m][n], 0, 0, 0); __builtin_amdgcn_s_setprio(0); } while (0)
#define PG8_WAIT_V(n) asm volatile("s_waitcnt vmcnt(" #n ")" ::: "memory")
#define PG8_WAIT_L(n) asm volatile("s_waitcnt lgkmcnt(" #n ")" ::: "memory")
#define PG8_BAR __builtin_amdgcn_s_barrier()
#define PG8_SCHED __builtin_amdgcn_sched_barrier(0)
    Unit cur, nxt; int ui = 0;
    if (!S.next(0, cur)) return;
    f32x4 acc[2][2][4][2];
#pragma unroll
    for (int a = 0; a < 2; ++a)
#pragma unroll
        for (int b = 0; b < 2; ++b)
#pragma unroll
            for (int m = 0; m < 4; ++m)
#pragma unroll
                for (int n = 0; n < 2; ++n) acc[a][b][m][n] = (f32x4){0.f, 0.f, 0.f, 0.f};
    bf16x8 At[4][2], B0[2][2], B1[2][2];
    const char* cA = (const char*)g.A + (size_t)cur.pm * tstep; const char* cB = (const char*)g.Bt + (size_t)cur.pn * tstep;
    S.a_ready(cur);
    if constexpr (SP2) {
        PG8_STAGE(PG8_SB(0, 0), cB, voffB); PG8_STAGE(PG8_SB(0, 1), cB + hstep, voffB); PG8_STAGE(PG8_SA(0, 0), cA, voffA); PG8_STAGE(PG8_SA(0, 1), cA + hstep, voffA);
        if (wr == 1) PG8_BAR;
        PG8_WAIT_V(2); PG8_BAR;
        PG8_STAGE(PG8_SB(1, 0), cB + kstep, voffB); PG8_STAGE(PG8_SA(1, 0), cA + kstep, voffA); PG8_STAGE(PG8_SB(1, 1), cB + hstep + kstep, voffB);
        PG8_WAIT_V(6); PG8_BAR;
    } else {
        PG8_STAGE(PG8_SB(0, 0), cB, voffB); PG8_STAGE(PG8_SA(0, 0), cA, voffA); PG8_STAGE(PG8_SB(0, 1), cB + hstep, voffB); PG8_STAGE(PG8_SA(0, 1), cA + hstep, voffA);
        if (wr == 1) PG8_BAR;
        PG8_WAIT_V(4); PG8_BAR;
        PG8_STAGE(PG8_SB(1, 0), cB + kstep, voffB); PG8_STAGE(PG8_SA(1, 0), cA + kstep, voffA); PG8_STAGE(PG8_SB(1, 1), cB + hstep + kstep, voffB);
        PG8_WAIT_V(6); PG8_BAR;
    }
    for (;;) {
        const bool has_next = S.next(ui + 1, nxt);
        const char* nA = has_next ? (const char*)g.A + (size_t)nxt.pm * tstep : cA; const char* nB = has_next ? (const char*)g.Bt + (size_t)nxt.pn * tstep : cB;
        for (int t = 0; t < nt; t += 2) {
            const bool last = (t == nt - 2);
            const char* a1 = cA + (size_t)(t + 1) * kstep;
            const char* a2 = last ? nA : cA + (size_t)(t + 2) * kstep; const char* b2 = last ? nB : cB + (size_t)(t + 2) * kstep;
            const char* a3 = a2 + kstep; const char* b3 = b2 + kstep;
            if (last && has_next) S.a_ready(nxt);
            if constexpr (SP2) {
            PG8_LDB(B0, 0, 0); PG8_LDB(B1, 0, 1); PG8_SCHED; PG8_LDA(At, 0, 0); PG8_STAGE(PG8_SA(1, 1), a1 + hstep, voffA);
            PG8_WAIT_V(8); PG8_WAIT_L(0); PG8_BAR; PG8_MMA(0, 0, At, B0); PG8_MMA(0, 1, At, B1); PG8_BAR; PG8_SCHED;
            PG8_LDA(At, 0, 1); PG8_STAGE(PG8_SB(0, 0), b2, voffB); PG8_STAGE(PG8_SB(0, 1), b2 + hstep, voffB); PG8_STAGE(PG8_SA(0, 0), a2, voffA);
            PG8_WAIT_V(8); PG8_WAIT_L(0); PG8_BAR; PG8_MMA(1, 0, At, B0); PG8_MMA(1, 1, At, B1); PG8_BAR; PG8_SCHED;
            PG8_LDB(B0, 1, 0); PG8_LDB(B1, 1, 1); PG8_SCHED; PG8_LDA(At, 1, 0); PG8_STAGE(PG8_SA(0, 1), a2 + hstep, voffA);
            PG8_WAIT_V(8); PG8_WAIT_L(0); PG8_BAR; PG8_MMA(0, 0, At, B0); PG8_MMA(0, 1, At, B1); PG8_BAR; PG8_SCHED;
            PG8_LDA(At, 1, 1); PG8_STAGE(PG8_SB(1, 0), b3, voffB); PG8_STAGE(PG8_SB(1, 1), b3 + hstep, voffB); PG8_STAGE(PG8_SA(1, 0), a3, voffA);
            PG8_WAIT_V(8); PG8_WAIT_L(0); PG8_BAR; PG8_MMA(1, 0, At, B0); PG8_MMA(1, 1, At, B1); PG8_BAR; PG8_SCHED;
            } else {
            PG8_LDB(B0, 0, 0); PG8_SCHED; PG8_LDA(At, 0, 0); PG8_STAGE(PG8_SA(1, 1), a1 + hstep, voffA);
            PG8_WAIT_L(8); PG8_BAR; PG8_WAIT_L(0); PG8_MMA(0, 0, At, B0); PG8_BAR; PG8_SCHED;
            PG8_LDB(B1, 0, 1); PG8_STAGE(PG8_SB(0, 0), b2, voffB);
            PG8_BAR; PG8_WAIT_L(0); PG8_MMA(0, 1, At, B1); PG8_BAR;
            PG8_LDA(At, 0, 1); PG8_STAGE(PG8_SA(0, 0), a2, voffA);
            PG8_BAR; PG8_WAIT_L(0); PG8_MMA(1, 0, At, B0); PG8_BAR; PG8_SCHED;
            PG8_STAGE(PG8_SB(0, 1), b2 + hstep, voffB);
            PG8_WAIT_V(6); PG8_BAR; PG8_MMA(1, 1, At, B1); PG8_BAR;
            PG8_LDB(B0, 1, 0); PG8_SCHED; PG8_LDA(At, 1, 0); PG8_STAGE(PG8_SA(0, 1), a2 + hstep, voffA);
            PG8_WAIT_L(8); PG8_BAR; PG8_WAIT_L(0); PG8_MMA(0, 0, At, B0); PG8_BAR; PG8_SCHED;
            PG8_LDB(B1, 1, 1); PG8_STAGE(PG8_SB(1, 0), b3, voffB);
            PG8_BAR; PG8_WAIT_L(0); PG8_MMA(0, 1, At, B1); PG8_BAR;
            PG8_LDA(At, 1, 1); PG8_STAGE(PG8_SA(1, 0), a3, voffA);
            PG8_BAR; PG8_WAIT_L(0); PG8_MMA(1, 0, At, B0); PG8_BAR; PG8_SCHED;
            PG8_STAGE(PG8_SB(1, 1), b3 + hstep, voffB);
            PG8_WAIT_V(6); PG8_BAR; PG8_MMA(1, 1, At, B1); PG8_BAR;
            }
        }
        if constexpr (ALIGN_EPI) { if (wr == 0) PG8_BAR; }
        if constexpr (!Epi::AFTER_DRAIN) { E(acc, cur, wr, wc, fr, fq); S.done(cur); }
        if (!has_next) break;
#pragma unroll
        for (int a = 0; a < 2; ++a)
#pragma unroll
            for (int b = 0; b < 2; ++b)
#pragma unroll
                for (int m = 0; m < 4; ++m)
#pragma unroll
                    for (int n = 0; n < 2; ++n) acc[a][b][m][n] = (f32x4){0.f, 0.f, 0.f, 0.f};
        cur = nxt; cA = nA; cB = nB; ++ui;
        if constexpr (ALIGN_EPI) { if (wr == 1) PG8_BAR; }
    }
    PG8_WAIT_V(0);
    if constexpr (!ALIGN_EPI) { if (wr == 0) PG8_BAR; }
    PG8_BAR;
    if constexpr (Epi::AFTER_DRAIN) { E.fused(acc, cur, wr, wc, fr, fq, lds, wid, lane); S.done(cur); }
#undef PG8_SA
#undef PG8_SB
#undef PG8_STAGE
#undef PG8_LDA
#undef PG8_LDB
#undef PG8_MMA
#undef PG8_WAIT_V
#undef PG8_WAIT_L
#undef PG8_BAR
#undef PG8_SCHED
}
}
typedef unsigned short bf16;
#define DEVI __device__ __forceinline__
#define LAS __attribute__((address_space(3)))
#define GAS __attribute__((address_space(1)))
typedef unsigned v4u __attribute__((ext_vector_type(4)));
typedef float f32x4 __attribute__((ext_vector_type(4)));
typedef short s16x4 __attribute__((ext_vector_type(4)));
typedef unsigned u32x2 __attribute__((ext_vector_type(2)));
typedef short bf16x8 __attribute__((ext_vector_type(8)));
#define RLX_AGENT __ATOMIC_RELAXED, __HIP_MEMORY_SCOPE_AGENT
#define LDS_WAIT() asm volatile("s_waitcnt lgkmcnt(0)" ::: "memory")
#define VM_WAIT() asm volatile("s_waitcnt vmcnt(0)" ::: "memory")

constexpr int NWAVES = 8;
constexpr int DM = 1024, NB = 8, SEQ = 4096, CTX = 256;
constexpr int TL = NB * SEQ, TC = NB * CTX, TA = TL + TC;
constexpr int CONVD = 2048, DPROJ = 3616, NIN = 4352, C_XBC = 1024, C_Y = 3072, C_DT = 4096, FOFF = 3104, DMIX = 1536, NE = 32, DE = 512;
constexpr int RPAD = 65536 + NE * 256;
constexpr float EPS = 1e-6f;
constexpr size_t MiB = 1u << 20;
constexpr size_t WS_CTL = 0, CTL_ZERO_BYTES = 64 * 1024;
constexpr size_t WS_WIN = 2 * MiB, WS_WOUT = 11 * MiB, WS_MODP = 14 * MiB, WS_WC = 15 * MiB, WS_ROUTE = 15 * MiB + 512 * 1024, WS_MOD = 1 * MiB;
constexpr size_t WS_XN = 17 * MiB, WS_YF = 17 * MiB, WS_WUP = 17 * MiB, WS_ZS = 85 * MiB, WS_WDN = 85 * MiB, WS_XBC = 149 * MiB, WS_MIX = 149 * MiB, WS_ACT = 149 * MiB;
constexpr size_t WS_YBUF = 222 * MiB, WS_YZ = 285 * MiB, WS_H2 = 285 * MiB, WS_DTV = 350 * MiB, WS_YB = 355 * MiB, WS_AP = 419 * MiB, WS_HPERM = 355 * MiB, WS_END = 512 * MiB;
constexpr int CW_CNT = 0, CW_BAR = 4096;
constexpr int RING_BYTES = 131072, LDSCTL_OFF = 155648, LDS_BYTES = 163840;
constexpr int LC_MISC = 0  , LC_TILE = 256  , LC_CNT = 2048  , LC_RT = 4096  ;

DEVI float bf2f(bf16 v) { return __uint_as_float(((unsigned)v) << 16); }
DEVI unsigned f2bf(float f) { unsigned u = __float_as_uint(f); return (u + 0x7fffu + ((u >> 16) & 1u)) >> 16; }
DEVI unsigned pk2(float lo, float hi) { return f2bf(lo) | (f2bf(hi) << 16); }
DEVI float siluf(float v) { return v / (1.f + __expf(-v)); }
DEVI float wave_sum(float v) {
#pragma unroll
    for (int o = 1; o < 64; o <<= 1) v += __shfl_xor(v, o);
    return v;
}
struct Ptrs {
    const float *x, *c, *ctx, *c_ctx, *w_mod, *b_mod, *norm1, *w_in, *conv_w, *conv_b, *dt_bias, *a_log, *d_skip, *ssd_norm, *w_four, *w_out, *norm2,
        *w_rg, *b_rg, *w_re, *b_re, *w_eg, *w_eu, *w_ed, *final_norm;
    float* out; unsigned char* ws;
};
struct Frame { LAS unsigned char* lds; int tid, lane, wave, vcu, G; };
#define XB_TMO      128
#define XB_XCNT(j)  (256  + 64 * (j))
#define XB_XSUB(j)  (1280 + 64 * (j))
#define XB_XGEN(j)  (2304 + 64 * (j))
#define XB_TOP      3328
#define XB_TOPGEN   3392
#define XCD_BAR_WORDS 3456
#define XB_SPIN_CAP (1u << 18)

__device__ __forceinline__ unsigned xb_ld(unsigned* p)              { return __hip_atomic_load(p, __ATOMIC_RELAXED, __HIP_MEMORY_SCOPE_AGENT); }
__device__ __forceinline__ unsigned xb_add(unsigned* p, unsigned v) { return __hip_atomic_fetch_add(p, v, __ATOMIC_RELAXED, __HIP_MEMORY_SCOPE_AGENT); }
__device__ __forceinline__ unsigned xb_xcc_id() { return (unsigned)__builtin_amdgcn_s_getreg((3 << 11) | 20) & 0xFu; }
#define XB_SPIN(cond, bar) do { unsigned _sp = 0; while (cond) { __builtin_amdgcn_s_sleep(1); \
    if ((++_sp & 255u) == 0u) { if (xb_ld(&(bar)[XB_TMO])) break; if (_sp > XB_SPIN_CAP) { atomicAdd(&(bar)[XB_TMO], 1u); break; } } } } while (0)

struct XcdBarrier {
    unsigned* bar; unsigned x;
    volatile LAS unsigned* st;
};

__device__ __forceinline__ XcdBarrier xcd_barrier_post(unsigned* bar, volatile LAS unsigned* st) {
    XcdBarrier b; b.bar = bar; b.x = xb_xcc_id(); b.st = st;
    if (threadIdx.x == 0) (void)xb_add(&bar[XB_XCNT(b.x)], 1u);
    return b;
}
__device__ __forceinline__ void xcd_barrier_complete(unsigned* bar, unsigned x, unsigned& nloc, unsigned& nx) {
    const unsigned G = gridDim.x * gridDim.y * gridDim.z;
    unsigned sum, cnt, mine, sp = 0u;
    for (;;) {
        sum = 0u; cnt = 0u; mine = 0u;
#pragma unroll
        for (unsigned j = 0; j < 16; ++j) { const unsigned c = xb_ld(&bar[XB_XCNT(j)]); sum += c; cnt += (c > 0u) ? 1u : 0u; mine = (j == x) ? c : mine; }
        if (sum == G) break;
        __builtin_amdgcn_s_sleep(1);
        if ((++sp & 255u) == 0u) { if (xb_ld(&bar[XB_TMO])) break; if (sp > XB_SPIN_CAP) { atomicAdd(&bar[XB_TMO], 1u); break; } }
    }
    nloc = mine > 0u ? mine : 1u; nx = cnt > 0u ? cnt : 1u;
}

__device__ __forceinline__ void xcd_barrier(const XcdBarrier& b) {
    asm volatile("s_waitcnt vmcnt(0)" ::: "memory");
    __syncthreads();
    if (threadIdx.x == 0) {
        unsigned* bar = b.bar;
        __builtin_amdgcn_s_waitcnt(0);
        unsigned nloc = b.st[0], nx = b.st[1];
        if (nloc == 0u) { xcd_barrier_complete(bar, b.x, nloc, nx); b.st[0] = nloc; b.st[1] = nx; }
        const unsigned old = xb_add(&bar[XB_XSUB(b.x)], 1u);
        const unsigned gen = old / nloc;
        if (old + 1u == (gen + 1u) * nloc) {
            __builtin_amdgcn_fence(__ATOMIC_RELEASE, "agent");
            asm volatile("s_waitcnt vmcnt(0)" ::: "memory");
            const unsigned og = xb_add(&bar[XB_TOP], 1u);
            const unsigned tg = og / nx;
            if (og + 1u == (tg + 1u) * nx) xb_add(&bar[XB_TOPGEN], 1u);
            else XB_SPIN(xb_ld(&bar[XB_TOPGEN]) == tg, bar);
            __builtin_amdgcn_fence(__ATOMIC_ACQUIRE, "agent");
            xb_add(&bar[XB_XGEN(b.x)], 1u);
            asm volatile("s_waitcnt vmcnt(0)" ::: "memory");
        } else {
            XB_SPIN(xb_ld(&bar[XB_XGEN(b.x)]) == gen, bar);
            __builtin_amdgcn_fence(__ATOMIC_ACQUIRE, "agent");
            asm volatile("s_waitcnt vmcnt(0)" ::: "memory");
        }
    }
    __syncthreads();
}
DEVI void transpose_item(const float* W, int N, bf16* WT, int Kt, int row_off, int k0, int n0, LAS float* scr, int lane) {
#pragma unroll 8
    for (int i = 0; i < 32; ++i) { const int kk = 2 * i + (lane >> 5); scr[kk * 33 + (lane & 31)] = W[(size_t)(k0 + kk) * N + n0 + (lane & 31)]; }
    LDS_WAIT(); asm volatile("" ::: "memory");
    const int c = lane & 7;
#pragma unroll
    for (int j = 0; j < 4; ++j) { const int n = (lane >> 3) + 8 * j; const LAS float* s = scr + (8 * c) * 33 + n;
        v4u o; o.x = pk2(s[0 * 33], s[1 * 33]); o.y = pk2(s[2 * 33], s[3 * 33]); o.z = pk2(s[4 * 33], s[5 * 33]); o.w = pk2(s[6 * 33], s[7 * 33]);
        *(v4u*)(WT + (size_t)(row_off + n0 + n) * Kt + k0 + 8 * c) = o; }
    LDS_WAIT(); asm volatile("" ::: "memory");
}
DEVI void phase0a(const Ptrs& P, const Frame& F) {
    const int gt = F.vcu * 512 + F.tid, NT = F.G * 512;
    { int* rowdest = (int*)(P.ws + WS_ROUTE + 3 * 262144); for (int i = gt; i < RPAD; i += NT) rowdest[i] = -1; }
    for (int o = gt; o < 4 * 128 * 256; o += NT) { const int g = o >> 15, c = (o >> 8) & 127, t = o & 255, ri = t >> 7, d = t & 127; float acc = 0.f;
        for (int m = 0; m < 128; ++m) { const float ang = (float)((m * c) & 127) * (2.0f / 128.0f); const float tw = ri == 0 ? cospif(ang) : -sinpif(ang); acc += tw * P.w_four[((size_t)g * 128 + m) * 128 + d]; }
        ((float*)(P.ws + WS_WC))[o] = acc * 0.08838834764831845f; }
    { LAS float* svec = (LAS float*)F.lds; LAS float* red = svec + 9 * 256;
      float* modp = (float*)(P.ws + WS_MODP);
      for (int u = F.vcu; u < 384; u += F.G) { const int cc = u % 96, kc = u / 96;
        __syncthreads();
        for (int i = F.tid; i < 9 * 256; i += 512) { const int r = i >> 8, k = kc * 256 + (i & 255); svec[i] = siluf(r < 8 ? P.c[r * DM + k] : P.c_ctx[k]); }
        __syncthreads();
        const int col = cc * 64 + F.lane; float acc[9];
#pragma unroll
        for (int r = 0; r < 9; ++r) acc[r] = 0.f;
#pragma unroll 8
        for (int i = 0; i < 32; ++i) { const int kl = F.wave * 32 + i; const float w = P.w_mod[(size_t)(kc * 256 + kl) * 6144 + col];
#pragma unroll
            for (int r = 0; r < 9; ++r) acc[r] += svec[r * 256 + kl] * w; }
#pragma unroll
        for (int r = 0; r < 9; ++r) red[(F.wave * 9 + r) * 64 + F.lane] = acc[r];
        __syncthreads();
        for (int i = F.tid; i < 576; i += 512) { float s = 0.f;
#pragma unroll
            for (int w = 0; w < 8; ++w) s += red[w * 576 + i];
            modp[((size_t)kc * 9 + (i >> 6)) * 6144 + cc * 64 + (i & 63)] = s; }
      }
      __syncthreads(); }
    { LAS float* scr = (LAS float*)(F.lds + F.wave * 16384); const int gw = F.vcu * NWAVES + F.wave, NGW = F.G * NWAVES;
      bf16* Win = (bf16*)(P.ws + WS_WIN); bf16* Wout = (bf16*)(P.ws + WS_WOUT);
      constexpr int I_IN = 16 * 97, I_OUT = 24 * 32;
      for (int it = gw; it < I_IN + I_OUT; it += NGW) {
          if (it < I_IN) { const int kb = it / 97, nb = it % 97; transpose_item(P.w_in, DPROJ, Win, DM, nb == 96 ? 1024 : 0, kb * 64, nb * 32, scr, F.lane); }
          else { const int r = it - I_IN, kb = r / 32, nb = r % 32; transpose_item(P.w_out, DM, Wout, DMIX, 0, kb * 64, nb * 32, scr, F.lane); } }
      for (int i = gt; i < (NIN - C_DT - 32) * DM / 8; i += NT) ((v4u*)(Win + (size_t)(C_DT + 32) * DM))[i] = (v4u){0u, 0u, 0u, 0u}; }
}
DEVI float modp_sum(const Ptrs& P, int r, int idx) { const float* mp = (const float*)(P.ws + WS_MODP) + (size_t)r * 6144 + idx; return P.b_mod[idx] + ((mp[0] + mp[9 * 6144]) + (mp[2 * 9 * 6144] + mp[3 * 9 * 6144])); }
DEVI void xn_row(const float* src, bf16* dst, const float* norm1, const LAS float* mrow, int lane) {
    f32x4 v[4]; float s = 0.f;
#pragma unroll
    for (int j = 0; j < 4; ++j) { v[j] = ((const f32x4*)src)[lane + 64 * j]; s += (v[j][0] * v[j][0] + v[j][1] * v[j][1]) + (v[j][2] * v[j][2] + v[j][3] * v[j][3]); }
    const float rstd = rsqrtf(wave_sum(s) * (1.f / DM) + EPS);
#pragma unroll
    for (int j = 0; j < 4; ++j) { const int c0 = (lane + 64 * j) * 4; const f32x4 nw = *(const f32x4*)(norm1 + c0); float o[4];
#pragma unroll
        for (int i = 0; i < 4; ++i) o[i] = v[j][i] * rstd * nw[i] * (1.f + mrow[1024 + c0 + i]) + mrow[c0 + i];
        uint2 w; w.x = pk2(o[0], o[1]); w.y = pk2(o[2], o[3]); *(uint2*)(dst + c0) = w; }
}
DEVI void phase0b(const Ptrs& P, const Frame& F) {
    const int gt = F.vcu * 512 + F.tid, NT = F.G * 512;
    { float* mod = (float*)(P.ws + WS_MOD); for (int i = gt; i < 9 * 6144; i += NT) mod[i] = modp_sum(P, i / 6144, i % 6144); }
    LAS float* mrow = (LAS float*)F.lds;
    for (int rb = F.vcu; rb < 256; rb += F.G) {
        __syncthreads();
        for (int i = F.tid; i < 2048; i += 512) mrow[i] = modp_sum(P, rb >> 5, i);
        __syncthreads();
        for (int r = F.wave; r < 128; r += NWAVES) { const int row = rb * 128 + r; xn_row(P.x + (size_t)row * DM, (bf16*)(P.ws + WS_XN) + (size_t)row * DM, P.norm1, mrow, F.lane); }
        __syncthreads();
        for (int i = F.tid; i < 2048; i += 512) mrow[i] = modp_sum(P, 8, i);
        __syncthreads();
        { const int row = rb * 8 + F.wave; xn_row(P.ctx + (size_t)row * DM, (bf16*)(P.ws + WS_XN) + (size_t)(TL + row) * DM, P.norm1, mrow, F.lane); }
    }
    { LAS float* wi = (LAS float*)F.lds; LAS float* wc = wi + 64 * 128; const float* Wc = (const float*)(P.ws + WS_WC); bf16* Win = (bf16*)(P.ws + WS_WIN);
      for (int u = F.vcu; u < 256; u += F.G) { const int g = u >> 6, kb = (u >> 2) & 15, jb = u & 3;
        __syncthreads();
        for (int i = F.tid; i < 64 * 128; i += 512) { const int kk = i >> 7, c = i & 127; wi[i] = P.w_in[(size_t)(kb * 64 + kk) * DPROJ + FOFF + g * 128 + c]; }
        for (int i = F.tid; i < 128 * 64; i += 512) { const int c = i >> 6, j = i & 63; wc[i] = Wc[((size_t)g * 128 + c) * 256 + jb * 64 + j]; }
        __syncthreads();
        float acc[8];
#pragma unroll
        for (int i = 0; i < 8; ++i) acc[i] = 0.f;
        for (int c = 0; c < 128; ++c) { const float wv = wc[c * 64 + F.lane];
#pragma unroll
            for (int i = 0; i < 8; ++i) acc[i] += wi[(F.wave * 8 + i) * 128 + c] * wv; }
        v4u o; o.x = pk2(acc[0], acc[1]); o.y = pk2(acc[2], acc[3]); o.z = pk2(acc[4], acc[5]); o.w = pk2(acc[6], acc[7]);
        *(v4u*)(Win + (size_t)(C_Y + g * 256 + jb * 64 + F.lane) * DM + kb * 64 + F.wave * 8) = o; }
      __syncthreads(); }
}
DEVI void phase_ssd_naive(const Ptrs& P, const Frame& F) {
    LAS float* Bs = (LAS float*)F.lds; LAS float* Cs = Bs + 128;
    for (int id = F.vcu; id < 256; id += F.G) {
    const int dir = id & 1, h = (id >> 1) & 15, b = id >> 5, p = F.tid & 63, g = h >> 2; const bool act = F.tid < 64;
    const bf16* xbc = (const bf16*)(P.ws + WS_XBC); const float* dtv = (const float*)(P.ws + WS_DTV);
    bf16* yout = (bf16*)(P.ws + (dir ? WS_YB : WS_YF));
    const float Aneg = -__expf(P.a_log[dir * 16 + h]); const float Dsk = P.d_skip[h];
    float hs[128];
#pragma unroll
    for (int n = 0; n < 128; ++n) hs[n] = 0.f;
    int ch[5]; ch[0] = h * 64 + p; ch[1] = 1024 + g * 128 + p; ch[2] = 1024 + g * 128 + 64 + p; ch[3] = 1536 + g * 128 + p; ch[4] = 1536 + g * 128 + 64 + p;
    float cw[5][5], cb[5];
#pragma unroll
    for (int i = 0; i < 5; ++i) { cb[i] = P.conv_b[ch[i]];
#pragma unroll
        for (int w = 0; w < 5; ++w) cw[i][w] = P.conv_w[w * CONVD + ch[i]]; }
    for (int seg = 0; seg < 2; ++seg) {
        const int len = seg == 0 ? CTX : SEQ; const size_t rbase = seg == 0 ? (size_t)TL + (size_t)b * CTX : (size_t)b * SEQ;
        for (int st = 0; st < len; ++st) {
            const int t = dir ? len - 1 - st : st;
            float cv[5];
#pragma unroll
            for (int i = 0; i < 5; ++i) { float a = cb[i];
#pragma unroll
                for (int w = 0; w < 5; ++w) { const int tt = t + w - 2; if (tt >= 0 && tt < len) a += bf2f(xbc[(rbase + tt) * 2048 + ch[i]]) * cw[i][w]; }
                cv[i] = siluf(a); }
            __syncthreads();
            if (act) { Bs[p] = cv[1]; Bs[64 + p] = cv[2]; Cs[p] = cv[3]; Cs[64 + p] = cv[4]; }
            __syncthreads();
            if (act) {
            const float dt = dtv[(rbase + t) * 32 + dir * 16 + h]; const float dec = __expf(dt * Aneg); const float xd = cv[0] * dt;
            float y = 0.f;
#pragma unroll
            for (int n = 0; n < 128; ++n) { hs[n] = hs[n] * dec + Bs[n] * xd; y += Cs[n] * hs[n]; }
            if (seg == 1) { if (dir == 0) y += Dsk * cv[0]; yout[(rbase + t) * 1024 + h * 64 + p] = (bf16)f2bf(y); }
            }
        }
    }
    }
}
DEVI void phase_four_naive(const Ptrs& P, const Frame& F) {
    LAS float* tab = (LAS float*)F.lds;
    for (int i = F.tid; i < 4096; i += 512) { const float a = (float)i * (2.0f / 4096.0f); tab[2 * i] = cospif(a); tab[2 * i + 1] = sinpif(a); }
    __syncthreads();
    const int d = F.tid & 127, ks = F.tid >> 7;
    for (int u = F.vcu; u < 8 * 4 * 128; u += F.G) { const int b = u >> 9, g = (u >> 7) & 3, k0 = (u & 127) * 32;
        const bf16* Y = (const bf16*)(P.ws + WS_YZ) + (size_t)b * SEQ * 1024 + g * 256 + d;
        float acc[8]; int kk[8];
#pragma unroll
        for (int i = 0; i < 8; ++i) { kk[i] = k0 + ks * 8 + i; acc[i] = 0.f; }
        for (int l = 0; l < SEQ; ++l) { const float yr = bf2f(Y[(size_t)l * 1024]), yi = bf2f(Y[(size_t)l * 1024 + 128]);
#pragma unroll
            for (int i = 0; i < 8; ++i) { const int ti = ((kk[i] * l) & 4095) * 2; acc[i] += tab[ti] * yr + tab[ti + 1] * yi; } }
        bf16* out = (bf16*)(P.ws + WS_MIX);
#pragma unroll
        for (int i = 0; i < 8; ++i) out[((size_t)b * SEQ + kk[i]) * DMIX + 1024 + g * 128 + d] = (bf16)f2bf(acc[i] * (1.f / 64.f)); }
    __syncthreads();
}
DEVI void phase_combine(const Ptrs& P, const Frame& F) {
    const int gw = F.vcu * NWAVES + F.wave, NGW = F.G * NWAVES, lane = F.lane;
    for (int row = gw; row < TL; row += NGW) {
        const bf16* yf = (const bf16*)(P.ws + WS_YF) + (size_t)row * 1024; const bf16* yb = (const bf16*)(P.ws + WS_YB) + (size_t)row * 1024; const bf16* zs = (const bf16*)(P.ws + WS_ZS) + (size_t)row * 1024;
        float v[16]; float s = 0.f;
#pragma unroll
        for (int j = 0; j < 2; ++j) { const int c0 = (lane + 64 * j) * 8; const v4u a = *(const v4u*)(yf + c0), bb = *(const v4u*)(yb + c0), z = *(const v4u*)(zs + c0);
#pragma unroll
            for (int i = 0; i < 4; ++i) { const float y0 = (__uint_as_float(a[i] << 16) + __uint_as_float(bb[i] << 16)) * __uint_as_float(z[i] << 16);
                const float y1 = (__uint_as_float(a[i] & 0xffff0000u) + __uint_as_float(bb[i] & 0xffff0000u)) * __uint_as_float(z[i] & 0xffff0000u);
                v[j * 8 + 2 * i] = y0; v[j * 8 + 2 * i + 1] = y1; s += y0 * y0 + y1 * y1; } }
        const float rstd = rsqrtf(wave_sum(s) * (1.f / 1024.f) + EPS);
        bf16* dst = (bf16*)(P.ws + WS_MIX) + (size_t)row * DMIX;
#pragma unroll
        for (int j = 0; j < 2; ++j) { const int c0 = (lane + 64 * j) * 8; const f32x4 n0 = *(const f32x4*)(P.ssd_norm + c0), n1 = *(const f32x4*)(P.ssd_norm + c0 + 4);
            v4u o; o.x = pk2(v[j * 8 + 0] * rstd * n0[0], v[j * 8 + 1] * rstd * n0[1]); o.y = pk2(v[j * 8 + 2] * rstd * n0[2], v[j * 8 + 3] * rstd * n0[3]);
            o.z = pk2(v[j * 8 + 4] * rstd * n1[0], v[j * 8 + 5] * rstd * n1[1]); o.w = pk2(v[j * 8 + 6] * rstd * n1[2], v[j * 8 + 7] * rstd * n1[3]);
            *(v4u*)(dst + c0) = o; }
    }
}
DEVI void phase_expert_weights(const Ptrs& P, const Frame& F) {
    LAS float* scr = (LAS float*)(F.lds + F.wave * 16384); const int gw = F.vcu * NWAVES + F.wave, NGW = F.G * NWAVES;
    bf16* Wup = (bf16*)(P.ws + WS_WUP); bf16* Wdn = (bf16*)(P.ws + WS_WDN);
    constexpr int I_UP = 32 * 2 * 256, I_DN = 32 * 256;
    for (int it = gw; it < I_UP + I_DN; it += NGW) {
        if (it < I_UP) { const int e = it >> 9, half = (it >> 8) & 1, r = it & 255, kb = r >> 4, nb = r & 15, n0 = nb * 32;
            const float* W = (half ? P.w_eu : P.w_eg) + (size_t)e * DM * DE;
            transpose_item(W, DE, Wup, DM, e * 1024 + (n0 >> 7) * 256 + half * 128 + (n0 & 127) - n0, kb * 64, n0, scr, F.lane); }
        else { const int r2 = it - I_UP, e = r2 >> 8, r = r2 & 255, kb = r >> 5, nb = r & 31;
            transpose_item(P.w_ed + (size_t)e * DE * DM, DM, Wdn, DE, e * 1024, kb * 64, nb * 32, scr, F.lane); } }
}
DEVI void phase_route(const Ptrs& P, const Frame& F) {
    const int gw = F.vcu * NWAVES + F.wave, NGW = F.G * NWAVES, lane = F.lane;
    LAS unsigned* lcnt = (LAS unsigned*)(F.lds + LDSCTL_OFF + LC_CNT);
    if (F.tid < 64) lcnt[F.tid] = 0u;
    __syncthreads();
    int* eid = (int*)(P.ws + WS_ROUTE); int* pos = eid + 65536; float* gate = (float*)(pos + 65536);
    const float* modall = (const float*)(P.ws + WS_MOD);
    for (int row = gw; row < TL; row += NGW) {
        const float* src = P.out + (size_t)row * DM; const float* mod = modall + (row / SEQ) * 6144;
        f32x4 v[4]; float s = 0.f;
#pragma unroll
        for (int j = 0; j < 4; ++j) { v[j] = ((const f32x4*)src)[lane + 64 * j]; s += (v[j][0] * v[j][0] + v[j][1] * v[j][1]) + (v[j][2] * v[j][2] + v[j][3] * v[j][3]); }
        const float rstd = rsqrtf(wave_sum(s) * (1.f / DM) + EPS);
        float t[16]; bf16* dst = (bf16*)(P.ws + WS_H2) + (size_t)row * DM;
#pragma unroll
        for (int j = 0; j < 4; ++j) { const int c0 = (lane + 64 * j) * 4; const f32x4 nw = *(const f32x4*)(P.norm2 + c0), sh = *(const f32x4*)(mod + 3072 + c0), sc = *(const f32x4*)(mod + 4096 + c0);
#pragma unroll
            for (int i = 0; i < 4; ++i) t[j * 4 + i] = v[j][i] * rstd * nw[i] * (1.f + sc[i]) + sh[i];
            uint2 w; w.x = pk2(t[j * 4], t[j * 4 + 1]); w.y = pk2(t[j * 4 + 2], t[j * 4 + 3]); *(uint2*)(dst + c0) = w; }
        float lg[4] = {0.f, 0.f, 0.f, 0.f};
#pragma unroll
        for (int j = 0; j < 4; ++j)
#pragma unroll
            for (int i = 0; i < 4; ++i) { const f32x4 w = *(const f32x4*)(P.w_rg + (size_t)((lane + 64 * j) * 4 + i) * 4);
#pragma unroll
                for (int q = 0; q < 4; ++q) lg[q] += t[j * 4 + i] * w[q]; }
#pragma unroll
        for (int q = 0; q < 4; ++q) lg[q] = wave_sum(lg[q]) + P.b_rg[q];
        int grp = 0; float mx = lg[0];
#pragma unroll
        for (int q = 1; q < 4; ++q) if (lg[q] > mx) { mx = lg[q]; grp = q; }
        float den = 0.f;
#pragma unroll
        for (int q = 0; q < 4; ++q) den += __expf(lg[q] - mx);
        const float pgrp = 1.f / den;
        float le[8] = {0.f, 0.f, 0.f, 0.f, 0.f, 0.f, 0.f, 0.f};
#pragma unroll
        for (int j = 0; j < 4; ++j)
#pragma unroll
            for (int i = 0; i < 4; ++i) { const float* wp = P.w_re + ((size_t)grp * DM + (lane + 64 * j) * 4 + i) * 8; const f32x4 w0 = *(const f32x4*)wp, w1 = *(const f32x4*)(wp + 4);
#pragma unroll
                for (int q = 0; q < 4; ++q) { le[q] += t[j * 4 + i] * w0[q]; le[4 + q] += t[j * 4 + i] * w1[q]; } }
#pragma unroll
        for (int q = 0; q < 8; ++q) le[q] = wave_sum(le[q]) + P.b_re[grp * 8 + q];
        int j0 = 0; float m0 = le[0];
#pragma unroll
        for (int q = 1; q < 8; ++q) if (le[q] > m0) { m0 = le[q]; j0 = q; }
        int j1 = 0; float m1 = -3.0e38f;
#pragma unroll
        for (int q = 0; q < 8; ++q) if (q != j0 && le[q] > m1) { m1 = le[q]; j1 = q; }
        const float e1 = __expf(m1 - m0);
        if (lane == 0) { const int ea = grp * 8 + j0, eb = grp * 8 + j1;
            eid[row * 2] = ea; eid[row * 2 + 1] = eb; gate[row * 2] = pgrp / (1.f + e1); gate[row * 2 + 1] = pgrp * e1 / (1.f + e1);
            const int it = (row - gw) / NGW; LAS int* rt = (LAS int*)(F.lds + LDSCTL_OFF + LC_RT) + (F.wave * 16 + (it & 15)) * 4;
            rt[0] = ea; rt[1] = eb; rt[2] = (int)__hip_atomic_fetch_add(&lcnt[ea], 1u, __ATOMIC_RELAXED, __HIP_MEMORY_SCOPE_WORKGROUP); rt[3] = (int)__hip_atomic_fetch_add(&lcnt[eb], 1u, __ATOMIC_RELAXED, __HIP_MEMORY_SCOPE_WORKGROUP); }
    }
    __syncthreads();
    if (F.tid < 32) lcnt[32 + F.tid] = __hip_atomic_fetch_add((unsigned*)(P.ws + WS_CTL) + CW_CNT + F.tid, lcnt[F.tid], RLX_AGENT);
    __syncthreads();
    for (int row = gw; row < TL; row += NGW) if (lane < 2) { const int it = (row - gw) / NGW; const LAS int* rt = (const LAS int*)(F.lds + LDSCTL_OFF + LC_RT) + (F.wave * 16 + (it & 15)) * 4;
        pos[row * 2 + lane] = rt[2 + lane] + (int)lcnt[32 + rt[lane]]; }
    __syncthreads();
}
DEVI int build_tile_table(const Ptrs& P, const Frame& F) {
    LAS int* tile_e = (LAS int*)(F.lds + LDSCTL_OFF + LC_TILE); LAS unsigned* lcnt = (LAS unsigned*)(F.lds + LDSCTL_OFF + LC_CNT);
    __syncthreads();
    if (F.tid < 32) lcnt[F.tid] = __hip_atomic_load((unsigned*)(P.ws + WS_CTL) + CW_CNT + F.tid, RLX_AGENT);
    __syncthreads();
    if (F.tid == 0) { int s = 0; for (int e = 0; e < NE; ++e) { const int nt = (int)((lcnt[e] + 255u) >> 8); lcnt[64 + e] = (unsigned)(s * 256); for (int i = 0; i < nt; ++i) tile_e[s + i] = e; s += nt; } lcnt[96] = (unsigned)s; }
    __syncthreads();
    return (int)lcnt[96];
}
DEVI void phase_gather(const Ptrs& P, const Frame& F) {
    build_tile_table(P, F);
    const LAS unsigned* lcnt = (const LAS unsigned*)(F.lds + LDSCTL_OFF + LC_CNT);
    const int gw = F.vcu * NWAVES + F.wave, NGW = F.G * NWAVES, lane = F.lane;
    const int* eid = (const int*)(P.ws + WS_ROUTE); const int* pos = eid + 65536; const float* gate = (const float*)(pos + 65536);
    int* rowdest = (int*)(P.ws + WS_ROUTE + 3 * 262144); float* rowgate = (float*)(rowdest + RPAD);
    for (int a = gw; a < 65536; a += NGW) {
        const int row = (int)lcnt[64 + eid[a]] + pos[a];
        const v4u* src = (const v4u*)((const bf16*)(P.ws + WS_H2) + (size_t)(a >> 1) * DM); v4u* dst = (v4u*)((bf16*)(P.ws + WS_HPERM) + (size_t)row * DM);
        dst[lane] = src[lane]; dst[lane + 64] = src[lane + 64];
        if (lane == 0) { rowdest[row] = a; rowgate[row] = gate[a]; }
    }
}
DEVI void phase_final(const Ptrs& P, const Frame& F) {
    const int gw = F.vcu * NWAVES + F.wave, NGW = F.G * NWAVES, lane = F.lane;
    for (int row = gw; row < TL; row += NGW) {
        float* xr = P.out + (size_t)row * DM; const float* g2 = (const float*)(P.ws + WS_MOD) + (row / SEQ) * 6144 + 5120;
        const bf16* y0 = (const bf16*)(P.ws + WS_YBUF) + (size_t)row * 2 * DM; const bf16* y1 = y0 + DM;
        float v[16]; float s = 0.f;
#pragma unroll
        for (int j = 0; j < 4; ++j) { const int c0 = (lane + 64 * j) * 4; const f32x4 xv = *(const f32x4*)(xr + c0), gv = *(const f32x4*)(g2 + c0); const uint2 a = *(const uint2*)(y0 + c0), b = *(const uint2*)(y1 + c0);
            const float ya[4] = {__uint_as_float(a.x << 16), __uint_as_float(a.x & 0xffff0000u), __uint_as_float(a.y << 16), __uint_as_float(a.y & 0xffff0000u)};
            const float yb[4] = {__uint_as_float(b.x << 16), __uint_as_float(b.x & 0xffff0000u), __uint_as_float(b.y << 16), __uint_as_float(b.y & 0xffff0000u)};
#pragma unroll
            for (int i = 0; i < 4; ++i) { const float o = xv[i] + gv[i] * (ya[i] + yb[i]); v[j * 4 + i] = o; s += o * o; } }
        const float rstd = rsqrtf(wave_sum(s) * (1.f / DM) + EPS);
#pragma unroll
        for (int j = 0; j < 4; ++j) { const int c0 = (lane + 64 * j) * 4; const f32x4 fn = *(const f32x4*)(P.final_norm + c0); f32x4 o;
#pragma unroll
            for (int i = 0; i < 4; ++i) o[i] = v[j * 4 + i] * rstd * fn[i];
            *(f32x4*)(xr + c0) = o; }
    }
}
typedef short s16x4_t __attribute__((ext_vector_type(4)));
constexpr int S_BS = 0, S_BT = 32768, S_CS = 65536, S_XT = 98304, S_HB = 114688, S_YS = 131072, S_YS_W = 2304, S_SM = S_YS + 8 * S_YS_W;
static_assert(S_SM + 1536 <= LDSCTL_OFF, "ssd LDS map");
DEVI int ssd_sw(int row, int colbyte) { return row * 256 + (colbyte ^ ((row & 15) << 4)); }
DEVI bf16x8 ssd_frag(const LAS unsigned char* tile, int row, int ks, int q) { return *(const LAS bf16x8*)(tile + ssd_sw(row, 64 * ks + 16 * q)); }
DEVI float fast_exp(float x) { return __expf(x); }
DEVI void phase_ssd(const Ptrs& P, const Frame& F) {
    LAS unsigned char* L = F.lds;
    LAS float* acs = (LAS float*)(L + S_SM); LAS float* dtj = acs + 128; LAS float* wj = acs + 256;
    const int lane = F.lane, w = F.wave, c = lane & 15, q = lane >> 4;
    const bf16* xbc = (const bf16*)(P.ws + WS_XBC); const float* dtv = (const float*)(P.ws + WS_DTV);
    for (int id = F.vcu; id < 256; id += F.G) {
    const int dir = id & 1, h = (id >> 1) & 15, b = id >> 5, g = h >> 2;
    bf16* yout = (bf16*)(P.ws + (dir ? WS_YB : WS_YF));
    const float Aneg = -__expf(P.a_log[dir * 16 + h]); const float Dsk = dir == 0 ? P.d_skip[h] : 0.f;
    const int jt = (w < 4) ? 2 * w : 15 - 2 * w;
    f32x4 acc_h[4];
#pragma unroll
    for (int pt = 0; pt < 4; ++pt) acc_h[pt] = (f32x4){0.f, 0.f, 0.f, 0.f};
    __syncthreads();
    for (int stp = 0; stp < 34; ++stp) {
        const bool isx = stp >= 2; const int len = isx ? SEQ : CTX; const size_t rbase = isx ? (size_t)b * SEQ : (size_t)TL + (size_t)b * CTX;
        const int ci = isx ? (dir ? 31 - (stp - 2) : stp - 2) : (dir ? 1 - stp : stp); const int t0 = ci * 128;
        float a_tot;
        { const int tA = t0 + (dir ? 127 - lane : lane), tB = t0 + (dir ? 63 - lane : 64 + lane);
          const float dA = dtv[(rbase + tA) * 32 + dir * 16 + h], dB = dtv[(rbase + tB) * 32 + dir * 16 + h];
          float sA = dA * Aneg, sB = dB * Aneg;
#pragma unroll
          for (int o = 1; o < 64; o <<= 1) { const float uA = __shfl_up(sA, o), uB = __shfl_up(sB, o); if (lane >= o) { sA += uA; sB += uB; } }
          sB += __shfl(sA, 63); a_tot = __shfl(sB, 63);
          acs[lane] = sA; acs[64 + lane] = sB; dtj[lane] = dA; dtj[64 + lane] = dB; wj[lane] = fast_exp(a_tot - sA); wj[64 + lane] = fast_exp(a_tot - sB); }
        LDS_WAIT(); asm volatile("" ::: "memory");
#pragma unroll 1
        for (int i5 = 0; i5 < 5; ++i5) {
            const int kind = i5 < 2 ? 0 : (i5 < 4 ? 1 : 2);
            const int tg = kind == 2 ? 2 * w + (lane >> 5) : (w + 8 * (i5 & 1));
            if (kind == 1 && !isx) continue;
            const int chn = kind == 0 ? 1024 + g * 128 + 2 * lane : (kind == 1 ? 1536 + g * 128 + 2 * lane : h * 64 + 2 * (lane & 31));
            const int tok0 = t0 + 8 * tg - 2; const bf16* src = xbc + (rbase + tok0) * 2048 + chn;
            unsigned raw[12];
#pragma unroll
            for (int i = 0; i < 12; ++i) { const int tk = tok0 + i; raw[i] = (tk >= 0 && tk < len) ? *(const unsigned*)(src + (size_t)i * 2048) : 0u; }
            float cw[5][2], cb[2];
            { const float2 bb = *(const float2*)(P.conv_b + chn); cb[0] = bb.x; cb[1] = bb.y;
#pragma unroll
              for (int t = 0; t < 5; ++t) { const float2 ww = *(const float2*)(P.conv_w + t * CONVD + chn); cw[t][0] = ww.x; cw[t][1] = ww.y; } }
            float v[8][2];
#pragma unroll
            for (int o = 0; o < 8; ++o) { float a0 = cb[0], a1 = cb[1];
#pragma unroll
                for (int t = 0; t < 5; ++t) { a0 += __uint_as_float(raw[o + t] << 16) * cw[t][0]; a1 += __uint_as_float(raw[o + t] & 0xffff0000u) * cw[t][1]; }
                v[o][0] = a0 * __builtin_amdgcn_rcpf(1.f + __expf(-a0)); v[o][1] = a1 * __builtin_amdgcn_rcpf(1.f + __expf(-a1)); }
            const int jg = dir ? 15 - tg : tg;
            if (kind < 2) { LAS unsigned char* rm = L + (kind == 0 ? S_BS : S_CS);
#pragma unroll
                for (int o = 0; o < 8; ++o) { const int j = dir ? 127 - (8 * tg + o) : 8 * tg + o; *(LAS unsigned*)(rm + ssd_sw(j, 4 * lane)) = pk2(v[o][0], v[o][1]); } }
            if (kind != 1) { const f32x4 s0 = *(const LAS f32x4*)((kind == 0 ? wj : dtj) + 8 * jg), s1 = *(const LAS f32x4*)((kind == 0 ? wj : dtj) + 8 * jg + 4);
                const float sc[8] = {s0[0], s0[1], s0[2], s0[3], s1[0], s1[1], s1[2], s1[3]};
                LAS unsigned char* tt = L + (kind == 0 ? S_BT : S_XT); const int r0 = kind == 0 ? 2 * lane : 2 * (lane & 31);
#pragma unroll
                for (int cc = 0; cc < 2; ++cc) { float e[8];
#pragma unroll
                    for (int ee = 0; ee < 8; ++ee) e[ee] = v[dir ? 7 - ee : ee][cc] * sc[ee];
                    v4u o4; o4.x = pk2(e[0], e[1]); o4.y = pk2(e[2], e[3]); o4.z = pk2(e[4], e[5]); o4.w = pk2(e[6], e[7]);
                    *(LAS v4u*)(tt + ssd_sw(r0 + cc, 16 * jg)) = o4; } }
        }
        __syncthreads();
        const float e_tot = fast_exp(a_tot);
        if (isx) {
            bf16x8 cf[4];
#pragma unroll
            for (int ks = 0; ks < 4; ++ks) cf[ks] = ssd_frag(L + S_CS, 16 * jt + c, ks, q);
            f32x4 acc_o[4], acc_y[4];
#pragma unroll
            for (int pt = 0; pt < 4; ++pt) { acc_o[pt] = (f32x4){0.f, 0.f, 0.f, 0.f}; acc_y[pt] = (f32x4){0.f, 0.f, 0.f, 0.f}; }
#pragma unroll
            for (int ks = 0; ks < 4; ++ks)
#pragma unroll
                for (int pt = 0; pt < 4; ++pt) acc_o[pt] = __builtin_amdgcn_mfma_f32_16x16x32_bf16(cf[ks], ssd_frag(L + S_HB, 16 * pt + c, ks, q), acc_o[pt], 0, 0, 0);
            const float acs_j = acs[16 * jt + c]; const float dsk_j = Dsk * __builtin_amdgcn_rcpf(dtj[16 * jt + c]);
            const int npair = (jt >> 1) + 1;
            for (int t = 0; t < npair; ++t) {
                f32x4 X0 = (f32x4){0.f, 0.f, 0.f, 0.f}, X1 = (f32x4){0.f, 0.f, 0.f, 0.f};
                const int st0 = 2 * t, st1 = 2 * t + 1; const bool has1 = st1 <= jt;
#pragma unroll
                for (int ks = 0; ks < 4; ++ks) X0 = __builtin_amdgcn_mfma_f32_16x16x32_bf16(ssd_frag(L + S_BS, 16 * st0 + c, ks, q), cf[ks], X0, 0, 0, 0);
                if (has1) {
#pragma unroll
                    for (int ks = 0; ks < 4; ++ks) X1 = __builtin_amdgcn_mfma_f32_16x16x32_bf16(ssd_frag(L + S_BS, 16 * st1 + c, ks, q), cf[ks], X1, 0, 0, 0); }
                const f32x4 as0 = *(const LAS f32x4*)(acs + 16 * st0 + 4 * q), as1 = *(const LAS f32x4*)(acs + 16 * (has1 ? st1 : st0) + 4 * q);
#pragma unroll
                for (int r = 0; r < 4; ++r) { const int sl = 4 * q + r;
                    float d0 = fast_exp(fminf(acs_j - as0[r], 0.f)), d1 = fast_exp(fminf(acs_j - as1[r], 0.f));
                    float x0 = X0[r] * d0, x1 = X1[r] * d1;
                    if (st0 == jt) { x0 = sl < c ? x0 : (sl == c ? x0 + dsk_j : 0.f); }
                    if (st1 == jt) { x1 = sl < c ? x1 : (sl == c ? x1 + dsk_j : 0.f); }
                    if (!has1) x1 = 0.f;
                    X0[r] = x0; X1[r] = x1; }
                bf16x8 af; { const unsigned a0 = pk2(X0[0], X0[1]), a1 = pk2(X0[2], X0[3]), a2 = pk2(X1[0], X1[1]), a3 = pk2(X1[2], X1[3]);
                    af = (bf16x8){(short)(a0 & 0xffff), (short)(a0 >> 16), (short)(a1 & 0xffff), (short)(a1 >> 16), (short)(a2 & 0xffff), (short)(a2 >> 16), (short)(a3 & 0xffff), (short)(a3 >> 16)}; }
#pragma unroll
                for (int pt = 0; pt < 4; ++pt) { const int p = 16 * pt + c;
                    const s16x4_t b0 = *(const LAS s16x4_t*)(L + S_XT + ssd_sw(p, 64 * t + 8 * q)), b1 = *(const LAS s16x4_t*)(L + S_XT + ssd_sw(p, 64 * t + 32 + 8 * q));
                    const bf16x8 bfr = (bf16x8){b0[0], b0[1], b0[2], b0[3], b1[0], b1[1], b1[2], b1[3]};
                    acc_y[pt] = __builtin_amdgcn_mfma_f32_16x16x32_bf16(af, bfr, acc_y[pt], 0, 0, 0); }
            }
            { const f32x4 aj = *(const LAS f32x4*)(acs + 16 * jt + 4 * q); LAS unsigned char* ys = L + S_YS + w * S_YS_W;
#pragma unroll
              for (int r = 0; r < 4; ++r) { const float ej = fast_exp(aj[r]);
#pragma unroll
                for (int pt = 0; pt < 4; ++pt) *(LAS bf16*)(ys + (4 * q + r) * 144 + (16 * pt + c) * 2) = (bf16)f2bf(acc_y[pt][r] + ej * acc_o[pt][r]); }
              LDS_WAIT(); asm volatile("" ::: "memory");
              const int row = lane >> 2, cbk = (lane & 3) * 32; const v4u o0 = *(const LAS v4u*)(ys + row * 144 + cbk), o1 = *(const LAS v4u*)(ys + row * 144 + cbk + 16);
              const int j = 16 * jt + row; const int tk = t0 + (dir ? 127 - j : j);
              bf16* dst = yout + (rbase + tk) * 1024 + h * 64 + (lane & 3) * 16; *(v4u*)dst = o0; *(v4u*)(dst + 8) = o1; }
        }
#pragma unroll
        for (int pt = 0; pt < 4; ++pt) acc_h[pt] = acc_h[pt] * e_tot;
#pragma unroll
        for (int ks = 0; ks < 4; ++ks) { const bf16x8 af = ssd_frag(L + S_BT, 16 * w + c, ks, q);
#pragma unroll
            for (int pt = 0; pt < 4; ++pt) acc_h[pt] = __builtin_amdgcn_mfma_f32_16x16x32_bf16(af, ssd_frag(L + S_XT, 16 * pt + c, ks, q), acc_h[pt], 0, 0, 0); }
        __syncthreads();
#pragma unroll
        for (int pt = 0; pt < 4; ++pt) { u32x2 hv; hv.x = pk2(acc_h[pt][0], acc_h[pt][1]); hv.y = pk2(acc_h[pt][2], acc_h[pt][3]); *(LAS u32x2*)(L + S_HB + ssd_sw(16 * pt + c, 32 * w + 8 * q)) = hv; }
    }
    __syncthreads();
    }
}
constexpr size_t WS_T1 = 1 * MiB + 512 * 1024;
constexpr int FT_ROWB = 288, FT_TILE = 128 * FT_ROWB;
DEVI int four_rho(int k) { const int kk = k >> 5, gq = (k >> 3) & 3, jj = k & 7; return 32 * kk + 16 * (jj >> 2) + 4 * gq + (jj & 3); }
DEVI void phase_four_tables(const Ptrs& P, const Frame& F) {
    const int gt = F.vcu * 512 + F.tid, NT = F.G * 512;
    bf16* T1 = (bf16*)(P.ws + WS_T1); bf16* T3 = T1 + 128 * 128;
    for (int o = gt; o < 128 * 128 + 64 * 128; o += NT) {
        if (o < 128 * 128) { const int i = o >> 7, k = o & 127, rho = four_rho(k), ro = i >> 6, k1 = i & 63, ri = rho >> 6, l1 = rho & 63;
            const float ang = (float)((k1 * l1) & 63) * (2.0f / 64.0f), c = cospif(ang), s = sinpif(ang);
            const float v = ro == 0 ? (ri == 0 ? c : s) : (ri == 0 ? -s : c); T1[o] = (bf16)f2bf(v * 0.125f); }
        else { const int o2 = o - 128 * 128, k2 = o2 >> 7, k = o2 & 127, rho = four_rho(k), ri = rho >> 6, l2 = rho & 63;
            const float ang = (float)((k2 * l2) & 63) * (2.0f / 64.0f); T3[o2] = (bf16)f2bf((ri == 0 ? cospif(ang) : sinpif(ang)) * 0.125f); }
    }
}
DEVI void four_load_T(const bf16* T, int rows, LAS unsigned char* dst, int tid) {
    for (int cid = tid; cid < rows * 16; cid += 512) { const int r = cid >> 4, ch = cid & 15; *(LAS v4u*)(dst + r * 256 + ((ch ^ (r & 15)) << 4)) = *(const v4u*)(T + r * 128 + ch * 8); }
}
DEVI bf16x8 four_Afrag(const LAS unsigned char* T, int it, int ks, int lane) { const int r = 16 * it + (lane & 15), ch = 4 * ks + (lane >> 4); return *(const LAS bf16x8*)(T + r * 256 + ((ch ^ (r & 15)) << 4)); }
DEVI bf16x8 four_Bfrag(const LAS unsigned char* tile, int dt, int ks, int lane) {
    const int gq = lane >> 4, qq = (lane & 15) >> 2, pp = lane & 3;
    const LAS unsigned char* p = tile + (32 * ks + 4 * gq + qq) * FT_ROWB + (16 * dt + 4 * pp) * 2;
    const s16x4 a = __builtin_amdgcn_ds_read_tr16_b64_v4i16((LAS s16x4*)p), b = __builtin_amdgcn_ds_read_tr16_b64_v4i16((LAS s16x4*)(p + 16 * FT_ROWB));
    return (bf16x8){a[0], a[1], a[2], a[3], b[0], b[1], b[2], b[3]};
}
DEVI void phase_four1(const Ptrs& P, const Frame& F) {
    LAS unsigned char* T = F.lds; LAS unsigned char* buf0 = F.lds + 32768;
    __syncthreads();
    four_load_T((const bf16*)(P.ws + WS_T1), 128, T, F.tid);
    const bf16* Yz = (const bf16*)(P.ws + WS_YZ); bf16* AP = (bf16*)(P.ws + WS_AP);
    const int w = F.wave, lane = F.lane, c = lane & 15, q = lane >> 4;
    v4u st[4];
    auto issue = [&](int u) { const int g = u & 3, l2 = (u >> 2) & 63, b = u >> 8;
#pragma unroll
        for (int i = 0; i < 4; ++i) { const int cid = F.tid + 512 * i, rho = cid >> 4, ch = cid & 15, ri = rho >> 6, l1 = rho & 63;
            st[i] = *(const v4u*)(Yz + ((size_t)b * SEQ + 64 * l1 + l2) * 1024 + g * 256 + ri * 128 + ch * 8); } };
    auto commit = [&](LAS unsigned char* buf) {
#pragma unroll
        for (int i = 0; i < 4; ++i) { const int cid = F.tid + 512 * i, rho = cid >> 4, ch = cid & 15; *(LAS v4u*)(buf + rho * FT_ROWB + ch * 16) = st[i]; } };
    int u = F.vcu; int par = 0;
    if (u < 2048) { issue(u); commit(buf0); }
    __syncthreads();
    for (; u < 2048; u += F.G, par ^= 1) {
        const int un = u + F.G; if (un < 2048) issue(un);
        const LAS unsigned char* tile = buf0 + par * FT_TILE; const int g = u & 3, l2 = (u >> 2) & 63, b = u >> 8;
        f32x4 acc[8];
#pragma unroll
        for (int it = 0; it < 8; ++it) acc[it] = (f32x4){0.f, 0.f, 0.f, 0.f};
#pragma unroll
        for (int ks = 0; ks < 4; ++ks) { const bf16x8 bf = four_Bfrag(tile, w, ks, lane);
#pragma unroll
            for (int it = 0; it < 8; ++it) acc[it] = __builtin_amdgcn_mfma_f32_16x16x32_bf16(four_Afrag(T, it, ks, lane), bf, acc[it], 0, 0, 0); }
#pragma unroll
        for (int it = 0; it < 4; ++it)
#pragma unroll
            for (int r = 0; r < 4; ++r) { const int k1 = 16 * it + 4 * q + r; const float ang = (float)((l2 * k1) & 4095) * (1.0f / 4096.0f);
                const float ct = __builtin_amdgcn_cosf(ang), sn = __builtin_amdgcn_sinf(ang); const float ar = acc[it][r], ai = acc[it + 4][r];
                bf16* dst = AP + (((((size_t)b * 4 + g) * 64 + k1) * 2) * 64 + l2) * 128 + 16 * w + c;
                dst[0] = (bf16)f2bf(ar * ct + ai * sn); dst[64 * 128] = (bf16)f2bf(ai * ct - ar * sn); }
        if (un < 2048) commit(buf0 + (par ^ 1) * FT_TILE);
        __syncthreads();
    }
}
DEVI void phase_four3(const Ptrs& P, const Frame& F) {
    LAS unsigned char* T = F.lds; LAS unsigned char* buf0 = F.lds + 32768;
    __syncthreads();
    four_load_T((const bf16*)(P.ws + WS_T1) + 128 * 128, 64, T, F.tid);
    const bf16* AP = (const bf16*)(P.ws + WS_AP); bf16* mix = (bf16*)(P.ws + WS_MIX);
    const int w = F.wave, lane = F.lane, c = lane & 15, q = lane >> 4;
    v4u st[4];
    auto issue = [&](int u) { const int g = u & 3, k1 = (u >> 2) & 63, b = u >> 8; const bf16* src = AP + ((((size_t)b * 4 + g) * 64 + k1) * 128) * 128;
#pragma unroll
        for (int i = 0; i < 4; ++i) st[i] = *(const v4u*)(src + (size_t)(F.tid + 512 * i) * 8); };
    auto commit = [&](LAS unsigned char* buf) {
#pragma unroll
        for (int i = 0; i < 4; ++i) { const int cid = F.tid + 512 * i, rho = cid >> 4, ch = cid & 15; *(LAS v4u*)(buf + rho * FT_ROWB + ch * 16) = st[i]; } };
    int u = F.vcu; int par = 0;
    if (u < 2048) { issue(u); commit(buf0); }
    __syncthreads();
    for (; u < 2048; u += F.G, par ^= 1) {
        const int un = u + F.G; if (un < 2048) issue(un);
        const LAS unsigned char* tile = buf0 + par * FT_TILE; const int g = u & 3, k1 = (u >> 2) & 63, b = u >> 8;
        f32x4 acc[4];
#pragma unroll
        for (int it = 0; it < 4; ++it) acc[it] = (f32x4){0.f, 0.f, 0.f, 0.f};
#pragma unroll
        for (int ks = 0; ks < 4; ++ks) { const bf16x8 bf = four_Bfrag(tile, w, ks, lane);
#pragma unroll
            for (int it = 0; it < 4; ++it) acc[it] = __builtin_amdgcn_mfma_f32_16x16x32_bf16(four_Afrag(T, it, ks, lane), bf, acc[it], 0, 0, 0); }
#pragma unroll
        for (int it = 0; it < 4; ++it)
#pragma unroll
            for (int r = 0; r < 4; ++r) { const int k2 = 16 * it + 4 * q + r; mix[((size_t)b * SEQ + k1 + 64 * k2) * DMIX + 1024 + g * 128 + 16 * w + c] = (bf16)f2bf(acc[it][r]); }
        if (un < 2048) commit(buf0 + (par ^ 1) * FT_TILE);
        __syncthreads();
    }
}
#ifndef MK_N_LAUNCHES
#define MK_N_LAUNCHES 1
#endif
constexpr int NPHASE = 10;
struct Args { Ptrs P; int ph_lo, ph_hi; };
__global__ void __launch_bounds__(NWAVES * 64, 2) fwd_megakernel(Args args) {
    extern __shared__ __attribute__((aligned(16))) unsigned char lds_raw[];
    Frame F; F.lds = (LAS unsigned char*)lds_raw;
    F.tid = threadIdx.x; F.lane = F.tid & 63; F.wave = __builtin_amdgcn_readfirstlane(F.tid >> 6);
    F.G = gridDim.x; { const int bx = blockIdx.x; F.vcu = (F.G % 8 == 0) ? (bx % 8) * (F.G / 8) + bx / 8 : bx; }
    const Ptrs& P = args.P;
    for (int u = F.tid; u < (LDS_BYTES - LDSCTL_OFF) / 4; u += NWAVES * 64) ((LAS unsigned*)(F.lds + LDSCTL_OFF))[u] = 0u;
    __syncthreads();
    XcdBarrier bar; bar.bar = (unsigned*)(P.ws + WS_CTL) + CW_BAR; bar.x = 0; bar.st = nullptr;
    const bool one = (args.ph_hi - args.ph_lo) > 1;
    if (one) bar = xcd_barrier_post((unsigned*)(P.ws + WS_CTL) + CW_BAR, (volatile LAS unsigned*)(F.lds + LDSCTL_OFF + LC_MISC) + 8);
    const int lo = args.ph_lo, hi = args.ph_hi;
#define IN(k) (lo <= (k) && (k) < hi)
#define SEAM(k) do { if (IN(k) && IN((k) + 1)) xcd_barrier(bar); } while (0)
    if (IN(0)) { phase0a(P, F); phase_four_tables(P, F); } SEAM(0);
    if (IN(1)) { phase0b(P, F); } SEAM(1);
    if (IN(2)) {
        pg8::Gemm g{(const bf16*)(P.ws + WS_XN), (const bf16*)(P.ws + WS_WIN), TA, NIN, DM}; pg8::InProjOrder S{F.G, (int)blockIdx.x};
        pg8::EpiInProj E{(bf16*)(P.ws + WS_ZS), (bf16*)(P.ws + WS_XBC), (bf16*)(P.ws + WS_YZ), (float*)(P.ws + WS_DTV), P.dt_bias};
        pg8::gemm_phase<pg8::EpiInProj, pg8::InProjOrder, true, true>(F.lds, g, S, E);
    } SEAM(2);
    if (IN(3)) { phase_ssd(P, F); phase_four1(P, F); } SEAM(3);
    if (IN(4)) { phase_four3(P, F); phase_combine(P, F); } SEAM(4);
    if (IN(5)) {
        pg8::Gemm g{(const bf16*)(P.ws + WS_MIX), (const bf16*)(P.ws + WS_WOUT), TL, DM, DMIX}; pg8::StaticOrder S; S.init(TL, DM, F.G, (int)blockIdx.x);
        pg8::EpiOutProj E{P.x, P.out, (const float*)(P.ws + WS_MOD)};
        pg8::gemm_phase<pg8::EpiOutProj, pg8::StaticOrder, true, true>(F.lds, g, S, E);
        phase_expert_weights(P, F);
    } SEAM(5);
    if (IN(6)) { phase_route(P, F); } SEAM(6);
    if (IN(7)) { phase_gather(P, F); } SEAM(7);
    if (IN(8)) {
        const int nt = build_tile_table(P, F);
        pg8::MoeOrder S{(const LAS int*)(F.lds + LDSCTL_OFF + LC_TILE), nt, F.G, (int)blockIdx.x};
        pg8::Gemm g{(const bf16*)(P.ws + WS_HPERM), (const bf16*)(P.ws + WS_WUP), RPAD, NE * 1024, DM};
        pg8::EpiUp E{(bf16*)(P.ws + WS_ACT)};
        pg8::gemm_phase<pg8::EpiUp, pg8::MoeOrder, true, true>(F.lds, g, S, E);
    } SEAM(8);
    if (IN(9)) {
        const int nt = build_tile_table(P, F);
        pg8::MoeOrder S{(const LAS int*)(F.lds + LDSCTL_OFF + LC_TILE), nt, F.G, (int)blockIdx.x};
        pg8::Gemm g{(const bf16*)(P.ws + WS_ACT), (const bf16*)(P.ws + WS_WDN), RPAD, NE * 1024, DE};
        pg8::EpiDown E{(bf16*)(P.ws + WS_YBUF), (const int*)(P.ws + WS_ROUTE + 3 * 262144), (const float*)(P.ws + WS_ROUTE + 3 * 262144 + 4 * RPAD)};
        pg8::gemm_phase<pg8::EpiDown, pg8::MoeOrder, true, true>(F.lds, g, S, E);
    } SEAM(9);
    if (IN(10)) { phase_final(P, F); }
#undef IN
#undef SEAM
}

extern "C" void kernel_launch(void* const* d_in, const int* in_sizes, int n_in, void* d_out, int out_size, void* d_ws, size_t ws_size, hipStream_t stream) {
    static int grid = 0;
    if (grid == 0) {
        if (n_in != 25 || in_sizes[0] != TL * DM || out_size != TL * DM || ws_size < WS_END) { fprintf(stderr, "kernel_launch: unexpected shapes (n_in %d, ws %zu)\n", n_in, ws_size); grid = -1; return; }
        int dev = 0, cus = 0, per_cu = 0;
        if (hipGetDevice(&dev) != hipSuccess || hipDeviceGetAttribute(&cus, hipDeviceAttributeMultiprocessorCount, dev) != hipSuccess) { grid = -1; return; }
        if (hipFuncSetAttribute((const void*)fwd_megakernel, hipFuncAttributeMaxDynamicSharedMemorySize, LDS_BYTES) != hipSuccess) { fprintf(stderr, "kernel_launch: hipFuncSetAttribute failed\n"); grid = -1; return; }
        if (hipOccupancyMaxActiveBlocksPerMultiprocessor(&per_cu, (const void*)fwd_megakernel, NWAVES * 64, LDS_BYTES) != hipSuccess || per_cu < 1) fprintf(stderr, "kernel_launch: occupancy query reports %d\n", per_cu);
        (void)hipGetLastError();
        grid = cus;
        if (grid != 256) fprintf(stderr, "kernel_launch: built for 256 CUs, got %d\n", grid);
    }
    if (grid < 0) return;
    (void)hipMemsetAsync((char*)d_ws + WS_CTL, 0, CTL_ZERO_BYTES, stream);
    Args a{};
    const float** pp = (const float**)&a.P;
    for (int i = 0; i < 25; ++i) pp[i] = (const float*)d_in[i];
    a.P.out = (float*)d_out; a.P.ws = (unsigned char*)d_ws;
#if MK_N_LAUNCHES == 1
    a.ph_lo = 0; a.ph_hi = NPHASE + 1;
    hipLaunchKernelGGL(fwd_megakernel, dim3(grid), dim3(NWAVES * 64), LDS_BYTES, stream, a);
#else
    for (int ph = 0; ph <= NPHASE; ++ph) { a.ph_lo = ph; a.ph_hi = ph + 1; hipLaunchKernelGGL(fwd_megakernel, dim3(grid), dim3(NWAVES * 64), LDS_BYTES, stream, a); }
#endif
}
```

```cpp
#include <hip/hip_runtime.h>
#include <cstdio>
#include <cstdint>
namespace pg8 {
#define PG8_LAS __attribute__((address_space(3)))
typedef unsigned short bf16_t;
typedef short bf16x8 __attribute__((ext_vector_type(8)));
typedef float f32x4 __attribute__((ext_vector_type(4)));
typedef unsigned u32x4 __attribute__((ext_vector_type(4)));
constexpr int BM = 256, BK = 64, HALF = 128, HTB = HALF * BK * 2  , STAGE_BYTES = 8 * HTB, NXCD = 8, WGM = 8;

__host__ __device__ __forceinline__ int lds_byte(int r, int c) { const int st = (r >> 4) * 2 + (c >> 5), rr = r & 15, cc = c & 31, ob = rr * 64 + cc * 2; return st * 1024 + (ob ^ (((ob >> 9) & 1) << 5)); }
__host__ __device__ __forceinline__ void stage_rc(int b, int& R, int& C) { const int st = b / 1024, sb = b % 1024, swz = sb ^ (((sb >> 9) & 1) << 5); R = (st >> 1) * 16 + swz / 64; C = (st & 1) * 32 + (swz % 64) / 2; }
__host__ __device__ __forceinline__ int perm32(int rho) { const int n = rho >> 4, i = rho & 15; return 8 * (i >> 2) + 4 * n + (i & 3); }

struct Unit { int pm, pn; };
struct Gemm { const bf16_t* A; const bf16_t* Bt; int M, N, K; };

struct StaticOrder {
    int nM, nN, nwg, G, c;
    __host__ __device__ void init(int M, int N, int G_, int c_) { nM = M / BM; nN = N / BM; nwg = nM * nN; G = G_; c = c_; }
    __host__ __device__ bool next(int i, Unit& u) const {
        const long L = (long)i * G + c; if (L >= nwg) return false;
        int wgid = (int)L; { const int q = nwg / NXCD, r = nwg % NXCD, xcd = wgid % NXCD, off = wgid / NXCD; wgid = (xcd < r ? xcd * (q + 1) : r * (q + 1) + (xcd - r) * q) + off; }
        const int nig = WGM * nN, gid = wgid / nig, fm = gid * WGM, gsz = (nM - fm) < WGM ? (nM - fm) : WGM;
        u.pm = fm + ((wgid % nig) % gsz); u.pn = (wgid % nig) / gsz; return true;
    }
    __device__ __forceinline__ void a_ready(const Unit&) const {}
    __device__ __forceinline__ void done(const Unit&) const {}
};

__device__ __forceinline__ unsigned cvt_pk_bf16(float lo, float hi) { unsigned r; asm volatile("v_cvt_pk_bf16_f32 %0, %1, %2" : "=v"(r) : "v"(lo), "v"(hi)); return r; }
typedef float f32x2 __attribute__((ext_vector_type(2)));
__device__ __forceinline__ float silu_f(float v) { return v * __builtin_amdgcn_rcpf(1.f + __expf(-v)); }
__device__ __forceinline__ float softplus_f(float v) { return v > 20.f ? v : log1pf(__expf(v)); }
struct EpiInProj {
    static constexpr bool PERM = true, AFTER_DRAIN = false;
    bf16_t* zs; bf16_t* xbc; bf16_t* yz; float* dtv; const float* dt_bias;
    __device__ __forceinline__ void operator()(const f32x4 (&acc)[2][2][4][2], const Unit& u, int wr, int wc, int fr, int fq) const {
        const int row0 = u.pm * BM + wr * 64 + fr; const int pn = u.pn;
        if (pn == 16) {
            if (wc == 0) {
                f32x4 bv[2];
#pragma unroll
                for (int n = 0; n < 2; ++n) bv[n] = *(const f32x4*)(dt_bias + 8 * fq + 4 * n);
#pragma unroll
                for (int ai = 0; ai < 2; ++ai)
#pragma unroll
                    for (int m = 0; m < 4; ++m) { float* rp = dtv + (size_t)(row0 + ai * HALF + m * 16) * 32 + 8 * fq;
#pragma unroll
                        for (int n = 0; n < 2; ++n) { const f32x4 v = acc[ai][0][m][n] + bv[n]; f32x4 o; o[0] = softplus_f(v[0]); o[1] = softplus_f(v[1]); o[2] = softplus_f(v[2]); o[3] = softplus_f(v[3]); *(f32x4*)(rp + 4 * n) = o; } }
            }
            return;
        }
        bf16_t* base; int ldc, colt; bool act = false;
        if (pn < 4) { base = zs; ldc = 1024; colt = pn * 256; act = true; } else if (pn < 12) { base = xbc; ldc = 2048; colt = (pn - 4) * 256; } else { base = yz; ldc = 1024; colt = (pn - 12) * 256; }
        const int col0 = colt + wc * 32 + 8 * fq;
#pragma unroll
        for (int ai = 0; ai < 2; ++ai)
#pragma unroll
            for (int m = 0; m < 4; ++m) { bf16_t* rowp = base + (size_t)(row0 + ai * HALF + m * 16) * ldc + col0;
#pragma unroll
                for (int bj = 0; bj < 2; ++bj) { f32x4 v0 = acc[ai][bj][m][0], v1 = acc[ai][bj][m][1];
                    if (act) { v0[0] = silu_f(v0[0]); v0[1] = silu_f(v0[1]); v0[2] = silu_f(v0[2]); v0[3] = silu_f(v0[3]); v1[0] = silu_f(v1[0]); v1[1] = silu_f(v1[1]); v1[2] = silu_f(v1[2]); v1[3] = silu_f(v1[3]); }
                    u32x4 w; w.x = cvt_pk_bf16(v0[0], v0[1]); w.y = cvt_pk_bf16(v0[2], v0[3]); w.z = cvt_pk_bf16(v1[0], v1[1]); w.w = cvt_pk_bf16(v1[2], v1[3]);
                    *(u32x4*)(rowp + bj * HALF) = w; } }
    }
};
struct EpiOutProj {
    static constexpr bool PERM = true, AFTER_DRAIN = false;
    const float* x; bf16_t* x1; const float* mod;
    __device__ __forceinline__ void operator()(const f32x4 (&acc)[2][2][4][2], const Unit& u, int wr, int wc, int fr, int fq) const {
        const int row0 = u.pm * BM + wr * 64 + fr, col0 = u.pn * BM + wc * 32 + 8 * fq;
        const float* g1 = mod + (size_t)(u.pm >> 4) * 6144 + 2048 + col0;
        f32x4 gv[2][2];
#pragma unroll
        for (int bj = 0; bj < 2; ++bj)
#pragma unroll
            for (int n = 0; n < 2; ++n) gv[bj][n] = *(const f32x4*)(g1 + bj * HALF + n * 4);
#pragma unroll
        for (int ai = 0; ai < 2; ++ai)
#pragma unroll
            for (int m = 0; m < 4; ++m) { const size_t off = (size_t)(row0 + ai * HALF + m * 16) * 1024 + col0;
#pragma unroll
                for (int bj = 0; bj < 2; ++bj) { const f32x4 x0 = *(const f32x4*)(x + off + bj * HALF), x1v = *(const f32x4*)(x + off + bj * HALF + 4);
                    const f32x4 v0 = x0 + gv[bj][0] * acc[ai][bj][m][0], v1 = x1v + gv[bj][1] * acc[ai][bj][m][1];
                    u32x4 w; w.x = cvt_pk_bf16(v0[0], v0[1]); w.y = cvt_pk_bf16(v0[2], v0[3]); w.z = cvt_pk_bf16(v1[0], v1[1]); w.w = cvt_pk_bf16(v1[2], v1[3]);
                    *(u32x4*)(x1 + off + bj * HALF) = w; } }
    }
};
struct EpiUp {
    static constexpr bool PERM = true, AFTER_DRAIN = false;
    bf16_t* act;
    __device__ __forceinline__ void operator()(const f32x4 (&acc)[2][2][4][2], const Unit& u, int wr, int wc, int fr, int fq) const {
        const int row0 = u.pm * BM + wr * 64 + fr, col0 = (u.pn & 3) * 128 + wc * 32 + 8 * fq;
#pragma unroll
        for (int ai = 0; ai < 2; ++ai)
#pragma unroll
            for (int m = 0; m < 4; ++m) { float a[8];
#pragma unroll
                for (int n = 0; n < 2; ++n)
#pragma unroll
                    for (int i = 0; i < 4; ++i) a[n * 4 + i] = silu_f(acc[ai][0][m][n][i]) * acc[ai][1][m][n][i];
                u32x4 w; w.x = cvt_pk_bf16(a[0], a[1]); w.y = cvt_pk_bf16(a[2], a[3]); w.z = cvt_pk_bf16(a[4], a[5]); w.w = cvt_pk_bf16(a[6], a[7]);
                *(u32x4*)(act + (size_t)(row0 + ai * HALF + m * 16) * 512 + col0) = w; }
    }
};
struct EpiDown {
    static constexpr bool PERM = true, AFTER_DRAIN = false;
    bf16_t* ybuf; const int* rowdest; const float* rowgate;
    __device__ __forceinline__ void operator()(const f32x4 (&acc)[2][2][4][2], const Unit& u, int wr, int wc, int fr, int fq) const {
        const int row0 = u.pm * BM + wr * 64 + fr, col0 = (u.pn & 3) * 256 + wc * 32 + 8 * fq;
#pragma unroll
        for (int ai = 0; ai < 2; ++ai)
#pragma unroll
            for (int m = 0; m < 4; ++m) { const int row = row0 + ai * HALF + m * 16; const int dest = rowdest[row]; const float gt = rowgate[row];
                if (dest >= 0) {
#pragma unroll
                    for (int bj = 0; bj < 2; ++bj) { const f32x4 v0 = acc[ai][bj][m][0] * gt, v1 = acc[ai][bj][m][1] * gt;
                        u32x4 w; w.x = cvt_pk_bf16(v0[0], v0[1]); w.y = cvt_pk_bf16(v0[2], v0[3]); w.z = cvt_pk_bf16(v1[0], v1[1]); w.w = cvt_pk_bf16(v1[2], v1[3]);
                        *(u32x4*)(ybuf + (size_t)dest * 1024 + col0 + bj * HALF) = w; } } }
    }
};
struct InProjOrder {
    int G, c;
    __device__ __forceinline__ bool next(int i, Unit& u) const {
        const int L = i * G + c;
        if (L < 2176) { const int wgid = (L % NXCD) * 272 + L / NXCD; const int r = wgid % 136; u.pm = (wgid / 136) * 8 + (r & 7); u.pn = r >> 3; return true; }
        const int L2 = L - 2176; if (L2 >= 72) return false;
        u.pm = 128 + L2 / 9; const int j = L2 % 9; u.pn = j < 8 ? 4 + j : 16; return true;
    }
    __device__ __forceinline__ void a_ready(const Unit&) const {}
    __device__ __forceinline__ void done(const Unit&) const {}
};
struct MoeOrder {
    const PG8_LAS int* tile_e; int ntiles, G, c;
    __device__ __forceinline__ bool next(int i, Unit& u) const {
        const int L = i * G + c; if (L >= ntiles * 4) return false;
        const int rt = L >> 2; u.pm = rt; u.pn = tile_e[rt] * 4 + (L & 3); return true;
    }
    __device__ __forceinline__ void a_ready(const Unit&) const {}
    __device__ __forceinline__ void done(const Unit&) const {}
};
template <class Epi, class Sched, bool ALIGN_EPI = false, bool SP2 = false>
__device__ __forceinline__ void gemm_phase(PG8_LAS unsigned char* lds, const Gemm g, const Sched& S, const Epi& E) {
    const int tid = threadIdx.x, wid = __builtin_amdgcn_readfirstlane(tid >> 6), lane = tid & 63, wr = wid >> 2, wc = wid & 3, fr = lane & 15, fq = lane >> 4;
    const int K = g.K, nt = K / BK;
    unsigned voffA[2], voffB[2];
#pragma unroll
    for (int i = 0; i < 2; ++i) { int R, C; stage_rc(tid * 16 + i * 8192, R, C); const int Rb = Epi::PERM ? ((R & ~31) + perm32(R & 31)) : R;
        voffA[i] = (unsigned)(R * K + C) * 2u; voffB[i] = (unsigned)(Rb * K + C) * 2u; }
    const size_t kstep = (size_t)(BK * 2);
    const size_t hstep = (size_t)HALF * K * 2;
    const size_t tstep = 2 * hstep;
    const unsigned ldsw = (unsigned)wid * 1024u;
    const int aoff = lds_byte(wr * 64 + fr, fq * 8), boff = lds_byte(wc * 32 + fr, fq * 8);
#define PG8_SA(b, h) (((b) * 2 + (h)) * HTB)
#define PG8_SB(b, h) ((4 + (b) * 2 + (h)) * HTB)
#define PG8_STAGE(bufoff, gbase, voff) do { _Pragma("unroll") for (int _i = 0; _i < 2; ++_i) \
        __builtin_amdgcn_global_load_lds((const unsigned*)((const char*)(gbase) + (voff)[_i]), (PG8_LAS unsigned*)(lds + (bufoff) + ldsw + _i * 8192), 16, 0, 0); } while (0)
#define PG8_LDA(dst, b, h) do { _Pragma("unroll") for (int m = 0; m < 4; ++m) _Pragma("unroll") for (int k = 0; k < 2; ++k) dst[m][k] = *(const PG8_LAS bf16x8*)(lds + PG8_SA(b, h) + aoff + m * 2048 + k * 1024); } while (0)
#define PG8_LDB(dst, b, h) do { _Pragma("unroll") for (int n = 0; n < 2; ++n) _Pragma("unroll") for (int k = 0; k < 2; ++k) dst[n][k] = *(const PG8_LAS bf16x8*)(lds + PG8_SB(b, h) + boff + n * 2048 + k * 1024); } while (0)
#define PG8_MMA(ai, bj, At, Bt) do { __builtin_amdgcn_s_setprio(1); _Pragma("unroll") for (int m = 0; m < 4; ++m) _Pragma("unroll") for (int n = 0; n < 2; ++n) _Pragma("unroll") for (int k = 0; k < 2; ++k) \
        acc[ai][bj][m][n] = __builtin_amdgcn_mfma_f32_16x16x32_bf16(Bt[n][k], At[m][k], acc[ai][bj][m][n], 0, 0, 0); __builtin_amdgcn_s_setprio(0); } while (0)
#define PG8_WAIT_V(n) asm volatile("s_waitcnt vmcnt(" #n ")" ::: "memory")
#define PG8_WAIT_L(n) asm volatile("s_waitcnt lgkmcnt(" #n ")" ::: "memory")
#define PG8_BAR __builtin_amdgcn_s_barrier()
#define PG8_SCHED __builtin_amdgcn_sched_barrier(0)
    Unit cur, nxt; int ui = 0;
    if (!S.next(0, cur)) return;
    f32x4 acc[2][2][4][2];
#pragma unroll
    for (int a = 0; a < 2; ++a)
#pragma unroll
        for (int b = 0; b < 2; ++b)
#pragma unroll
            for (int m = 0; m < 4; ++m)
#pragma unroll
                for (int n = 0; n < 2; ++n) acc[a][b][m][n] = (f32x4){0.f, 0.f, 0.f, 0.f};
    bf16x8 At[4][2], B0[2][2], B1[2][2];
    const char* cA = (const char*)g.A + (size_t)cur.pm * tstep; const char* cB = (const char*)g.Bt + (size_t)cur.pn * tstep;
    S.a_ready(cur);
    if constexpr (SP2) {
        PG8_STAGE(PG8_SB(0, 0), cB, voffB); PG8_STAGE(PG8_SB(0, 1), cB + hstep, voffB); PG8_STAGE(PG8_SA(0, 0), cA, voffA); PG8_STAGE(PG8_SA(0, 1), cA + hstep, voffA);
        if (wr == 1) PG8_BAR;
        PG8_WAIT_V(2); PG8_BAR;
        PG8_STAGE(PG8_SB(1, 0), cB + kstep, voffB); PG8_STAGE(PG8_SA(1, 0), cA + kstep, voffA); PG8_STAGE(PG8_SB(1, 1), cB + hstep + kstep, voffB);
        PG8_WAIT_V(6); PG8_BAR;
    } else {
        PG8_STAGE(PG8_SB(0, 0), cB, voffB); PG8_STAGE(PG8_SA(0, 0), cA, voffA); PG8_STAGE(PG8_SB(0, 1), cB + hstep, voffB); PG8_STAGE(PG8_SA(0, 1), cA + hstep, voffA);
        if (wr == 1) PG8_BAR;
        PG8_WAIT_V(4); PG8_BAR;
        PG8_STAGE(PG8_SB(1, 0), cB + kstep, voffB); PG8_STAGE(PG8_SA(1, 0), cA + kstep, voffA); PG8_STAGE(PG8_SB(1, 1), cB + hstep + kstep, voffB);
        PG8_WAIT_V(6); PG8_BAR;
    }
    for (;;) {
        const bool has_next = S.next(ui + 1, nxt);
        const char* nA = has_next ? (const char*)g.A + (size_t)nxt.pm * tstep : cA; const char* nB = has_next ? (const char*)g.Bt + (size_t)nxt.pn * tstep : cB;
        for (int t = 0; t < nt; t += 2) {
            const bool last = (t == nt - 2);
            const char* a1 = cA + (size_t)(t + 1) * kstep;
            const char* a2 = last ? nA : cA + (size_t)(t + 2) * kstep; const char* b2 = last ? nB : cB + (size_t)(t + 2) * kstep;
            const char* a3 = a2 + kstep; const char* b3 = b2 + kstep;
            if (last && has_next) S.a_ready(nxt);
            if constexpr (SP2) {
            PG8_LDB(B0, 0, 0); PG8_LDB(B1, 0, 1); PG8_SCHED; PG8_LDA(At, 0, 0); PG8_STAGE(PG8_SA(1, 1), a1 + hstep, voffA);
            PG8_WAIT_V(8); PG8_WAIT_L(0); PG8_BAR; PG8_MMA(0, 0, At, B0); PG8_MMA(0, 1, At, B1); PG8_BAR; PG8_SCHED;
            PG8_LDA(At, 0, 1); PG8_STAGE(PG8_SB(0, 0), b2, voffB); PG8_STAGE(PG8_SB(0, 1), b2 + hstep, voffB); PG8_STAGE(PG8_SA(0, 0), a2, voffA);
            PG8_WAIT_V(8); PG8_WAIT_L(0); PG8_BAR; PG8_MMA(1, 0, At, B0); PG8_MMA(1, 1, At, B1); PG8_BAR; PG8_SCHED;
            PG8_LDB(B0, 1, 0); PG8_LDB(B1, 1, 1); PG8_SCHED; PG8_LDA(At, 1, 0); PG8_STAGE(PG8_SA(0, 1), a2 + hstep, voffA);
            PG8_WAIT_V(8); PG8_WAIT_L(0); PG8_BAR; PG8_MMA(0, 0, At, B0); PG8_MMA(0, 1, At, B1); PG8_BAR; PG8_SCHED;
            PG8_LDA(At, 1, 1); PG8_STAGE(PG8_SB(1, 0), b3, voffB); PG8_STAGE(PG8_SB(1, 1), b3 + hstep, voffB); PG8_STAGE(PG8_SA(1, 0), a3, voffA);
            PG8_WAIT_V(8); PG8_WAIT_L(0); PG8_BAR; PG8_MMA(1, 0, At, B0); PG8_MMA(1, 1, At, B1); PG8_BAR; PG8_SCHED;
            } else {
            PG8_LDB(B0, 0, 0); PG8_SCHED; PG8_LDA(At, 0, 0); PG8_STAGE(PG8_SA(1, 1), a1 + hstep, voffA);
            PG8_WAIT_L(8); PG8_BAR; PG8_WAIT_L(0); PG8_MMA(0, 0, At, B0); PG8_BAR; PG8_SCHED;
            PG8_LDB(B1, 0, 1); PG8_STAGE(PG8_SB(0, 0), b2, voffB);
            PG8_BAR; PG8_WAIT_L(0); PG8_MMA(0, 1, At, B1); PG8_BAR;
            PG8_LDA(At, 0, 1); PG8_STAGE(PG8_SA(0, 0), a2, voffA);
            PG8_BAR; PG8_WAIT_L(0); PG8_MMA(1, 0, At, B0); PG8_BAR; PG8_SCHED;
            PG8_STAGE(PG8_SB(0, 1), b2 + hstep, voffB);
            PG8_WAIT_V(6); PG8_BAR; PG8_MMA(1, 1, At, B1); PG8_BAR;
            PG8_LDB(B0, 1, 0); PG8_SCHED; PG8_LDA(At, 1, 0); PG8_STAGE(PG8_SA(0, 1), a2 + hstep, voffA);
            PG8_WAIT_L(8); PG8_BAR; PG8_WAIT_L(0); PG8_MMA(0, 0, At, B0); PG8_BAR; PG8_SCHED;
            PG8_LDB(B1, 1, 1); PG8_STAGE(PG8_SB(1, 0), b3, voffB);
            PG8_BAR; PG8_WAIT_L(0); PG8_MMA(0, 1, At, B1); PG8_BAR;
            PG8_LDA(At, 1, 1); PG8_STAGE(PG8_SA(1, 0), a3, voffA);
            PG8_BAR; PG8_WAIT_L(0); PG8_MMA(1, 0, At, B0); PG8_BAR; PG8_SCHED;
            PG8_STAGE(PG8_SB(1, 1), b3 + hstep, voffB);
            PG8_WAIT_V(6); PG8_BAR; PG8_MMA(1, 1, At, B1); PG8_BAR;
            }
        }
        if constexpr (ALIGN_EPI) { if (wr == 0) PG8_BAR; }
        if constexpr (!Epi::AFTER_DRAIN) { E(acc, cur, wr, wc, fr, fq); S.done(cur); }
        if (!has_next) break;
#pragma unroll
        for (int a = 0; a < 2; ++a)
#pragma unroll
            for (int b = 0; b < 2; ++b)
#pragma unroll
                for (int m = 0; m < 4; ++m)
#pragma unroll
                    for (int n = 0; n < 2; ++n) acc[a][b][m][n] = (f32x4){0.f, 0.f, 0.f, 0.f};
        cur = nxt; cA = nA; cB = nB; ++ui;
        if constexpr (ALIGN_EPI) { if (wr == 1) PG8_BAR; }
    }
    PG8_WAIT_V(0);
    if constexpr (!ALIGN_EPI) { if (wr == 0) PG8_BAR; }
    PG8_BAR;
    if constexpr (Epi::AFTER_DRAIN) { E.fused(acc, cur, wr, wc, fr, fq, lds, wid, lane); S.done(cur); }
#undef PG8_SA
#undef PG8_SB
#undef PG8_STAGE
#undef PG8_LDA
#undef PG8_LDB
#undef PG8_MMA
#undef PG8_WAIT_V
#undef PG8_WAIT_L
#undef PG8_BAR
#undef PG8_SCHED
}
}
typedef unsigned short bf16;
#define DEVI __device__ __forceinline__
#define LAS __attribute__((address_space(3)))
#define GAS __attribute__((address_space(1)))
typedef unsigned v4u __attribute__((ext_vector_type(4)));
typedef float f32x4 __attribute__((ext_vector_type(4)));
typedef short s16x4 __attribute__((ext_vector_type(4)));
typedef unsigned u32x2 __attribute__((ext_vector_type(2)));
typedef short bf16x8 __attribute__((ext_vector_type(8)));
#define RLX_AGENT __ATOMIC_RELAXED, __HIP_MEMORY_SCOPE_AGENT
#define LDS_WAIT() asm volatile("s_waitcnt lgkmcnt(0)" ::: "memory")
#define VM_WAIT() asm volatile("s_waitcnt vmcnt(0)" ::: "memory")

constexpr int NWAVES = 8;
constexpr int DM = 1024, NB = 8, SEQ = 4096, CTX = 256;
constexpr int TL = NB * SEQ, TC = NB * CTX, TA = TL + TC;
constexpr int CONVD = 2048, DPROJ = 3616, NIN = 4352, C_XBC = 1024, C_Y = 3072, C_DT = 4096, FOFF = 3104, DMIX = 1536, NE = 32, DE = 512;
constexpr int RPAD = 65536 + NE * 256;
constexpr float EPS = 1e-6f;
constexpr size_t MiB = 1u << 20;
constexpr size_t WS_CTL = 0, CTL_ZERO_BYTES = 64 * 1024;
constexpr size_t WS_WIN = 2 * MiB, WS_WOUT = 11 * MiB, WS_MODP = 14 * MiB, WS_WC = 15 * MiB, WS_ROUTE = 15 * MiB + 512 * 1024, WS_MOD = 1 * MiB;
constexpr size_t WS_XN = 17 * MiB, WS_AP = 17 * MiB, WS_WDN = 17 * MiB, WS_ZS = 85 * MiB, WS_WUP = 85 * MiB, WS_YBUF = 213 * MiB, WS_X1 = 149 * MiB, WS_XBC = 149 * MiB, WS_YF = 149 * MiB, WS_YB = 213 * MiB, WS_H2 = 149 * MiB;
constexpr size_t WS_HPERM = 213 * MiB, WS_YZ = 285 * MiB, WS_DTV = 350 * MiB, WS_XC = 355 * MiB, WS_MIX = 355 * MiB, WS_ACT = 358 * MiB, WS_END = 512 * MiB;
constexpr int CW_CNT = 0, CW_BAR = 4096;
constexpr int RING_BYTES = 131072, LDSCTL_OFF = 155648, LDS_BYTES = 163840;
constexpr int LC_MISC = 0  , LC_TILE = 256  , LC_CNT = 2048  , LC_RT = 4096  , LC_PTR = 6144  ;

DEVI float bf2f(bf16 v) { return __uint_as_float(((unsigned)v) << 16); }
typedef float f32x2_t __attribute__((ext_vector_type(2)));
typedef __bf16 bf16x2_t __attribute__((ext_vector_type(2)));
DEVI unsigned pk2(float lo, float hi) { const f32x2_t v = {lo, hi}; return __builtin_bit_cast(unsigned, __builtin_convertvector(v, bf16x2_t)); }
DEVI unsigned f2bf(float f) { return pk2(f, f) & 0xffffu; }
DEVI float siluf(float v) { return v / (1.f + __expf(-v)); }
DEVI float wave_sum(float v) {
#pragma unroll
    for (int o = 1; o < 64; o <<= 1) v += __shfl_xor(v, o);
    return v;
}
struct Ptrs {
    const float *x, *c, *ctx, *c_ctx, *w_mod, *b_mod, *norm1, *w_in, *conv_w, *conv_b, *dt_bias, *a_log, *d_skip, *ssd_norm, *w_four, *w_out, *norm2,
        *w_rg, *b_rg, *w_re, *b_re, *w_eg, *w_eu, *w_ed, *final_norm;
    float* out; unsigned char* ws;
};
struct Frame { LAS unsigned char* lds; int tid, lane, wave, vcu, G; };
#define XB_TMO      128
#define XB_XCNT(j)  (256  + 64 * (j))
#define XB_XSUB(j)  (1280 + 64 * (j))
#define XB_XGEN(j)  (2304 + 64 * (j))
#define XB_TOP      3328
#define XB_TOPGEN   3392
#define XCD_BAR_WORDS 3456
#define XB_SPIN_CAP (1u << 18)

__device__ __forceinline__ unsigned xb_ld(unsigned* p)              { return __hip_atomic_load(p, __ATOMIC_RELAXED, __HIP_MEMORY_SCOPE_AGENT); }
__device__ __forceinline__ unsigned xb_add(unsigned* p, unsigned v) { return __hip_atomic_fetch_add(p, v, __ATOMIC_RELAXED, __HIP_MEMORY_SCOPE_AGENT); }
__device__ __forceinline__ unsigned xb_xcc_id() { return (unsigned)__builtin_amdgcn_s_getreg((3 << 11) | 20) & 0xFu; }
#define XB_SPIN(cond, bar) do { unsigned _sp = 0; while (cond) { __builtin_amdgcn_s_sleep(1); \
    if ((++_sp & 255u) == 0u) { if (xb_ld(&(bar)[XB_TMO])) break; if (_sp > XB_SPIN_CAP) { atomicAdd(&(bar)[XB_TMO], 1u); break; } } } } while (0)

struct XcdBarrier {
    unsigned* bar; unsigned x;
    volatile LAS unsigned* st;
};

__device__ __forceinline__ XcdBarrier xcd_barrier_post(unsigned* bar, volatile LAS unsigned* st) {
    XcdBarrier b; b.bar = bar; b.x = xb_xcc_id(); b.st = st;
    if (threadIdx.x == 0) (void)xb_add(&bar[XB_XCNT(b.x)], 1u);
    return b;
}
__device__ __forceinline__ void xcd_barrier_complete(unsigned* bar, unsigned x, unsigned& nloc, unsigned& nx) {
    const unsigned G = gridDim.x * gridDim.y * gridDim.z;
    unsigned sum, cnt, mine, sp = 0u;
    for (;;) {
        sum = 0u; cnt = 0u; mine = 0u;
#pragma unroll
        for (unsigned j = 0; j < 16; ++j) { const unsigned c = xb_ld(&bar[XB_XCNT(j)]); sum += c; cnt += (c > 0u) ? 1u : 0u; mine = (j == x) ? c : mine; }
        if (sum == G) break;
        __builtin_amdgcn_s_sleep(1);
        if ((++sp & 255u) == 0u) { if (xb_ld(&bar[XB_TMO])) break; if (sp > XB_SPIN_CAP) { atomicAdd(&bar[XB_TMO], 1u); break; } }
    }
    nloc = mine > 0u ? mine : 1u; nx = cnt > 0u ? cnt : 1u;
}

__device__ __forceinline__ void xcd_barrier(const XcdBarrier& b) {
    asm volatile("s_waitcnt vmcnt(0)" ::: "memory");
    __syncthreads();
    if (threadIdx.x == 0) {
        unsigned* bar = b.bar;
        __builtin_amdgcn_s_waitcnt(0);
        unsigned nloc = b.st[0], nx = b.st[1];
        if (nloc == 0u) { xcd_barrier_complete(bar, b.x, nloc, nx); b.st[0] = nloc; b.st[1] = nx; }
        const unsigned old = xb_add(&bar[XB_XSUB(b.x)], 1u);
        const unsigned gen = old / nloc;
        if (old + 1u == (gen + 1u) * nloc) {
            __builtin_amdgcn_fence(__ATOMIC_RELEASE, "agent");
            asm volatile("s_waitcnt vmcnt(0)" ::: "memory");
            const unsigned og = xb_add(&bar[XB_TOP], 1u);
            const unsigned tg = og / nx;
            if (og + 1u == (tg + 1u) * nx) xb_add(&bar[XB_TOPGEN], 1u);
            else XB_SPIN(xb_ld(&bar[XB_TOPGEN]) == tg, bar);
            __builtin_amdgcn_fence(__ATOMIC_ACQUIRE, "agent");
            xb_add(&bar[XB_XGEN(b.x)], 1u);
            asm volatile("s_waitcnt vmcnt(0)" ::: "memory");
        } else {
            XB_SPIN(xb_ld(&bar[XB_XGEN(b.x)]) == gen, bar);
            __builtin_amdgcn_fence(__ATOMIC_ACQUIRE, "agent");
            asm volatile("s_waitcnt vmcnt(0)" ::: "memory");
        }
    }
    __syncthreads();
}
DEVI void transpose_item(const float* W, int N, bf16* WT, int Kt, int row_off, int k0, int n0, LAS float* scr, int lane) {
#pragma unroll 8
    for (int i = 0; i < 32; ++i) { const int kk = 2 * i + (lane >> 5); scr[kk * 33 + (lane & 31)] = W[(size_t)(k0 + kk) * N + n0 + (lane & 31)]; }
    LDS_WAIT(); asm volatile("" ::: "memory");
    const int c = lane & 7;
#pragma unroll
    for (int j = 0; j < 4; ++j) { const int n = (lane >> 3) + 8 * j; const LAS float* s = scr + (8 * c) * 33 + n;
        v4u o; o.x = pk2(s[0 * 33], s[1 * 33]); o.y = pk2(s[2 * 33], s[3 * 33]); o.z = pk2(s[4 * 33], s[5 * 33]); o.w = pk2(s[6 * 33], s[7 * 33]);
        *(v4u*)(WT + (size_t)(row_off + n0 + n) * Kt + k0 + 8 * c) = o; }
    LDS_WAIT(); asm volatile("" ::: "memory");
}
DEVI void phase0a(const Ptrs& P, const Frame& F) {
    const int gt = F.vcu * 512 + F.tid, NT = F.G * 512;
    { int* rowdest = (int*)(P.ws + WS_ROUTE + 3 * 262144); for (int i = gt; i < RPAD; i += NT) rowdest[i] = -1; }
    for (int o = gt; o < 4 * 128 * 256; o += NT) { const int g = o >> 15, c = (o >> 8) & 127, t = o & 255, ri = t >> 7, d = t & 127; float acc = 0.f;
        for (int m = 0; m < 128; ++m) { const float ang = (float)((m * c) & 127) * (2.0f / 128.0f); const float tw = ri == 0 ? cospif(ang) : -sinpif(ang); acc += tw * P.w_four[((size_t)g * 128 + m) * 128 + d]; }
        ((float*)(P.ws + WS_WC))[o] = acc * 0.08838834764831845f; }
    { LAS float* svec = (LAS float*)F.lds; LAS float* red = svec + 9 * 256;
      float* modp = (float*)(P.ws + WS_MODP);
      for (int u = F.vcu; u < 384; u += F.G) { const int cc = u % 96, kc = u / 96;
        __syncthreads();
        for (int i = F.tid; i < 9 * 256; i += 512) { const int r = i >> 8, k = kc * 256 + (i & 255); svec[i] = siluf(r < 8 ? P.c[r * DM + k] : P.c_ctx[k]); }
        __syncthreads();
        const int col = cc * 64 + F.lane; float acc[9];
#pragma unroll
        for (int r = 0; r < 9; ++r) acc[r] = 0.f;
#pragma unroll 8
        for (int i = 0; i < 32; ++i) { const int kl = F.wave * 32 + i; const float w = P.w_mod[(size_t)(kc * 256 + kl) * 6144 + col];
#pragma unroll
            for (int r = 0; r < 9; ++r) acc[r] += svec[r * 256 + kl] * w; }
#pragma unroll
        for (int r = 0; r < 9; ++r) red[(F.wave * 9 + r) * 64 + F.lane] = acc[r];
        __syncthreads();
        for (int i = F.tid; i < 576; i += 512) { float s = 0.f;
#pragma unroll
            for (int w = 0; w < 8; ++w) s += red[w * 576 + i];
            modp[((size_t)kc * 9 + (i >> 6)) * 6144 + cc * 64 + (i & 63)] = s; }
      }
      __syncthreads(); }
    { LAS float* scr = (LAS float*)(F.lds + F.wave * 16384); const int gw = F.vcu * NWAVES + F.wave, NGW = F.G * NWAVES;
      bf16* Win = (bf16*)(P.ws + WS_WIN); bf16* Wout = (bf16*)(P.ws + WS_WOUT);
      constexpr int I_IN = 16 * 97, I_OUT = 24 * 32;
      for (int it = gw; it < I_IN + I_OUT; it += NGW) {
          if (it < I_IN) { const int kb = it / 97, nb = it % 97; transpose_item(P.w_in, DPROJ, Win, DM, nb == 96 ? 1024 : 0, kb * 64, nb * 32, scr, F.lane); }
          else { const int r = it - I_IN, kb = r / 32, nb = r % 32; transpose_item(P.w_out, DM, Wout, DMIX, 0, kb * 64, nb * 32, scr, F.lane); } }
      for (int i = gt; i < (NIN - C_DT - 32) * DM / 8; i += NT) ((v4u*)(Win + (size_t)(C_DT + 32) * DM))[i] = (v4u){0u, 0u, 0u, 0u}; }
}
DEVI float modp_sum(const Ptrs& P, int r, int idx) { const float* mp = (const float*)(P.ws + WS_MODP) + (size_t)r * 6144 + idx; return P.b_mod[idx] + ((mp[0] + mp[9 * 6144]) + (mp[2 * 9 * 6144] + mp[3 * 9 * 6144])); }
template <int R>
DEVI void xn_rows(const float* const (&src)[R], bf16* const (&dst)[R], const float* norm1, const LAS float* mrow, int lane) {
    f32x4 v[R][4];
#pragma unroll
    for (int r = 0; r < R; ++r)
#pragma unroll
        for (int j = 0; j < 4; ++j) v[r][j] = ((const f32x4*)src[r])[lane + 64 * j];
#pragma unroll
    for (int r = 0; r < R; ++r) { float s = 0.f;
#pragma unroll
        for (int j = 0; j < 4; ++j) s += (v[r][j][0] * v[r][j][0] + v[r][j][1] * v[r][j][1]) + (v[r][j][2] * v[r][j][2] + v[r][j][3] * v[r][j][3]);
        const float rstd = rsqrtf(wave_sum(s) * (1.f / DM) + EPS);
#pragma unroll
        for (int j = 0; j < 4; ++j) { const int c0 = (lane + 64 * j) * 4; const f32x4 nw = *(const f32x4*)(norm1 + c0); float o[4];
#pragma unroll
            for (int i = 0; i < 4; ++i) o[i] = v[r][j][i] * rstd * nw[i] * (1.f + mrow[1024 + c0 + i]) + mrow[c0 + i];
            u32x2 w; w.x = pk2(o[0], o[1]); w.y = pk2(o[2], o[3]); *(u32x2*)(dst[r] + c0) = w; } }
}
DEVI void phase0b(const Ptrs& P, const Frame& F) {
    const int gt = F.vcu * 512 + F.tid, NT = F.G * 512;
    { float* mod = (float*)(P.ws + WS_MOD); for (int i = gt; i < 9 * 6144; i += NT) mod[i] = modp_sum(P, i / 6144, i % 6144); }
    LAS float* mrow = (LAS float*)F.lds;
    for (int rb = F.vcu; rb < 256; rb += F.G) {
        __syncthreads();
        for (int i = F.tid; i < 2048; i += 512) mrow[i] = modp_sum(P, rb >> 5, i);
        __syncthreads();
        for (int r = F.wave * 4; r < 128; r += NWAVES * 4) { const float* src[4]; bf16* dst[4];
#pragma unroll
            for (int k = 0; k < 4; ++k) { const int row = rb * 128 + r + k; src[k] = P.x + (size_t)row * DM; dst[k] = (bf16*)(P.ws + WS_XN) + (size_t)row * DM; }
            xn_rows<4>(src, dst, P.norm1, mrow, F.lane); }
        __syncthreads();
        for (int i = F.tid; i < 2048; i += 512) mrow[i] = modp_sum(P, 8, i);
        __syncthreads();
        { const int row = rb * 8 + F.wave; const float* src[1] = {P.ctx + (size_t)row * DM}; bf16* dst[1] = {(bf16*)(P.ws + WS_XN) + (size_t)(TL + row) * DM}; xn_rows<1>(src, dst, P.norm1, mrow, F.lane); }
    }
    { LAS float* wi = (LAS float*)F.lds; LAS float* wc = wi + 64 * 128; const float* Wc = (const float*)(P.ws + WS_WC); bf16* Win = (bf16*)(P.ws + WS_WIN);
      for (int u = F.vcu; u < 256; u += F.G) { const int g = u >> 6, kb = (u >> 2) & 15, jb = u & 3;
        __syncthreads();
        for (int i = F.tid; i < 64 * 128; i += 512) { const int kk = i >> 7, c = i & 127; wi[i] = P.w_in[(size_t)(kb * 64 + kk) * DPROJ + FOFF + g * 128 + c]; }
        for (int i = F.tid; i < 128 * 64; i += 512) { const int c = i >> 6, j = i & 63; wc[i] = Wc[((size_t)g * 128 + c) * 256 + jb * 64 + j]; }
        __syncthreads();
        float acc[8];
#pragma unroll
        for (int i = 0; i < 8; ++i) acc[i] = 0.f;
        for (int c = 0; c < 128; ++c) { const float wv = wc[c * 64 + F.lane];
#pragma unroll
            for (int i = 0; i < 8; ++i) acc[i] += wi[(F.wave * 8 + i) * 128 + c] * wv; }
        v4u o; o.x = pk2(acc[0], acc[1]); o.y = pk2(acc[2], acc[3]); o.z = pk2(acc[4], acc[5]); o.w = pk2(acc[6], acc[7]);
        *(v4u*)(Win + (size_t)(C_Y + g * 256 + jb * 64 + F.lane) * DM + kb * 64 + F.wave * 8) = o; }
      __syncthreads(); }
}
DEVI void phase_conv(const Ptrs& P, const Frame& F) {
    const bf16* xbc = (const bf16*)(P.ws + WS_XBC); bf16* xc = (bf16*)(P.ws + WS_XC);
    for (int u = F.vcu; u < (TA / 16) * 2; u += F.G) {
        const int tb = u >> 1, ch = (u & 1) * 1024 + 2 * F.tid; const int row0 = tb * 16;
        const int len = row0 < TL ? SEQ : CTX; const int t0 = row0 < TL ? (row0 & (SEQ - 1)) : ((row0 - TL) & (CTX - 1));
        float cw[5][2], cb[2];
        { const float2 bb = *(const float2*)(P.conv_b + ch); cb[0] = bb.x; cb[1] = bb.y;
#pragma unroll
          for (int t = 0; t < 5; ++t) { const float2 ww = *(const float2*)(P.conv_w + t * CONVD + ch); cw[t][0] = ww.x; cw[t][1] = ww.y; } }
        unsigned raw[20];
        const bf16* src = xbc + (size_t)(row0 - 2) * 2048 + ch;
#pragma unroll
        for (int i = 0; i < 20; ++i) raw[i] = *(const unsigned*)(src + (size_t)i * 2048);
#pragma unroll
        for (int i = 0; i < 2; ++i) { asm volatile("" : "+v"(raw[i]), "+v"(raw[18 + i]));
            if (t0 - 2 + i < 0) raw[i] = 0u; if (t0 + 16 + i >= len) raw[18 + i] = 0u; }
        bf16* dst = xc + (size_t)row0 * 2048 + ch;
#pragma unroll
        for (int o = 0; o < 16; ++o) { float a0 = cb[0], a1 = cb[1];
#pragma unroll
            for (int t = 0; t < 5; ++t) { a0 += __uint_as_float(raw[o + t] << 16) * cw[t][0]; a1 += __uint_as_float(raw[o + t] & 0xffff0000u) * cw[t][1]; }
            a0 = a0 * __builtin_amdgcn_rcpf(1.f + __expf(-a0)); a1 = a1 * __builtin_amdgcn_rcpf(1.f + __expf(-a1));
            *(unsigned*)(dst + (size_t)o * 2048) = pk2(a0, a1); }
    }
}
DEVI void phase_ssd_naive(const Ptrs& P, const Frame& F) {
    LAS float* Bs = (LAS float*)F.lds; LAS float* Cs = Bs + 128;
    for (int id = F.vcu; id < 256; id += F.G) {
    const int dir = id & 1, h = (id >> 1) & 15, b = id >> 5, p = F.tid & 63, g = h >> 2; const bool act = F.tid < 64;
    const bf16* xbc = (const bf16*)(P.ws + WS_XBC); const float* dtv = (const float*)(P.ws + WS_DTV);
    bf16* yout = (bf16*)(P.ws + (dir ? WS_YB : WS_YF));
    const float Aneg = -__expf(P.a_log[dir * 16 + h]); const float Dsk = P.d_skip[h];
    float hs[128];
#pragma unroll
    for (int n = 0; n < 128; ++n) hs[n] = 0.f;
    int ch[5]; ch[0] = h * 64 + p; ch[1] = 1024 + g * 128 + p; ch[2] = 1024 + g * 128 + 64 + p; ch[3] = 1536 + g * 128 + p; ch[4] = 1536 + g * 128 + 64 + p;
    float cw[5][5], cb[5];
#pragma unroll
    for (int i = 0; i < 5; ++i) { cb[i] = P.conv_b[ch[i]];
#pragma unroll
        for (int w = 0; w < 5; ++w) cw[i][w] = P.conv_w[w * CONVD + ch[i]]; }
    for (int seg = 0; seg < 2; ++seg) {
        const int len = seg == 0 ? CTX : SEQ; const size_t rbase = seg == 0 ? (size_t)TL + (size_t)b * CTX : (size_t)b * SEQ;
        for (int st = 0; st < len; ++st) {
            const int t = dir ? len - 1 - st : st;
            float cv[5];
#pragma unroll
            for (int i = 0; i < 5; ++i) { float a = cb[i];
#pragma unroll
                for (int w = 0; w < 5; ++w) { const int tt = t + w - 2; if (tt >= 0 && tt < len) a += bf2f(xbc[(rbase + tt) * 2048 + ch[i]]) * cw[i][w]; }
                cv[i] = siluf(a); }
            __syncthreads();
            if (act) { Bs[p] = cv[1]; Bs[64 + p] = cv[2]; Cs[p] = cv[3]; Cs[64 + p] = cv[4]; }
            __syncthreads();
            if (act) {
            const float dt = dtv[(rbase + t) * 32 + dir * 16 + h]; const float dec = __expf(dt * Aneg); const float xd = cv[0] * dt;
            float y = 0.f;
#pragma unroll
            for (int n = 0; n < 128; ++n) { hs[n] = hs[n] * dec + Bs[n] * xd; y += Cs[n] * hs[n]; }
            if (seg == 1) { if (dir == 0) y += Dsk * cv[0]; yout[(rbase + t) * 1024 + h * 64 + p] = (bf16)f2bf(y); }
            }
        }
    }
    }
}
DEVI void phase_four_naive(const Ptrs& P, const Frame& F) {
    LAS float* tab = (LAS float*)F.lds;
    for (int i = F.tid; i < 4096; i += 512) { const float a = (float)i * (2.0f / 4096.0f); tab[2 * i] = cospif(a); tab[2 * i + 1] = sinpif(a); }
    __syncthreads();
    const int d = F.tid & 127, ks = F.tid >> 7;
    for (int u = F.vcu; u < 8 * 4 * 128; u += F.G) { const int b = u >> 9, g = (u >> 7) & 3, k0 = (u & 127) * 32;
        const bf16* Y = (const bf16*)(P.ws + WS_YZ) + (size_t)b * SEQ * 1024 + g * 256 + d;
        float acc[8]; int kk[8];
#pragma unroll
        for (int i = 0; i < 8; ++i) { kk[i] = k0 + ks * 8 + i; acc[i] = 0.f; }
        for (int l = 0; l < SEQ; ++l) { const float yr = bf2f(Y[(size_t)l * 1024]), yi = bf2f(Y[(size_t)l * 1024 + 128]);
#pragma unroll
            for (int i = 0; i < 8; ++i) { const int ti = ((kk[i] * l) & 4095) * 2; acc[i] += tab[ti] * yr + tab[ti + 1] * yi; } }
        bf16* out = (bf16*)(P.ws + WS_MIX);
#pragma unroll
        for (int i = 0; i < 8; ++i) out[((size_t)b * SEQ + kk[i]) * DMIX + 1024 + g * 128 + d] = (bf16)f2bf(acc[i] * (1.f / 64.f)); }
    __syncthreads();
}
DEVI void phase_combine(const Ptrs& P, const Frame& F) {
    const int gw = F.vcu * NWAVES + F.wave, NGW = F.G * NWAVES, lane = F.lane;
    constexpr int R = 4;
    for (int row0 = gw; row0 < TL; row0 += R * NGW) {
        v4u ya[R][2], yb[R][2], zz[R][2];
#pragma unroll
        for (int r = 0; r < R; ++r) { const size_t ro = (size_t)(row0 + r * NGW) * 1024;
#pragma unroll
            for (int j = 0; j < 2; ++j) { const int c0 = (lane + 64 * j) * 8; ya[r][j] = *(const v4u*)((const bf16*)(P.ws + WS_YF) + ro + c0); yb[r][j] = *(const v4u*)((const bf16*)(P.ws + WS_YB) + ro + c0); zz[r][j] = *(const v4u*)((const bf16*)(P.ws + WS_ZS) + ro + c0); } }
#pragma unroll
        for (int r = 0; r < R; ++r) { float v[16]; float s = 0.f;
#pragma unroll
            for (int j = 0; j < 2; ++j)
#pragma unroll
                for (int i = 0; i < 4; ++i) { const float y0 = (__uint_as_float(ya[r][j][i] << 16) + __uint_as_float(yb[r][j][i] << 16)) * __uint_as_float(zz[r][j][i] << 16);
                    const float y1 = (__uint_as_float(ya[r][j][i] & 0xffff0000u) + __uint_as_float(yb[r][j][i] & 0xffff0000u)) * __uint_as_float(zz[r][j][i] & 0xffff0000u);
                    v[j * 8 + 2 * i] = y0; v[j * 8 + 2 * i + 1] = y1; s += y0 * y0 + y1 * y1; }
            const float rstd = rsqrtf(wave_sum(s) * (1.f / 1024.f) + EPS);
            bf16* dst = (bf16*)(P.ws + WS_MIX) + (size_t)(row0 + r * NGW) * DMIX;
#pragma unroll
            for (int j = 0; j < 2; ++j) { const int c0 = (lane + 64 * j) * 8; const f32x4 n0 = *(const f32x4*)(P.ssd_norm + c0), n1 = *(const f32x4*)(P.ssd_norm + c0 + 4);
                v4u o; o.x = pk2(v[j * 8 + 0] * rstd * n0[0], v[j * 8 + 1] * rstd * n0[1]); o.y = pk2(v[j * 8 + 2] * rstd * n0[2], v[j * 8 + 3] * rstd * n0[3]);
                o.z = pk2(v[j * 8 + 4] * rstd * n1[0], v[j * 8 + 5] * rstd * n1[1]); o.w = pk2(v[j * 8 + 6] * rstd * n1[2], v[j * 8 + 7] * rstd * n1[3]);
                *(v4u*)(dst + c0) = o; } }
    }
}
DEVI void phase_expert_weights(const Ptrs& P, const Frame& F) {
    LAS float* scr = (LAS float*)(F.lds + F.wave * 16384); const int gw = F.vcu * NWAVES + F.wave, NGW = F.G * NWAVES;
    bf16* Wup = (bf16*)(P.ws + WS_WUP); bf16* Wdn = (bf16*)(P.ws + WS_WDN);
    constexpr int I_UP = 32 * 2 * 256, I_DN = 32 * 256;
    for (int it = gw; it < I_UP + I_DN; it += NGW) {
        if (it < I_UP) { const int e = it >> 9, half = (it >> 8) & 1, r = it & 255, kb = r >> 4, nb = r & 15, n0 = nb * 32;
            const float* W = (half ? P.w_eu : P.w_eg) + (size_t)e * DM * DE;
            transpose_item(W, DE, Wup, DM, e * 1024 + (n0 >> 7) * 256 + half * 128 + (n0 & 127) - n0, kb * 64, n0, scr, F.lane); }
        else { const int r2 = it - I_UP, e = r2 >> 8, r = r2 & 255, kb = r >> 5, nb = r & 31;
            transpose_item(P.w_ed + (size_t)e * DE * DM, DM, Wdn, DE, e * 1024, kb * 64, nb * 32, scr, F.lane); } }
}
template <int R>
DEVI void h2_rows(const Ptrs& P, const int (&rows)[R], int lane, float (&t)[R][16]) {
    v4u xa[R][2];
#pragma unroll
    for (int r = 0; r < R; ++r)
#pragma unroll
        for (int j = 0; j < 2; ++j) xa[r][j] = *(const v4u*)((const bf16*)(P.ws + WS_X1) + (size_t)rows[r] * DM + (lane + 64 * j) * 8);
    float rstd[R];
#pragma unroll
    for (int r = 0; r < R; ++r) { float s = 0.f;
#pragma unroll
        for (int j = 0; j < 2; ++j)
#pragma unroll
            for (int i = 0; i < 4; ++i) { const float lo = __uint_as_float(xa[r][j][i] << 16), hi = __uint_as_float(xa[r][j][i] & 0xffff0000u); t[r][j * 8 + 2 * i] = lo; t[r][j * 8 + 2 * i + 1] = hi; s += lo * lo + hi * hi; }
        rstd[r] = s; }
#pragma unroll
    for (int o = 1; o < 64; o <<= 1)
#pragma unroll
        for (int r = 0; r < R; ++r) rstd[r] += __shfl_xor(rstd[r], o);
#pragma unroll
    for (int r = 0; r < R; ++r) { rstd[r] = rsqrtf(rstd[r] * (1.f / DM) + EPS); const float* mod = (const float*)(P.ws + WS_MOD) + (rows[r] / SEQ) * 6144;
#pragma unroll
        for (int j = 0; j < 2; ++j) { const int c0 = (lane + 64 * j) * 8;
#pragma unroll
            for (int hh = 0; hh < 2; ++hh) { const f32x4 nw = *(const f32x4*)(P.norm2 + c0 + 4 * hh), sh = *(const f32x4*)(mod + 3072 + c0 + 4 * hh), sc = *(const f32x4*)(mod + 4096 + c0 + 4 * hh);
#pragma unroll
                for (int i = 0; i < 4; ++i) t[r][j * 8 + hh * 4 + i] = t[r][j * 8 + hh * 4 + i] * rstd[r] * nw[i] * (1.f + sc[i]) + sh[i]; } } }
}
DEVI void phase_route(const Ptrs& P, const Frame& F, bool dry) {
    const int gw = F.vcu * NWAVES + F.wave, NGW = F.G * NWAVES, lane = F.lane;
    constexpr int R = 2;
    LAS unsigned* lcnt = (LAS unsigned*)(F.lds + LDSCTL_OFF + LC_CNT);
    if (F.tid < 64) lcnt[F.tid] = 0u;
    __syncthreads();
    int* eid = (int*)(P.ws + WS_ROUTE); int* pos = eid + 65536; float* gate = (float*)(pos + 65536);
    for (int row0 = gw; row0 < TL; row0 += R * NGW) {
        int rows[R];
#pragma unroll
        for (int r = 0; r < R; ++r) rows[r] = row0 + r * NGW;
        float t[R][16]; h2_rows<R>(P, rows, lane, t);
        float lg[R][4];
#pragma unroll
        for (int r = 0; r < R; ++r)
#pragma unroll
            for (int q = 0; q < 4; ++q) lg[r][q] = 0.f;
#pragma unroll
        for (int j = 0; j < 2; ++j)
#pragma unroll
            for (int i = 0; i < 8; ++i) { const f32x4 w = *(const f32x4*)(P.w_rg + (size_t)((lane + 64 * j) * 8 + i) * 4);
#pragma unroll
                for (int r = 0; r < R; ++r)
#pragma unroll
                    for (int q = 0; q < 4; ++q) lg[r][q] += t[r][j * 8 + i] * w[q]; }
#pragma unroll
        for (int o = 1; o < 64; o <<= 1)
#pragma unroll
            for (int r = 0; r < R; ++r)
#pragma unroll
                for (int q = 0; q < 4; ++q) lg[r][q] += __shfl_xor(lg[r][q], o);
        int grp[R]; float pgrp[R];
#pragma unroll
        for (int r = 0; r < R; ++r) { float mx = lg[r][0] + P.b_rg[0]; int gi = 0;
#pragma unroll
            for (int q = 0; q < 4; ++q) lg[r][q] += P.b_rg[q];
            mx = lg[r][0];
#pragma unroll
            for (int q = 1; q < 4; ++q) if (lg[r][q] > mx) { mx = lg[r][q]; gi = q; }
            float den = 0.f;
#pragma unroll
            for (int q = 0; q < 4; ++q) den += __expf(lg[r][q] - mx);
            grp[r] = gi; pgrp[r] = 1.f / den; }
        float le[R][8];
#pragma unroll
        for (int r = 0; r < R; ++r)
#pragma unroll
            for (int q = 0; q < 8; ++q) le[r][q] = 0.f;
#pragma unroll
        for (int j = 0; j < 2; ++j)
#pragma unroll
            for (int i = 0; i < 8; ++i)
#pragma unroll
                for (int r = 0; r < R; ++r) { const float* wp = P.w_re + ((size_t)grp[r] * DM + (lane + 64 * j) * 8 + i) * 8; const f32x4 w0 = *(const f32x4*)wp, w1 = *(const f32x4*)(wp + 4);
#pragma unroll
                    for (int q = 0; q < 4; ++q) { le[r][q] += t[r][j * 8 + i] * w0[q]; le[r][4 + q] += t[r][j * 8 + i] * w1[q]; } }
#pragma unroll
        for (int o = 1; o < 64; o <<= 1)
#pragma unroll
            for (int r = 0; r < R; ++r)
#pragma unroll
                for (int q = 0; q < 8; ++q) le[r][q] += __shfl_xor(le[r][q], o);
#pragma unroll
        for (int r = 0; r < R; ++r) { const int row = rows[r];
#pragma unroll
            for (int q = 0; q < 8; ++q) le[r][q] += P.b_re[grp[r] * 8 + q];
            int j0 = 0; float m0 = le[r][0];
#pragma unroll
            for (int q = 1; q < 8; ++q) if (le[r][q] > m0) { m0 = le[r][q]; j0 = q; }
            int j1 = 0; float m1 = -3.0e38f;
#pragma unroll
            for (int q = 0; q < 8; ++q) if (q != j0 && le[r][q] > m1) { m1 = le[r][q]; j1 = q; }
            const float e1 = __expf(m1 - m0);
            if (lane == 0 && !dry) { const int ea = grp[r] * 8 + j0, eb = grp[r] * 8 + j1;
                eid[row * 2] = ea; eid[row * 2 + 1] = eb; gate[row * 2] = pgrp[r] / (1.f + e1); gate[row * 2 + 1] = pgrp[r] * e1 / (1.f + e1);
                const int it = (row - gw) / NGW; LAS int* rt = (LAS int*)(F.lds + LDSCTL_OFF + LC_RT) + (F.wave * 16 + (it & 15)) * 4;
                rt[0] = ea; rt[1] = eb; rt[2] = (int)__hip_atomic_fetch_add(&lcnt[ea], 1u, __ATOMIC_RELAXED, __HIP_MEMORY_SCOPE_WORKGROUP); rt[3] = (int)__hip_atomic_fetch_add(&lcnt[eb], 1u, __ATOMIC_RELAXED, __HIP_MEMORY_SCOPE_WORKGROUP); }
            if (dry) asm volatile("" :: "v"(e1), "v"(j0), "v"(j1), "v"(pgrp[r])); }
    }
    __syncthreads();
    if (dry) return;
    if (F.tid < 32) lcnt[32 + F.tid] = __hip_atomic_fetch_add((unsigned*)(P.ws + WS_CTL) + CW_CNT + F.tid, lcnt[F.tid], RLX_AGENT);
    __syncthreads();
    for (int row = gw; row < TL; row += NGW) if (lane < 2) { const int it = (row - gw) / NGW; const LAS int* rt = (const LAS int*)(F.lds + LDSCTL_OFF + LC_RT) + (F.wave * 16 + (it & 15)) * 4;
        pos[row * 2 + lane] = rt[2 + lane] + (int)lcnt[32 + rt[lane]]; }
    __syncthreads();
}
DEVI int build_tile_table(const Ptrs& P, const Frame& F) {
    LAS int* tile_e = (LAS int*)(F.lds + LDSCTL_OFF + LC_TILE); LAS unsigned* lcnt = (LAS unsigned*)(F.lds + LDSCTL_OFF + LC_CNT);
    __syncthreads();
    if (F.tid < 32) lcnt[F.tid] = __hip_atomic_load((unsigned*)(P.ws + WS_CTL) + CW_CNT + F.tid, RLX_AGENT);
    __syncthreads();
    if (F.tid == 0) { int s = 0; for (int e = 0; e < NE; ++e) { const int nt = (int)((lcnt[e] + 255u) >> 8); lcnt[64 + e] = (unsigned)(s * 256); for (int i = 0; i < nt; ++i) tile_e[s + i] = e; s += nt; } lcnt[96] = (unsigned)s; }
    __syncthreads();
    return (int)lcnt[96];
}
DEVI void phase_gather(const Ptrs& P, const Frame& F) {
    build_tile_table(P, F);
    const LAS unsigned* lcnt = (const LAS unsigned*)(F.lds + LDSCTL_OFF + LC_CNT);
    const int gw = F.vcu * NWAVES + F.wave, NGW = F.G * NWAVES, lane = F.lane;
    constexpr int R = 4;
    const int* eid = (const int*)(P.ws + WS_ROUTE); const int* pos = eid + 65536; const float* gate = (const float*)(pos + 65536);
    int* rowdest = (int*)(P.ws + WS_ROUTE + 3 * 262144); float* rowgate = (float*)(rowdest + RPAD);
    for (int row0 = gw; row0 < TL; row0 += R * NGW) {
        int rows[R];
#pragma unroll
        for (int r = 0; r < R; ++r) rows[r] = row0 + r * NGW;
        float t[R][16]; h2_rows<R>(P, rows, lane, t);
#pragma unroll
        for (int r = 0; r < R; ++r) { const int row = rows[r];
            const int r0 = (int)lcnt[64 + eid[row * 2]] + pos[row * 2], r1 = (int)lcnt[64 + eid[row * 2 + 1]] + pos[row * 2 + 1];
            bf16* d0 = (bf16*)(P.ws + WS_HPERM) + (size_t)r0 * DM; bf16* d1 = (bf16*)(P.ws + WS_HPERM) + (size_t)r1 * DM;
#pragma unroll
            for (int j = 0; j < 2; ++j) { v4u o; o.x = pk2(t[r][j * 8], t[r][j * 8 + 1]); o.y = pk2(t[r][j * 8 + 2], t[r][j * 8 + 3]); o.z = pk2(t[r][j * 8 + 4], t[r][j * 8 + 5]); o.w = pk2(t[r][j * 8 + 6], t[r][j * 8 + 7]);
                *(v4u*)(d0 + (lane + 64 * j) * 8) = o; *(v4u*)(d1 + (lane + 64 * j) * 8) = o; }
            if (lane == 0) { rowdest[r0] = row * 2; rowgate[r0] = gate[row * 2]; rowdest[r1] = row * 2 + 1; rowgate[r1] = gate[row * 2 + 1]; } }
    }
}
DEVI void phase_final(const Ptrs& P, const Frame& F, float* outp) {
    const int gw = F.vcu * NWAVES + F.wave, NGW = F.G * NWAVES, lane = F.lane;
    constexpr int R = 4;
    for (int row0 = gw; row0 < TL; row0 += R * NGW) {
        v4u xa[R][2], ya[R][2], yb[R][2];
#pragma unroll
        for (int r = 0; r < R; ++r) { const size_t row = (size_t)(row0 + r * NGW);
#pragma unroll
            for (int j = 0; j < 2; ++j) { const int c0 = (lane + 64 * j) * 8; xa[r][j] = *(const v4u*)((const bf16*)(P.ws + WS_X1) + row * DM + c0);
                ya[r][j] = *(const v4u*)((const bf16*)(P.ws + WS_YBUF) + row * 2 * DM + c0); yb[r][j] = *(const v4u*)((const bf16*)(P.ws + WS_YBUF) + row * 2 * DM + DM + c0); } }
#pragma unroll
        for (int r = 0; r < R; ++r) { const int row = row0 + r * NGW; const float* g2 = (const float*)(P.ws + WS_MOD) + (row / SEQ) * 6144 + 5120;
            float v[16]; float s = 0.f;
#pragma unroll
            for (int j = 0; j < 2; ++j) { const int c0 = (lane + 64 * j) * 8; const f32x4 ga = *(const f32x4*)(g2 + c0), gb = *(const f32x4*)(g2 + c0 + 4);
                const float gg[8] = {ga[0], ga[1], ga[2], ga[3], gb[0], gb[1], gb[2], gb[3]};
#pragma unroll
                for (int i = 0; i < 4; ++i) { const float o0 = __uint_as_float(xa[r][j][i] << 16) + gg[2 * i] * (__uint_as_float(ya[r][j][i] << 16) + __uint_as_float(yb[r][j][i] << 16));
                    const float o1 = __uint_as_float(xa[r][j][i] & 0xffff0000u) + gg[2 * i + 1] * (__uint_as_float(ya[r][j][i] & 0xffff0000u) + __uint_as_float(yb[r][j][i] & 0xffff0000u));
                    v[j * 8 + 2 * i] = o0; v[j * 8 + 2 * i + 1] = o1; s += o0 * o0 + o1 * o1; } }
            const float rstd = rsqrtf(wave_sum(s) * (1.f / DM) + EPS);
#pragma unroll
            for (int j = 0; j < 2; ++j) { const int c0 = (lane + 64 * j) * 8;
#pragma unroll
                for (int hh = 0; hh < 2; ++hh) { const f32x4 fn = *(const f32x4*)(P.final_norm + c0 + 4 * hh); f32x4 o;
#pragma unroll
                    for (int i = 0; i < 4; ++i) o[i] = v[j * 8 + hh * 4 + i] * rstd * fn[i];
                    *(f32x4*)(outp + (size_t)row * DM + c0 + 4 * hh) = o; } } }
    }
}
typedef short s16x4_t __attribute__((ext_vector_type(4)));
constexpr int S_BS = 0, S_BT = 32768, S_CS = 65536, S_XT = 98304, S_HB = 114688, S_YS = 131072, S_YS_W = 2304, S_SM = S_YS + 8 * S_YS_W;
static_assert(S_SM + 1536 <= LDSCTL_OFF, "ssd LDS map");
DEVI int ssd_sw(int row, int colbyte) { return row * 256 + (colbyte ^ ((row & 15) << 4)); }
DEVI bf16x8 ssd_frag(const LAS unsigned char* tile, int row, int ks, int q) { return *(const LAS bf16x8*)(tile + ssd_sw(row, 64 * ks + 16 * q)); }
DEVI float fast_exp(float x) { return __expf(x); }
DEVI void phase_ssd(const Ptrs& P, const Frame& F) {
    LAS unsigned char* L = F.lds;
    LAS float* acs = (LAS float*)(L + S_SM); LAS float* dtj = acs + 128; LAS float* wj = acs + 256;
    const int w = F.wave;
    const bf16* xbc = (const bf16*)(P.ws + WS_XC); const float* dtv = (const float*)(P.ws + WS_DTV);
    for (int id = F.vcu; id < 256; id += F.G) {
    const int dir = id & 1, h = (id >> 1) & 15, b = id >> 5, g = h >> 2;
    bf16* yout = (bf16*)(P.ws + (dir ? WS_YB : WS_YF));
    const float Aneg = -__expf(P.a_log[dir * 16 + h]); const float Dsk = dir == 0 ? P.d_skip[h] : 0.f;
    const int jt = (w < 4) ? 2 * w : 15 - 2 * w;
    f32x4 acc_h[4];
#pragma unroll
    for (int pt = 0; pt < 4; ++pt) acc_h[pt] = (f32x4){0.f, 0.f, 0.f, 0.f};
    float dA, dB; unsigned raw[5][8];
#define SSD_GEOM(stp) const bool isx = (stp) >= 2; const int len = isx ? SEQ : CTX; const size_t rbase = isx ? (size_t)b * SEQ : (size_t)TL + (size_t)b * CTX; \
        const int t0 = 128 * (isx ? (dir ? 31 - ((stp) - 2) : (stp) - 2) : (dir ? 1 - (stp) : (stp)));
#define SSD_ISSUE(stp, i_lo, i_hi, with_dt) do { SSD_GEOM(stp) int ln = F.lane; asm volatile("" : "+v"(ln)); \
        if (with_dt) { const int tA = t0 + (dir ? 127 - ln : ln), tB = t0 + (dir ? 63 - ln : 64 + ln); dA = dtv[(rbase + tA) * 32 + dir * 16 + h]; dB = dtv[(rbase + tB) * 32 + dir * 16 + h]; } \
        _Pragma("unroll") for (int i5 = (i_lo); i5 < (i_hi); ++i5) { const int kind = i5 < 2 ? 0 : (i5 < 3 ? 2 : 1); const int tg = kind == 2 ? 2 * w + (ln >> 5) : (w + 8 * (i5 & 1)); \
            const int ch = kind == 0 ? 1024 + g * 128 + 2 * ln : (kind == 1 ? 1536 + g * 128 + 2 * ln : h * 64 + 2 * (ln & 31)); \
            const bf16* src = xbc + (rbase + t0 + 8 * tg) * 2048 + ch; \
            _Pragma("unroll") for (int i = 0; i < 8; ++i) raw[i5][i] = *(const unsigned*)(src + (size_t)i * 2048); } } while (0)
    __syncthreads();
    SSD_ISSUE(0, 0, 5, true);
    for (int stp = 0; stp < 34; ++stp) {
        SSD_GEOM(stp)
        int lane = F.lane; asm volatile("" : "+v"(lane));
        const int c = lane & 15, q = lane >> 4, cq4 = (q ^ c) << 4;
        float a_tot;
        { float sA = dA * Aneg, sB = dB * Aneg;
#define SSD_DPP_ADD(v, sh) v += __builtin_bit_cast(float, __builtin_amdgcn_update_dpp(0, __builtin_bit_cast(int, v), 0x110 + (sh), 0xf, 0xf, true))
          SSD_DPP_ADD(sA, 1); SSD_DPP_ADD(sB, 1); SSD_DPP_ADD(sA, 2); SSD_DPP_ADD(sB, 2); SSD_DPP_ADD(sA, 4); SSD_DPP_ADD(sB, 4); SSD_DPP_ADD(sA, 8); SSD_DPP_ADD(sB, 8);
#undef SSD_DPP_ADD
#define RDL(v, l) __builtin_bit_cast(float, __builtin_amdgcn_readlane(__builtin_bit_cast(int, v), l))
          { const float a0 = RDL(sA, 15), a1 = RDL(sA, 31), a2 = RDL(sA, 47), a3 = RDL(sA, 63);
            const float b0 = RDL(sB, 15), b1 = RDL(sB, 31), b2 = RDL(sB, 47), b3 = RDL(sB, 63);
            const int rw = lane >> 4; const float totA = ((a0 + a1) + a2) + a3;
            sA += rw == 0 ? 0.f : (rw == 1 ? a0 : (rw == 2 ? a0 + a1 : (a0 + a1) + a2));
            sB += totA + (rw == 0 ? 0.f : (rw == 1 ? b0 : (rw == 2 ? b0 + b1 : (b0 + b1) + b2)));
            a_tot = totA + (((b0 + b1) + b2) + b3); }
#undef RDL
          acs[lane] = sA; acs[64 + lane] = sB; dtj[lane] = dA; dtj[64 + lane] = dB; wj[lane] = fast_exp(a_tot - sA); wj[64 + lane] = fast_exp(a_tot - sB); }
        LDS_WAIT(); asm volatile("" ::: "memory");
#pragma unroll
        for (int i5 = 0; i5 < 5; ++i5) {
            const int kind = i5 < 2 ? 0 : (i5 < 3 ? 2 : 1);
            const int tg = kind == 2 ? 2 * w + (lane >> 5) : (w + 8 * (i5 & 1));
            if (kind == 1 && !isx) continue;
            float v[8][2];
#pragma unroll
            for (int o = 0; o < 8; ++o) { v[o][0] = __uint_as_float(raw[i5][o] << 16); v[o][1] = __uint_as_float(raw[i5][o] & 0xffff0000u); }
            const int jg = dir ? 15 - tg : tg;
            if (kind < 2) { LAS unsigned char* rm = L + (kind == 0 ? S_BS : S_CS);
#pragma unroll
                for (int o = 0; o < 8; ++o) { const int j = dir ? 127 - (8 * tg + o) : 8 * tg + o; *(LAS unsigned*)(rm + ssd_sw(j, 4 * lane)) = raw[i5][o]; } }
            if (kind != 1) { const f32x4 s0 = *(const LAS f32x4*)((kind == 0 ? wj : dtj) + 8 * jg), s1 = *(const LAS f32x4*)((kind == 0 ? wj : dtj) + 8 * jg + 4);
                const float sc[8] = {s0[0], s0[1], s0[2], s0[3], s1[0], s1[1], s1[2], s1[3]};
                LAS unsigned char* tt = L + (kind == 0 ? S_BT : S_XT); const int r0 = kind == 0 ? 2 * lane : 2 * (lane & 31);
#pragma unroll
                for (int cc = 0; cc < 2; ++cc) { float e[8];
#pragma unroll
                    for (int ee = 0; ee < 8; ++ee) e[ee] = (dir ? v[7 - ee][cc] : v[ee][cc]) * sc[ee];
                    v4u o4; o4.x = pk2(e[0], e[1]); o4.y = pk2(e[2], e[3]); o4.z = pk2(e[4], e[5]); o4.w = pk2(e[6], e[7]);
                    *(LAS v4u*)(tt + ssd_sw(r0 + cc, 16 * jg)) = o4; } }
        }
        __syncthreads();
        const float e_tot = fast_exp(a_tot);
        if (stp + 1 < 34) SSD_ISSUE(stp + 1, 0, 2, true);
#define SSD_FRAG(tile_off, rowt, ks) (*(const LAS bf16x8*)(L + (tile_off) + (16 * (rowt) + c) * 256 + ((64 * (ks)) ^ cq4)))
        if (isx) {
            bf16x8 cf[4];
#pragma unroll
            for (int ks = 0; ks < 4; ++ks) cf[ks] = SSD_FRAG(S_CS, jt, ks);
            f32x4 acc_y[4];
            { f32x4 acc_o[4];
#pragma unroll
              for (int pt = 0; pt < 4; ++pt) acc_o[pt] = (f32x4){0.f, 0.f, 0.f, 0.f};
#pragma unroll
              for (int ks = 0; ks < 4; ++ks)
#pragma unroll
                for (int pt = 0; pt < 4; ++pt) acc_o[pt] = __builtin_amdgcn_mfma_f32_16x16x32_bf16(cf[ks], SSD_FRAG(S_HB, pt, ks), acc_o[pt], 0, 0, 0);
              const f32x4 aj = *(const LAS f32x4*)(acs + 16 * jt + 4 * q);
#pragma unroll
              for (int r = 0; r < 4; ++r) { const float ej = fast_exp(aj[r]);
#pragma unroll
                for (int pt = 0; pt < 4; ++pt) acc_y[pt][r] = ej * acc_o[pt][r]; } }
            const float acs_j = acs[16 * jt + c]; const float dsk_j = Dsk * __builtin_amdgcn_rcpf(dtj[16 * jt + c]);
            const int npair = (jt >> 1) + 1;
            for (int t = 0; t < npair; ++t) {
                f32x4 X0 = (f32x4){0.f, 0.f, 0.f, 0.f}, X1 = (f32x4){0.f, 0.f, 0.f, 0.f};
                const int st0 = 2 * t, st1 = 2 * t + 1; const bool has1 = st1 <= jt; const int st1c = has1 ? st1 : st0;
#pragma unroll
                for (int ks = 0; ks < 4; ++ks) { X0 = __builtin_amdgcn_mfma_f32_16x16x32_bf16(SSD_FRAG(S_BS, st0, ks), cf[ks], X0, 0, 0, 0); X1 = __builtin_amdgcn_mfma_f32_16x16x32_bf16(SSD_FRAG(S_BS, st1c, ks), cf[ks], X1, 0, 0, 0); }
                const f32x4 as0 = *(const LAS f32x4*)(acs + 16 * st0 + 4 * q), as1 = *(const LAS f32x4*)(acs + 16 * st1c + 4 * q);
#pragma unroll
                for (int r = 0; r < 4; ++r) { const int sl = 4 * q + r;
                    const float d0 = fast_exp(fminf(acs_j - as0[r], 0.f)), d1 = fast_exp(fminf(acs_j - as1[r], 0.f));
                    float x0 = X0[r] * d0, x1 = X1[r] * d1;
                    if (st0 == jt) { x0 = sl < c ? x0 : (sl == c ? x0 + dsk_j : 0.f); }
                    if (st1 == jt) { x1 = sl < c ? x1 : (sl == c ? x1 + dsk_j : 0.f); }
                    if (!has1) x1 = 0.f;
                    X0[r] = x0; X1[r] = x1; }
                bf16x8 af; { const unsigned a0 = pk2(X0[0], X0[1]), a1 = pk2(X0[2], X0[3]), a2 = pk2(X1[0], X1[1]), a3 = pk2(X1[2], X1[3]);
                    af = (bf16x8){(short)(a0 & 0xffff), (short)(a0 >> 16), (short)(a1 & 0xffff), (short)(a1 >> 16), (short)(a2 & 0xffff), (short)(a2 >> 16), (short)(a3 & 0xffff), (short)(a3 >> 16)}; }
#pragma unroll
                for (int pt = 0; pt < 4; ++pt) { const int p = 16 * pt + c;
                    const s16x4_t b0 = *(const LAS s16x4_t*)(L + S_XT + ssd_sw(p, 64 * t + 8 * q)), b1 = *(const LAS s16x4_t*)(L + S_XT + ssd_sw(p, 64 * t + 32 + 8 * q));
                    const bf16x8 bfr = (bf16x8){b0[0], b0[1], b0[2], b0[3], b1[0], b1[1], b1[2], b1[3]};
                    acc_y[pt] = __builtin_amdgcn_mfma_f32_16x16x32_bf16(af, bfr, acc_y[pt], 0, 0, 0); }
            }
            { LAS unsigned char* ys = L + S_YS + w * S_YS_W;
#pragma unroll
              for (int r = 0; r < 4; ++r)
#pragma unroll
                for (int pt = 0; pt < 4; ++pt) *(LAS bf16*)(ys + (4 * q + r) * 144 + (16 * pt + c) * 2) = (bf16)f2bf(acc_y[pt][r]);
              LDS_WAIT(); asm volatile("" ::: "memory");
              const int row = lane >> 2, cbk = (lane & 3) * 32; const v4u o0 = *(const LAS v4u*)(ys + row * 144 + cbk), o1 = *(const LAS v4u*)(ys + row * 144 + cbk + 16);
              const int j = 16 * jt + row; const int tk = t0 + (dir ? 127 - j : j);
              bf16* dst = yout + (rbase + tk) * 1024 + h * 64 + (lane & 3) * 16; *(v4u*)dst = o0; *(v4u*)(dst + 8) = o1; }
        }
        if (stp + 1 < 34) SSD_ISSUE(stp + 1, 2, 5, false);
#pragma unroll
        for (int pt = 0; pt < 4; ++pt) acc_h[pt] = acc_h[pt] * e_tot;
#pragma unroll
        for (int ks = 0; ks < 4; ++ks) { const bf16x8 af = SSD_FRAG(S_BT, w, ks);
#pragma unroll
            for (int pt = 0; pt < 4; ++pt) acc_h[pt] = __builtin_amdgcn_mfma_f32_16x16x32_bf16(af, SSD_FRAG(S_XT, pt, ks), acc_h[pt], 0, 0, 0); }
        __syncthreads();
#pragma unroll
        for (int pt = 0; pt < 4; ++pt) { u32x2 hv; hv.x = pk2(acc_h[pt][0], acc_h[pt][1]); hv.y = pk2(acc_h[pt][2], acc_h[pt][3]); *(LAS u32x2*)(L + S_HB + ssd_sw(16 * pt + c, 32 * w + 8 * q)) = hv; }
    }
    __syncthreads();
    }
#undef SSD_GEOM
#undef SSD_ISSUE
#undef SSD_FRAG
}
constexpr size_t WS_T1 = 1 * MiB + 512 * 1024;
constexpr int FT_ROWB = 288, FT_TILE = 128 * FT_ROWB;
DEVI int four_rho(int k) { const int kk = k >> 5, gq = (k >> 3) & 3, jj = k & 7; return 32 * kk + 16 * (jj >> 2) + 4 * gq + (jj & 3); }
DEVI void phase_four_tables(const Ptrs& P, const Frame& F) {
    const int gt = F.vcu * 512 + F.tid, NT = F.G * 512;
    bf16* T1 = (bf16*)(P.ws + WS_T1); bf16* T3 = T1 + 128 * 128;
    for (int o = gt; o < 128 * 128 + 64 * 128; o += NT) {
        if (o < 128 * 128) { const int i = o >> 7, k = o & 127, rho = four_rho(k), ro = i >> 6, k1 = i & 63, ri = rho >> 6, l1 = rho & 63;
            const float ang = (float)((k1 * l1) & 63) * (2.0f / 64.0f), c = cospif(ang), s = sinpif(ang);
            const float v = ro == 0 ? (ri == 0 ? c : s) : (ri == 0 ? -s : c); T1[o] = (bf16)f2bf(v * 0.125f); }
        else { const int o2 = o - 128 * 128, k2 = o2 >> 7, k = o2 & 127, rho = four_rho(k), ri = rho >> 6, l2 = rho & 63;
            const float ang = (float)((k2 * l2) & 63) * (2.0f / 64.0f); T3[o2] = (bf16)f2bf((ri == 0 ? cospif(ang) : sinpif(ang)) * 0.125f); }
    }
}
DEVI void four_load_T(const bf16* T, int rows, LAS unsigned char* dst, int tid) {
    for (int cid = tid; cid < rows * 16; cid += 512) { const int r = cid >> 4, ch = cid & 15; *(LAS v4u*)(dst + r * 256 + ((ch ^ (r & 15)) << 4)) = *(const v4u*)(T + r * 128 + ch * 8); }
}
DEVI bf16x8 four_Afrag(const LAS unsigned char* T, int it, int ks, int lane) { const int r = 16 * it + (lane & 15), ch = 4 * ks + (lane >> 4); return *(const LAS bf16x8*)(T + r * 256 + ((ch ^ (r & 15)) << 4)); }
DEVI bf16x8 four_Bfrag(const LAS unsigned char* tile, int dt, int ks, int lane) {
    const int gq = lane >> 4, qq = (lane & 15) >> 2, pp = lane & 3;
    const LAS unsigned char* p = tile + (32 * ks + 4 * gq + qq) * FT_ROWB + (16 * dt + 4 * pp) * 2;
    const s16x4 a = __builtin_amdgcn_ds_read_tr16_b64_v4i16((LAS s16x4*)p), b = __builtin_amdgcn_ds_read_tr16_b64_v4i16((LAS s16x4*)(p + 16 * FT_ROWB));
    return (bf16x8){a[0], a[1], a[2], a[3], b[0], b[1], b[2], b[3]};
}
DEVI void phase_four1(const Ptrs& P, const Frame& F) {
    LAS unsigned char* T = F.lds; LAS unsigned char* buf0 = F.lds + 32768;
    __syncthreads();
    four_load_T((const bf16*)(P.ws + WS_T1), 128, T, F.tid);
    const bf16* Yz = (const bf16*)(P.ws + WS_YZ); bf16* AP = (bf16*)(P.ws + WS_AP);
    const int w = F.wave, lane = F.lane, c = lane & 15, q = lane >> 4;
    v4u st[4];
    auto issue = [&](int u) { const int g = u & 3, l2 = (u >> 2) & 63, b = u >> 8;
#pragma unroll
        for (int i = 0; i < 4; ++i) { const int cid = F.tid + 512 * i, rho = cid >> 4, ch = cid & 15, ri = rho >> 6, l1 = rho & 63;
            st[i] = *(const v4u*)(Yz + ((size_t)b * SEQ + 64 * l1 + l2) * 1024 + g * 256 + ri * 128 + ch * 8); } };
    auto commit = [&](LAS unsigned char* buf) {
#pragma unroll
        for (int i = 0; i < 4; ++i) { const int cid = F.tid + 512 * i, rho = cid >> 4, ch = cid & 15; *(LAS v4u*)(buf + rho * FT_ROWB + ch * 16) = st[i]; } };
    int u = F.vcu; int par = 0;
    if (u < 2048) { issue(u); commit(buf0); }
    __syncthreads();
    for (; u < 2048; u += F.G, par ^= 1) {
        const int un = u + F.G; if (un < 2048) issue(un);
        const LAS unsigned char* tile = buf0 + par * FT_TILE; const int g = u & 3, l2 = (u >> 2) & 63, b = u >> 8;
        f32x4 acc[8];
#pragma unroll
        for (int it = 0; it < 8; ++it) acc[it] = (f32x4){0.f, 0.f, 0.f, 0.f};
#pragma unroll
        for (int ks = 0; ks < 4; ++ks) { const bf16x8 bf = four_Bfrag(tile, w, ks, lane);
#pragma unroll
            for (int it = 0; it < 8; ++it) acc[it] = __builtin_amdgcn_mfma_f32_16x16x32_bf16(four_Afrag(T, it, ks, lane), bf, acc[it], 0, 0, 0); }
#pragma unroll
        for (int it = 0; it < 4; ++it)
#pragma unroll
            for (int r = 0; r < 4; ++r) { const int k1 = 16 * it + 4 * q + r; const float ang = (float)((l2 * k1) & 4095) * (1.0f / 4096.0f);
                const float ct = __builtin_amdgcn_cosf(ang), sn = __builtin_amdgcn_sinf(ang); const float ar = acc[it][r], ai = acc[it + 4][r];
                bf16* dst = AP + (((((size_t)b * 4 + g) * 64 + k1) * 2) * 64 + l2) * 128 + 16 * w + c;
                dst[0] = (bf16)f2bf(ar * ct + ai * sn); dst[64 * 128] = (bf16)f2bf(ai * ct - ar * sn); }
        if (un < 2048) commit(buf0 + (par ^ 1) * FT_TILE);
        __syncthreads();
    }
}
DEVI void phase_four3(const Ptrs& P, const Frame& F) {
    LAS unsigned char* T = F.lds; LAS unsigned char* buf0 = F.lds + 32768;
    __syncthreads();
    four_load_T((const bf16*)(P.ws + WS_T1) + 128 * 128, 64, T, F.tid);
    const bf16* AP = (const bf16*)(P.ws + WS_AP); bf16* mix = (bf16*)(P.ws + WS_MIX);
    const int w = F.wave, lane = F.lane, c = lane & 15, q = lane >> 4;
    v4u st[4];
    auto issue = [&](int u) { const int g = u & 3, k1 = (u >> 2) & 63, b = u >> 8; const bf16* src = AP + ((((size_t)b * 4 + g) * 64 + k1) * 128) * 128;
#pragma unroll
        for (int i = 0; i < 4; ++i) st[i] = *(const v4u*)(src + (size_t)(F.tid + 512 * i) * 8); };
    auto commit = [&](LAS unsigned char* buf) {
#pragma unroll
        for (int i = 0; i < 4; ++i) { const int cid = F.tid + 512 * i, rho = cid >> 4, ch = cid & 15; *(LAS v4u*)(buf + rho * FT_ROWB + ch * 16) = st[i]; } };
    int u = F.vcu; int par = 0;
    if (u < 2048) { issue(u); commit(buf0); }
    __syncthreads();
    for (; u < 2048; u += F.G, par ^= 1) {
        const int un = u + F.G; if (un < 2048) issue(un);
        const LAS unsigned char* tile = buf0 + par * FT_TILE; const int g = u & 3, k1 = (u >> 2) & 63, b = u >> 8;
        f32x4 acc[4];
#pragma unroll
        for (int it = 0; it < 4; ++it) acc[it] = (f32x4){0.f, 0.f, 0.f, 0.f};
#pragma unroll
        for (int ks = 0; ks < 4; ++ks) { const bf16x8 bf = four_Bfrag(tile, w, ks, lane);
#pragma unroll
            for (int it = 0; it < 4; ++it) acc[it] = __builtin_amdgcn_mfma_f32_16x16x32_bf16(four_Afrag(T, it, ks, lane), bf, acc[it], 0, 0, 0); }
#pragma unroll
        for (int it = 0; it < 4; ++it)
#pragma unroll
            for (int r = 0; r < 4; ++r) { const int k2 = 16 * it + 4 * q + r; mix[((size_t)b * SEQ + k1 + 64 * k2) * DMIX + 1024 + g * 128 + 16 * w + c] = (bf16)f2bf(acc[it][r]); }
        if (un < 2048) commit(buf0 + (par ^ 1) * FT_TILE);
        __syncthreads();
    }
}
#ifndef MK_N_LAUNCHES
#define MK_N_LAUNCHES 1
#endif
constexpr int NPHASE = 11;
#ifndef DUPMASK
#define DUPMASK 0
#endif
#define DUP(k) for (int _d = 0; _d < (((DUPMASK) >> (k)) & 1) + 1; ++_d)
DEVI unsigned long long rfl64(unsigned long long v) { const unsigned lo = __builtin_amdgcn_readfirstlane((unsigned)v), hi = __builtin_amdgcn_readfirstlane((unsigned)(v >> 32)); return ((unsigned long long)hi << 32) | lo; }
DEVI void store_ptrs(const Ptrs& A, LAS unsigned long long* lp) { lp[0] = (unsigned long long)A.x; lp[1] = (unsigned long long)A.c; lp[2] = (unsigned long long)A.ctx; lp[3] = (unsigned long long)A.c_ctx; lp[4] = (unsigned long long)A.w_mod; lp[5] = (unsigned long long)A.b_mod; lp[6] = (unsigned long long)A.norm1; lp[7] = (unsigned long long)A.w_in; lp[8] = (unsigned long long)A.conv_w; lp[9] = (unsigned long long)A.conv_b; lp[10] = (unsigned long long)A.dt_bias; lp[11] = (unsigned long long)A.a_log; lp[12] = (unsigned long long)A.d_skip; lp[13] = (unsigned long long)A.ssd_norm; lp[14] = (unsigned long long)A.w_four; lp[15] = (unsigned long long)A.w_out; lp[16] = (unsigned long long)A.norm2; lp[17] = (unsigned long long)A.w_rg; lp[18] = (unsigned long long)A.b_rg; lp[19] = (unsigned long long)A.w_re; lp[20] = (unsigned long long)A.b_re; lp[21] = (unsigned long long)A.w_eg; lp[22] = (unsigned long long)A.w_eu; lp[23] = (unsigned long long)A.w_ed; lp[24] = (unsigned long long)A.final_norm; lp[25] = (unsigned long long)A.out; lp[26] = (unsigned long long)A.ws; }
DEVI void load_ptrs(Ptrs& P, const LAS unsigned long long* lp) { P.x = (const float*)(const GAS float*)rfl64(lp[0]); P.c = (const float*)(const GAS float*)rfl64(lp[1]); P.ctx = (const float*)(const GAS float*)rfl64(lp[2]); P.c_ctx = (const float*)(const GAS float*)rfl64(lp[3]); P.w_mod = (const float*)(const GAS float*)rfl64(lp[4]); P.b_mod = (const float*)(const GAS float*)rfl64(lp[5]); P.norm1 = (const float*)(const GAS float*)rfl64(lp[6]); P.w_in = (const float*)(const GAS float*)rfl64(lp[7]); P.conv_w = (const float*)(const GAS float*)rfl64(lp[8]); P.conv_b = (const float*)(const GAS float*)rfl64(lp[9]); P.dt_bias = (const float*)(const GAS float*)rfl64(lp[10]); P.a_log = (const float*)(const GAS float*)rfl64(lp[11]); P.d_skip = (const float*)(const GAS float*)rfl64(lp[12]); P.ssd_norm = (const float*)(const GAS float*)rfl64(lp[13]); P.w_four = (const float*)(const GAS float*)rfl64(lp[14]); P.w_out = (const float*)(const GAS float*)rfl64(lp[15]); P.norm2 = (const float*)(const GAS float*)rfl64(lp[16]); P.w_rg = (const float*)(const GAS float*)rfl64(lp[17]); P.b_rg = (const float*)(const GAS float*)rfl64(lp[18]); P.w_re = (const float*)(const GAS float*)rfl64(lp[19]); P.b_re = (const float*)(const GAS float*)rfl64(lp[20]); P.w_eg = (const float*)(const GAS float*)rfl64(lp[21]); P.w_eu = (const float*)(const GAS float*)rfl64(lp[22]); P.w_ed = (const float*)(const GAS float*)rfl64(lp[23]); P.final_norm = (const float*)(const GAS float*)rfl64(lp[24]); P.out = (float*)(GAS float*)rfl64(lp[25]); P.ws = (unsigned char*)(GAS unsigned char*)rfl64(lp[26]); }
struct Args { Ptrs P; int ph_lo, ph_hi; };
__global__ void __launch_bounds__(NWAVES * 64, 2) fwd_megakernel(Args args) {
    extern __shared__ __attribute__((aligned(16))) unsigned char lds_raw[];
    Frame F; F.lds = (LAS unsigned char*)lds_raw;
    F.tid = threadIdx.x; F.lane = F.tid & 63; F.wave = __builtin_amdgcn_readfirstlane(F.tid >> 6);
    F.G = gridDim.x; { const int bx = blockIdx.x; F.vcu = (F.G % 8 == 0) ? (bx % 8) * (F.G / 8) + bx / 8 : bx; }
    for (int u = F.tid; u < (LDS_BYTES - LDSCTL_OFF) / 4; u += NWAVES * 64) ((LAS unsigned*)(F.lds + LDSCTL_OFF))[u] = 0u;
    __syncthreads();
    LAS unsigned long long* lp = (LAS unsigned long long*)(F.lds + LDSCTL_OFF + LC_PTR);
    if (F.tid == 0) store_ptrs(args.P, lp);
    unsigned char* const ws0 = args.P.ws;
    __syncthreads();
#define LOADP Ptrs P; load_ptrs(P, lp); asm volatile("" : "+v"(F.tid) :: "memory"); F.lane = F.tid & 63
    XcdBarrier bar; bar.bar = (unsigned*)(ws0 + WS_CTL) + CW_BAR; bar.x = 0; bar.st = nullptr;
    const bool one = (args.ph_hi - args.ph_lo) > 1;
    if (one) bar = xcd_barrier_post((unsigned*)(ws0 + WS_CTL) + CW_BAR, (volatile LAS unsigned*)(F.lds + LDSCTL_OFF + LC_MISC) + 8);
    const int lo = args.ph_lo, hi = args.ph_hi;
#define IN(k) (lo <= (k) && (k) < hi)
#define SEAM(k) do { if (IN(k) && IN((k) + 1)) { xcd_barrier(bar); if ((DUPMASK >> 14) & 1) xcd_barrier(bar); } } while (0)
    if (IN(0)) { LOADP; DUP(0) { phase0a(P, F); phase_four_tables(P, F); } } SEAM(0);
    if (IN(1)) { LOADP; DUP(1) phase0b(P, F); } SEAM(1);
    if (IN(2)) { LOADP;
        pg8::Gemm g{(const bf16*)(P.ws + WS_XN), (const bf16*)(P.ws + WS_WIN), TA, NIN, DM}; pg8::InProjOrder S{F.G, (int)blockIdx.x};
        pg8::EpiInProj E{(bf16*)(P.ws + WS_ZS), (bf16*)(P.ws + WS_XBC), (bf16*)(P.ws + WS_YZ), (float*)(P.ws + WS_DTV), P.dt_bias};
        if ((DUPMASK >> 2) & 1) { pg8::gemm_phase<pg8::EpiInProj, pg8::InProjOrder, true, true>(F.lds, g, S, E); __syncthreads(); asm volatile("" : "+v"(F.tid) :: "memory"); }
        pg8::gemm_phase<pg8::EpiInProj, pg8::InProjOrder, true, true>(F.lds, g, S, E);
    } SEAM(2);
    if (IN(3)) { LOADP; DUP(11) phase_conv(P, F); asm volatile("" : "+v"(F.tid) :: "memory"); F.lane = F.tid & 63; DUP(4) phase_four1(P, F); } SEAM(3);
    if (IN(4)) { LOADP; DUP(3) phase_ssd(P, F); } SEAM(4);
    if (IN(5)) { LOADP; DUP(4) phase_four3(P, F); DUP(5) phase_combine(P, F); } SEAM(5);
    if (IN(6)) { LOADP;
        pg8::Gemm g{(const bf16*)(P.ws + WS_MIX), (const bf16*)(P.ws + WS_WOUT), TL, DM, DMIX}; pg8::StaticOrder S; S.init(TL, DM, F.G, (int)blockIdx.x);
        pg8::EpiOutProj E{P.x, (bf16*)(P.ws + WS_X1), (const float*)(P.ws + WS_MOD)};
        DUP(6) pg8::gemm_phase<pg8::EpiOutProj, pg8::StaticOrder, true, true>(F.lds, g, S, E);
        DUP(7) phase_expert_weights(P, F);
    } SEAM(6);
    if (IN(7)) { LOADP; if ((DUPMASK >> 12) & 1) phase_route(P, F, true); phase_route(P, F, false); } SEAM(7);
    if (IN(8)) { LOADP; DUP(8) phase_gather(P, F); } SEAM(8);
    if (IN(9)) { LOADP;
        const int nt = build_tile_table(P, F);
        pg8::MoeOrder S{(const LAS int*)(F.lds + LDSCTL_OFF + LC_TILE), nt, F.G, (int)blockIdx.x};
        pg8::Gemm g{(const bf16*)(P.ws + WS_HPERM), (const bf16*)(P.ws + WS_WUP), RPAD, NE * 1024, DM};
        pg8::EpiUp E{(bf16*)(P.ws + WS_ACT)};
        DUP(9) pg8::gemm_phase<pg8::EpiUp, pg8::MoeOrder, true, true>(F.lds, g, S, E);
    } SEAM(9);
    if (IN(10)) { LOADP;
        const int nt = build_tile_table(P, F);
        pg8::MoeOrder S{(const LAS int*)(F.lds + LDSCTL_OFF + LC_TILE), nt, F.G, (int)blockIdx.x};
        pg8::Gemm g{(const bf16*)(P.ws + WS_ACT), (const bf16*)(P.ws + WS_WDN), RPAD, NE * 1024, DE};
        pg8::EpiDown E{(bf16*)(P.ws + WS_YBUF), (const int*)(P.ws + WS_ROUTE + 3 * 262144), (const float*)(P.ws + WS_ROUTE + 3 * 262144 + 4 * RPAD)};
        DUP(10) pg8::gemm_phase<pg8::EpiDown, pg8::MoeOrder, true, true>(F.lds, g, S, E);
    } SEAM(10);
    if (IN(11)) { LOADP; if ((DUPMASK >> 13) & 1) phase_final(P, F, (float*)(P.ws + WS_XC)); phase_final(P, F, P.out); }
#undef IN
#undef SEAM
}

extern "C" void kernel_launch(void* const* d_in, const int* in_sizes, int n_in, void* d_out, int out_size, void* d_ws, size_t ws_size, hipStream_t stream) {
    static int grid = 0;
    if (grid == 0) {
        if (n_in != 25 || in_sizes[0] != TL * DM || out_size != TL * DM || ws_size < WS_END) { fprintf(stderr, "kernel_launch: unexpected shapes (n_in %d, ws %zu)\n", n_in, ws_size); grid = -1; return; }
        int dev = 0, cus = 0, per_cu = 0;
        if (hipGetDevice(&dev) != hipSuccess || hipDeviceGetAttribute(&cus, hipDeviceAttributeMultiprocessorCount, dev) != hipSuccess) { grid = -1; return; }
        if (hipFuncSetAttribute((const void*)fwd_megakernel, hipFuncAttributeMaxDynamicSharedMemorySize, LDS_BYTES) != hipSuccess) { fprintf(stderr, "kernel_launch: hipFuncSetAttribute failed\n"); grid = -1; return; }
        if (hipOccupancyMaxActiveBlocksPerMultiprocessor(&per_cu, (const void*)fwd_megakernel, NWAVES * 64, LDS_BYTES) != hipSuccess || per_cu < 1) fprintf(stderr, "kernel_launch: occupancy query reports %d\n", per_cu);
        (void)hipGetLastError();
        grid = cus;
        if (grid != 256) fprintf(stderr, "kernel_launch: built for 256 CUs, got %d\n", grid);
    }
    if (grid < 0) return;
    (void)hipMemsetAsync((char*)d_ws + WS_CTL, 0, CTL_ZERO_BYTES, stream);
    Args a{};
    const float** pp = (const float**)&a.P;
    for (int i = 0; i < 25; ++i) pp[i] = (const float*)d_in[i];
    a.P.out = (float*)d_out; a.P.ws = (unsigned char*)d_ws;
#if MK_N_LAUNCHES == 1
    a.ph_lo = 0; a.ph_hi = NPHASE + 1;
    hipLaunchKernelGGL(fwd_megakernel, dim3(grid), dim3(NWAVES * 64), LDS_BYTES, stream, a);
#else
    for (int ph = 0; ph <= NPHASE; ++ph) { a.ph_lo = ph; a.ph_hi = ph + 1; hipLaunchKernelGGL(fwd_megakernel, dim3(grid), dim3(NWAVES * 64), LDS_BYTES, stream, a); }
#endif
}
```

```cpp
#include <hip/hip_runtime.h>
#include <cstdio>
#include <cstdint>
namespace pg8 {
#define PG8_LAS __attribute__((address_space(3)))
typedef unsigned short bf16_t;
typedef short bf16x8 __attribute__((ext_vector_type(8)));
typedef float f32x4 __attribute__((ext_vector_type(4)));
typedef unsigned u32x4 __attribute__((ext_vector_type(4)));
constexpr int BM = 256, BK = 64, HALF = 128, HTB = HALF * BK * 2  , STAGE_BYTES = 8 * HTB, NXCD = 8, WGM = 8;

__host__ __device__ __forceinline__ int lds_byte(int r, int c) { const int st = (r >> 4) * 2 + (c >> 5), rr = r & 15, cc = c & 31, ob = rr * 64 + cc * 2; return st * 1024 + (ob ^ (((ob >> 9) & 1) << 5)); }
__host__ __device__ __forceinline__ void stage_rc(int b, int& R, int& C) { const int st = b / 1024, sb = b % 1024, swz = sb ^ (((sb >> 9) & 1) << 5); R = (st >> 1) * 16 + swz / 64; C = (st & 1) * 32 + (swz % 64) / 2; }
__host__ __device__ __forceinline__ int perm32(int rho) { const int n = rho >> 4, i = rho & 15; return 8 * (i >> 2) + 4 * n + (i & 3); }

struct Unit { int pm, pn; };
struct Gemm { const bf16_t* A; const bf16_t* Bt; int M, N, K; const int* gat = nullptr; int scale_a = 0x7f7f7f7f, scale_b = 0x7f7f7f7f; int k8 = 0; const float* sa = nullptr; float* stamp = nullptr; };

struct OneUnit {
    int pm, pn;
    __device__ __forceinline__ bool next(int i, Unit& u) const { if (i != 0) return false; u.pm = pm; u.pn = pn; return true; }
    __device__ __forceinline__ void a_ready(const Unit&) const {}
    __device__ __forceinline__ void done(const Unit&) const {}
};
struct StaticOrder {
    int nM, nN, nwg, G, c;
    __host__ __device__ void init(int M, int N, int G_, int c_) { nM = M / BM; nN = N / BM; nwg = nM * nN; G = G_; c = c_; }
    __host__ __device__ bool next(int i, Unit& u) const {
        const long L = (long)i * G + c; if (L >= nwg) return false;
        int wgid = (int)L; { const int q = nwg / NXCD, r = nwg % NXCD, xcd = wgid % NXCD, off = wgid / NXCD; wgid = (xcd < r ? xcd * (q + 1) : r * (q + 1) + (xcd - r) * q) + off; }
        const int nig = WGM * nN, gid = wgid / nig, fm = gid * WGM, gsz = (nM - fm) < WGM ? (nM - fm) : WGM;
        u.pm = fm + ((wgid % nig) % gsz); u.pn = (wgid % nig) / gsz; return true;
    }
    __device__ __forceinline__ void a_ready(const Unit&) const {}
    __device__ __forceinline__ void done(const Unit&) const {}
};

__device__ __forceinline__ unsigned cvt_pk_bf16(float lo, float hi) { unsigned r; asm volatile("v_cvt_pk_bf16_f32 %0, %1, %2" : "=v"(r) : "v"(lo), "v"(hi)); return r; }
typedef float f32x2 __attribute__((ext_vector_type(2)));
__device__ __forceinline__ float silu_f(float v) { return v * __builtin_amdgcn_rcpf(1.f + __expf(-v)); }
__device__ __forceinline__ float softplus_f(float v) { return v > 20.f ? v : log1pf(__expf(v)); }
struct EpiInProj {
    static constexpr bool PERM = true, AFTER_DRAIN = false, HAS_PRE = false;
    bf16_t* zs; bf16_t* xbc; bf16_t* yz; float* dtv; const float* dt_bias;
    __device__ __forceinline__ void operator()(const f32x4 (&acc)[2][2][4][2], const Unit& u, int wr, int wc, int fr, int fq) const {
        const int row0 = u.pm * BM + wr * 64 + fr; const int pn = u.pn;
        if (pn == 14) {
            if (wc == 0) {
                f32x4 bv[2];
#pragma unroll
                for (int n = 0; n < 2; ++n) bv[n] = *(const f32x4*)(dt_bias + 8 * fq + 4 * n);
#pragma unroll
                for (int ai = 0; ai < 2; ++ai)
#pragma unroll
                    for (int m = 0; m < 4; ++m) { float* rp = dtv + (size_t)(row0 + ai * HALF + m * 16) * 32 + 8 * fq;
#pragma unroll
                        for (int n = 0; n < 2; ++n) { const f32x4 v = acc[ai][0][m][n] + bv[n]; f32x4 o; o[0] = softplus_f(v[0]); o[1] = softplus_f(v[1]); o[2] = softplus_f(v[2]); o[3] = softplus_f(v[3]); *(f32x4*)(rp + 4 * n) = o; } }
            }
            return;
        }
        bf16_t* base; int ldc, colt; bool act = false;
        if (pn < 4) { base = zs; ldc = 1024; colt = pn * 256; act = true; } else if (pn < 12) { base = xbc; ldc = 2048; colt = (pn - 4) * 256; } else { base = yz; ldc = 512; colt = (pn - 12) * 256; }
        const int col0 = colt + wc * 32 + 8 * fq;
#pragma unroll
        for (int ai = 0; ai < 2; ++ai)
#pragma unroll
            for (int m = 0; m < 4; ++m) { bf16_t* rowp = base + (size_t)(row0 + ai * HALF + m * 16) * ldc + col0;
#pragma unroll
                for (int bj = 0; bj < 2; ++bj) { f32x4 v0 = acc[ai][bj][m][0], v1 = acc[ai][bj][m][1];
                    if (act) { v0[0] = silu_f(v0[0]); v0[1] = silu_f(v0[1]); v0[2] = silu_f(v0[2]); v0[3] = silu_f(v0[3]); v1[0] = silu_f(v1[0]); v1[1] = silu_f(v1[1]); v1[2] = silu_f(v1[2]); v1[3] = silu_f(v1[3]); }
                    u32x4 w; w.x = cvt_pk_bf16(v0[0], v0[1]); w.y = cvt_pk_bf16(v0[2], v0[3]); w.z = cvt_pk_bf16(v1[0], v1[1]); w.w = cvt_pk_bf16(v1[2], v1[3]);
                    *(u32x4*)(rowp + bj * HALF) = w; } }
    }
};
typedef int pg8_v4i __attribute__((ext_vector_type(4)));
struct EpiInProjI8 {
    static constexpr bool PERM = true, AFTER_DRAIN = false, HAS_PRE = false;
    bf16_t* zs; bf16_t* xbc; bf16_t* yz; float* dtv; const float* dt_bias; const float* sa; const float* sb;
    const PG8_LAS float* tab; mutable int k;
    __device__ __forceinline__ void operator()(const pg8_v4i (&acc)[2][2][4][2], const Unit& u, int wr, int wc, int fr, int fq) const {
        const int row0 = u.pm * BM + wr * 64 + fr; const int pn = u.pn;
        const PG8_LAS float* sap = tab + k * 512 + wr * 64 + fr; const PG8_LAS float* sbp = tab + k * 512 + 256 + wc * 32 + 8 * fq; ++k;
        float rav[2][4];
#pragma unroll
        for (int ai = 0; ai < 2; ++ai)
#pragma unroll
            for (int m = 0; m < 4; ++m) rav[ai][m] = sap[ai * HALF + m * 16];
        if (pn == 14) {
            if (wc == 0) {
                f32x4 bv[2], sv[2];
#pragma unroll
                for (int n = 0; n < 2; ++n) { bv[n] = *(const f32x4*)(dt_bias + 8 * fq + 4 * n); sv[n] = *(const PG8_LAS f32x4*)(sbp + 4 * n); }
#pragma unroll
                for (int ai = 0; ai < 2; ++ai)
#pragma unroll
                    for (int m = 0; m < 4; ++m) { const int row = row0 + ai * HALF + m * 16; const float ra = rav[ai][m]; float* rp = dtv + (size_t)row * 32 + 8 * fq;
#pragma unroll
                        for (int n = 0; n < 2; ++n) { const f32x4 v = __builtin_convertvector(acc[ai][0][m][n], f32x4) * (sv[n] * ra) + bv[n]; f32x4 o; o[0] = softplus_f(v[0]); o[1] = softplus_f(v[1]); o[2] = softplus_f(v[2]); o[3] = softplus_f(v[3]); *(f32x4*)(rp + 4 * n) = o; } }
            }
            return;
        }
        bf16_t* base; int ldc, colt;
        if (pn < 4) { base = zs; ldc = 1024; colt = pn * 256; } else if (pn < 12) { base = xbc; ldc = 2048; colt = (pn - 4) * 256; } else { base = yz; ldc = 512; colt = (pn - 12) * 256; }
        const int col0 = colt + wc * 32 + 8 * fq;
        f32x4 sv[2][2];
#pragma unroll
        for (int bj = 0; bj < 2; ++bj)
#pragma unroll
            for (int n = 0; n < 2; ++n) sv[bj][n] = *(const PG8_LAS f32x4*)(sbp + bj * HALF + 4 * n);
#pragma unroll
        for (int ai = 0; ai < 2; ++ai)
#pragma unroll
            for (int m = 0; m < 4; ++m) { const int row = row0 + ai * HALF + m * 16; const float ra = rav[ai][m]; bf16_t* rowp = base + (size_t)row * ldc + col0;
#pragma unroll
                for (int bj = 0; bj < 2; ++bj) { f32x4 v0 = __builtin_convertvector(acc[ai][bj][m][0], f32x4) * (sv[bj][0] * ra), v1 = __builtin_convertvector(acc[ai][bj][m][1], f32x4) * (sv[bj][1] * ra);
                    u32x4 w; w.x = cvt_pk_bf16(v0[0], v0[1]); w.y = cvt_pk_bf16(v0[2], v0[3]); w.z = cvt_pk_bf16(v1[0], v1[1]); w.w = cvt_pk_bf16(v1[2], v1[3]);
                    *(u32x4*)(rowp + bj * HALF) = w; } }
    }
};
#ifndef OUTPROJ_PRE
#define OUTPROJ_PRE false
#endif
struct EpiOutProj {
    static constexpr bool PERM = true, AFTER_DRAIN = false, HAS_PRE = OUTPROJ_PRE;
    const float* x; bf16_t* x1; const float* mod; const float* sb;
    const PG8_LAS float* tab; mutable int k;
    mutable f32x4 xp[2][2];
    __device__ __forceinline__ void pre(const Unit& u, int wr, int wc, int fr, int fq) const {
        const size_t off = (size_t)(u.pm * BM + wr * 64 + fr) * 1024 + u.pn * BM + wc * 32 + 8 * fq;
#pragma unroll
        for (int bj = 0; bj < 2; ++bj) { xp[bj][0] = __builtin_nontemporal_load((const f32x4*)(x + off + bj * HALF)); xp[bj][1] = __builtin_nontemporal_load((const f32x4*)(x + off + bj * HALF + 4)); }
    }
    __device__ __forceinline__ void operator()(const f32x4 (&acc)[2][2][4][2], const Unit& u, int wr, int wc, int fr, int fq) const {
        const int row0 = u.pm * BM + wr * 64 + fr, col0 = u.pn * BM + wc * 32 + 8 * fq;
        f32x4 gv[2][2];
#pragma unroll
        for (int bj = 0; bj < 2; ++bj)
#pragma unroll
            for (int n = 0; n < 2; ++n) gv[bj][n] = *(const PG8_LAS f32x4*)(tab + k * 256 + wc * 32 + 8 * fq + bj * HALF + n * 4);
        ++k;
        f32x4 xv[2][2][2];
#define EPI_XLOAD(par_, it_) do { const size_t off_ = (size_t)(row0 + ((it_) >> 2) * HALF + ((it_) & 3) * 16) * 1024 + col0; _Pragma("unroll") for (int bj = 0; bj < 2; ++bj) { \
            xv[par_][bj][0] = __builtin_nontemporal_load((const f32x4*)(x + off_ + bj * HALF)); xv[par_][bj][1] = __builtin_nontemporal_load((const f32x4*)(x + off_ + bj * HALF + 4)); } } while (0)
        if constexpr (HAS_PRE) {
#pragma unroll
            for (int bj = 0; bj < 2; ++bj) { xv[0][bj][0] = xp[bj][0]; xv[0][bj][1] = xp[bj][1]; }
        } else EPI_XLOAD(0, 0);
#pragma unroll
        for (int it = 0; it < 8; ++it) { const int ai = it >> 2, m = it & 3; const size_t off = (size_t)(row0 + ai * HALF + m * 16) * 1024 + col0;
            if (it < 7) EPI_XLOAD((it + 1) & 1, it + 1);
#pragma unroll
            for (int bj = 0; bj < 2; ++bj) { const f32x4 v0 = xv[it & 1][bj][0] + gv[bj][0] * acc[ai][bj][m][0], v1 = xv[it & 1][bj][1] + gv[bj][1] * acc[ai][bj][m][1];
                u32x4 w; w.x = cvt_pk_bf16(v0[0], v0[1]); w.y = cvt_pk_bf16(v0[2], v0[3]); w.z = cvt_pk_bf16(v1[0], v1[1]); w.w = cvt_pk_bf16(v1[2], v1[3]);
                *(u32x4*)(x1 + off + bj * HALF) = w; } }
#undef EPI_XLOAD
    }
};
__device__ __forceinline__ unsigned pk4_fp8(float a, float b, float c, float d) { int w = __builtin_amdgcn_cvt_pk_fp8_f32(a, b, 0, false); return (unsigned)__builtin_amdgcn_cvt_pk_fp8_f32(c, d, w, true); }
struct EpiUp {
    static constexpr bool PERM = true, AFTER_DRAIN = false, HAS_PRE = false;
    unsigned char* act;
    __device__ __forceinline__ void operator()(const f32x4 (&acc)[2][2][4][2], const Unit& u, int wr, int wc, int fr, int fq) const {
        const int row0 = u.pm * BM + wr * 64 + fr, col0 = (u.pn & 3) * 128 + wc * 32 + 8 * fq;
#pragma unroll
        for (int ai = 0; ai < 2; ++ai)
#pragma unroll
            for (int m = 0; m < 4; ++m) { float a[8];
#pragma unroll
                for (int n = 0; n < 2; ++n)
#pragma unroll
                    for (int i = 0; i < 4; ++i) a[n * 4 + i] = 4.f * silu_f(acc[ai][0][m][n][i]) * acc[ai][1][m][n][i];
                typedef unsigned u32x2e __attribute__((ext_vector_type(2)));
                u32x2e w; w.x = pk4_fp8(a[0], a[1], a[2], a[3]); w.y = pk4_fp8(a[4], a[5], a[6], a[7]);
                *(u32x2e*)(act + (size_t)(row0 + ai * HALF + m * 16) * 512 + col0) = w; }
    }
};
struct EpiDown {
    static constexpr bool PERM = true, AFTER_DRAIN = false, HAS_PRE = false;
    bf16_t* ybuf; const int* rowdest; const float* rowgate;
    const PG8_LAS int* tab; mutable int k;
    __device__ __forceinline__ void operator()(const f32x4 (&acc)[2][2][4][2], const Unit& u, int wr, int wc, int fr, int fq) const {
        const int row0 = u.pm * BM + wr * 64 + fr, col0 = (u.pn & 3) * 256 + wc * 32 + 8 * fq;
        int dsv[2][4]; float gtv[2][4];
#pragma unroll
        for (int ai = 0; ai < 2; ++ai)
#pragma unroll
            for (int m = 0; m < 4; ++m) { const int rl = k * 512 + wr * 64 + fr + ai * HALF + m * 16; dsv[ai][m] = tab[rl]; gtv[ai][m] = __builtin_bit_cast(float, tab[rl + 256]); }
        ++k;
#pragma unroll
        for (int ai = 0; ai < 2; ++ai)
#pragma unroll
            for (int m = 0; m < 4; ++m) { const int dest = dsv[ai][m]; const float gt = gtv[ai][m];
                if (dest >= 0) {
#pragma unroll
                    for (int bj = 0; bj < 2; ++bj) { const f32x4 v0 = acc[ai][bj][m][0] * (gt * 16.f), v1 = acc[ai][bj][m][1] * (gt * 16.f);
                        typedef unsigned u32x2d __attribute__((ext_vector_type(2)));
                        u32x2d w; w.x = pk4_fp8(v0[0], v0[1], v0[2], v0[3]); w.y = pk4_fp8(v1[0], v1[1], v1[2], v1[3]);
                        *(u32x2d*)((unsigned char*)ybuf + (size_t)dest * 1024 + col0 + bj * HALF) = w; } } }
    }
};
struct InProjOrder {
    int G, c;
    __device__ __forceinline__ bool next(int i, Unit& u) const {
        const int L = i * G + c;
        if (L < 1920) { const int wgid = (L % NXCD) * 240 + L / NXCD; const int r = wgid % 120; u.pm = (wgid / 120) * 8 + (r & 7); u.pn = r >> 3; return true; }
        const int L2 = L - 1920; if (L2 >= 72) return false;
        u.pm = 128 + L2 / 9; const int j = L2 % 9; u.pn = j < 8 ? 4 + j : 14; return true;
    }
    __device__ __forceinline__ void a_ready(const Unit&) const {}
    __device__ __forceinline__ void done(const Unit&) const {}
};
struct MoeOrder {
    const PG8_LAS int* tile_e; int ntiles, G, c;
    __device__ __forceinline__ bool next(int i, Unit& u) const {
        const int nwg = ntiles * 4, L0 = i * G + c; if (L0 >= nwg) return false;
        const int q = nwg / NXCD, r = nwg % NXCD, xcd = L0 % NXCD, off = L0 / NXCD;
        const int L = (xcd < r ? xcd * (q + 1) : r * (q + 1) + (xcd - r) * q) + off;
        const int rt = L >> 2; u.pm = rt; u.pn = tile_e[rt] * 4 + (L & 3); return true;
    }
    __device__ __forceinline__ void a_ready(const Unit&) const {}
    __device__ __forceinline__ void done(const Unit&) const {}
};
#ifndef PG8_STAMP_OFF
#define PG8_STAMP_OFF 0.5f
#endif
#ifndef PG8_STAMP
#define PG8_STAMP 0
#endif
typedef int pg8_v4i __attribute__((ext_vector_type(4)));
typedef int pg8_v8i __attribute__((ext_vector_type(8)));
template <bool I8> struct AccSel { typedef f32x4 type; };
template <> struct AccSel<true> { typedef pg8_v4i type; };
template <class Epi, class Sched, bool ALIGN_EPI = false, bool SP2 = false, bool GATHER = false, bool FP8 = false, bool I8 = false, bool MIX = false>
__device__ __forceinline__ void gemm_phase(PG8_LAS unsigned char* lds, const Gemm g, const Sched& S, const Epi& E) {
    const int tid = threadIdx.x, wid = __builtin_amdgcn_readfirstlane(tid >> 6), lane = tid & 63, wr = wid >> 2, wc = wid & 3, fr = lane & 15, fq = lane >> 4;
    const int K = g.K, nt = K / BK;
    unsigned voffA[2], voffB[2];
#pragma unroll
    for (int i = 0; i < 2; ++i) { int R, C; stage_rc(tid * 16 + i * 8192, R, C); const int Rb = Epi::PERM ? ((R & ~31) + perm32(R & 31)) : R;
        voffA[i] = (unsigned)(R * K + C) * 2u; voffB[i] = (unsigned)(Rb * K + C) * 2u; }
    int gR[2], gC[2];
#pragma unroll
    for (int i = 0; i < 2; ++i) stage_rc(tid * 16 + i * 8192, gR[i], gC[i]);
    unsigned vC0[2] = {voffA[0], voffA[1]}, vC1[2] = {voffA[0], voffA[1]}, vN0[2] = {voffA[0], voffA[1]}, vN1[2] = {voffA[0], voffA[1]};
#define PG8_GOFF(dst0, dst1, pm_) do { _Pragma("unroll") for (int _i = 0; _i < 2; ++_i) { const int r0_ = g.gat[(pm_) * BM + gR[_i]], r1_ = g.gat[(pm_) * BM + HALF + gR[_i]]; \
        dst0[_i] = (unsigned)(((r0_ < 0 ? 0 : r0_) >> 1) * K + gC[_i]) * 2u; dst1[_i] = (unsigned)(((r1_ < 0 ? 0 : r1_) >> 1) * K + gC[_i]) * 2u; } } while (0)
    const size_t kstep = (size_t)(BK * 2);
    const size_t hstep = (size_t)HALF * K * 2;
    const size_t hstepA = GATHER ? 0 : hstep;
    const size_t tstep = 2 * hstep;
    const unsigned ldsw = (unsigned)wid * 1024u;
    const int aoff = lds_byte(wr * 64 + fr, fq * 8), boff = lds_byte(wc * 32 + fr, fq * 8);
#define PG8_SA(b, h) (((b) * 2 + (h)) * HTB)
#define PG8_SB(b, h) ((4 + (b) * 2 + (h)) * HTB)
#define PG8_STAGE(bufoff, gbase, voff) do { _Pragma("unroll") for (int _i = 0; _i < 2; ++_i) \
        __builtin_amdgcn_global_load_lds((const unsigned*)((const char*)(gbase) + (voff)[_i]), (PG8_LAS unsigned*)(lds + (bufoff) + ldsw + _i * 8192), 16, 0, 0); } while (0)
#define PG8_LD16(off) (*(const PG8_LAS pg8_v4i*)(lds + (off)))
#define PG8_LDA(dst, b, h) do { _Pragma("unroll") for (int m = 0; m < 4; ++m) dst[m] = __builtin_shufflevector(PG8_LD16(PG8_SA(b, h) + aoff + m * 2048), PG8_LD16(PG8_SA(b, h) + aoff + m * 2048 + 1024), 0, 1, 2, 3, 4, 5, 6, 7); } while (0)
#define PG8_LDB(dst, b, h) do { _Pragma("unroll") for (int n = 0; n < 2; ++n) dst[n] = __builtin_shufflevector(PG8_LD16(PG8_SB(b, h) + boff + n * 2048), PG8_LD16(PG8_SB(b, h) + boff + n * 2048 + 1024), 0, 1, 2, 3, 4, 5, 6, 7); } while (0)
#define PG8_HALF(x, k) __builtin_bit_cast(bf16x8, (k) == 0 ? __builtin_shufflevector((x), (x), 0, 1, 2, 3) : __builtin_shufflevector((x), (x), 4, 5, 6, 7))
#define PG8_HALFI(x, k) ((k) == 0 ? __builtin_shufflevector((x), (x), 0, 1, 2, 3) : __builtin_shufflevector((x), (x), 4, 5, 6, 7))
#define PG8_PIN (FP8 || I8 || MIX)
#define PG8_MMAF(FL, ai, bj, At, Bt) do { if constexpr (PG8_PIN) asm volatile("" : "+v"(At[0]), "+v"(At[1]), "+v"(At[2]), "+v"(At[3]), "+v"(Bt[0]), "+v"(Bt[1])); \
        __builtin_amdgcn_s_setprio(1); _Pragma("unroll") for (int m = 0; m < 4; ++m) _Pragma("unroll") for (int n = 0; n < 2; ++n) { \
        if constexpr (FP8) acc[ai][bj][m][n] = __builtin_amdgcn_mfma_scale_f32_16x16x128_f8f6f4(Bt[n], At[m], acc[ai][bj][m][n], 0, 0, 0, g.scale_b, 0, g.scale_a); \
        else if constexpr (I8 || (FL)) { pg8_v4i c_ = __builtin_amdgcn_mfma_i32_16x16x64_i8(PG8_HALFI(Bt[n], 0), PG8_HALFI(At[m], 0), __builtin_bit_cast(pg8_v4i, acc[ai][bj][m][n]), 0, 0, 0); \
               acc[ai][bj][m][n] = __builtin_bit_cast(acc_t, __builtin_amdgcn_mfma_i32_16x16x64_i8(PG8_HALFI(Bt[n], 1), PG8_HALFI(At[m], 1), c_, 0, 0, 0)); } \
        else { acc[ai][bj][m][n] = __builtin_amdgcn_mfma_f32_16x16x32_bf16(PG8_HALF(Bt[n], 0), PG8_HALF(At[m], 0), acc[ai][bj][m][n], 0, 0, 0); \
               acc[ai][bj][m][n] = __builtin_amdgcn_mfma_f32_16x16x32_bf16(PG8_HALF(Bt[n], 1), PG8_HALF(At[m], 1), acc[ai][bj][m][n], 0, 0, 0); } } \
        __builtin_amdgcn_s_setprio(0); \
        if constexpr (PG8_PIN) asm volatile("" : "+v"(acc[ai][bj][0][0]), "+v"(acc[ai][bj][0][1]), "+v"(acc[ai][bj][1][0]), "+v"(acc[ai][bj][1][1]), "+v"(acc[ai][bj][2][0]), "+v"(acc[ai][bj][2][1]), "+v"(acc[ai][bj][3][0]), "+v"(acc[ai][bj][3][1])); } while (0)
#define PG8_WAIT_V(n) asm volatile("s_waitcnt vmcnt(" #n ")" ::: "memory")
#define PG8_WAIT_L(n) asm volatile("s_waitcnt lgkmcnt(" #n ")" ::: "memory")
#define PG8_BAR __builtin_amdgcn_s_barrier()
#define PG8_SCHED __builtin_amdgcn_sched_barrier(0)
    Unit cur, nxt; int ui = 0;
    unsigned long long st_t0 = 0, st_acc = 0, st_a = 0; const bool st_on = (PG8_STAMP) && g.stamp != nullptr && blockIdx.x == 0 && tid == 0; if (st_on) st_t0 = __builtin_amdgcn_s_memrealtime();
    if (!S.next(0, cur)) return;
    if constexpr (MIX) { Unit su; for (int i = 0; i < 8 && S.next(i, su); ++i) if (tid < BM) ((PG8_LAS float*)(lds + STAGE_BYTES))[i * BM + tid] = g.sa[su.pm * BM + tid]; }
    typedef typename AccSel<I8>::type acc_t;
    acc_t acc[2][2][4][2];
#pragma unroll
    for (int a = 0; a < 2; ++a)
#pragma unroll
        for (int b = 0; b < 2; ++b)
#pragma unroll
            for (int m = 0; m < 4; ++m)
#pragma unroll
                for (int n = 0; n < 2; ++n) acc[a][b][m][n] = (acc_t){0, 0, 0, 0};
    pg8_v8i At[4], B0[2], B1[2];
    const char* cA = (const char*)g.A + (GATHER ? (size_t)0 : (size_t)cur.pm * tstep); const char* cB = (const char*)g.Bt + (size_t)cur.pn * tstep;
    if constexpr (GATHER) PG8_GOFF(vC0, vC1, cur.pm);
    S.a_ready(cur);
    static_assert(SP2, "only the two-super-phase schedule is kept in this file");
    PG8_STAGE(PG8_SB(0, 0), cB, voffB); PG8_STAGE(PG8_SB(0, 1), cB + hstep, voffB); PG8_STAGE(PG8_SA(0, 0), cA, vC0); PG8_STAGE(PG8_SA(0, 1), cA + hstepA, vC1);
    if (wr == 1) PG8_BAR;
    PG8_WAIT_V(2); PG8_BAR;
    PG8_STAGE(PG8_SB(1, 0), cB + kstep, voffB); PG8_STAGE(PG8_SA(1, 0), cA + kstep, vC0); PG8_STAGE(PG8_SB(1, 1), cB + hstep + kstep, voffB);
    PG8_WAIT_V(6); PG8_BAR;
    for (;;) {
        const bool has_next = S.next(ui + 1, nxt);
        const char* nA = (has_next && !GATHER) ? (const char*)g.A + (size_t)nxt.pm * tstep : cA;
        if constexpr (GATHER) { if (has_next) PG8_GOFF(vN0, vN1, nxt.pm); else { vN0[0] = vC0[0]; vN0[1] = vC0[1]; vN1[0] = vC1[0]; vN1[1] = vC1[1]; } } const char* nB = has_next ? (const char*)g.Bt + (size_t)nxt.pn * tstep : cB;
#define PG8_TRIP(FL) do { \
            const bool last = (t == nt - 2); \
            const char* a1 = cA + (size_t)(t + 1) * kstep; \
            const char* a2 = last ? nA : cA + (size_t)(t + 2) * kstep; const char* b2 = last ? nB : cB + (size_t)(t + 2) * kstep; \
            const char* a3 = a2 + kstep; const char* b3 = b2 + kstep; \
            if (last && has_next) S.a_ready(nxt); \
            if constexpr (Epi::HAS_PRE) { if (last) E.pre(cur, wr, wc, fr, fq); } \
            const unsigned v20[2] = {last ? vN0[0] : vC0[0], last ? vN0[1] : vC0[1]}, v21[2] = {last ? vN1[0] : vC1[0], last ? vN1[1] : vC1[1]}; \
            PG8_LDB(B0, 0, 0); PG8_LDB(B1, 0, 1); PG8_SCHED; PG8_LDA(At, 0, 0); PG8_STAGE(PG8_SA(1, 1), a1 + hstepA, vC1); \
            PG8_WAIT_V(8); PG8_WAIT_L(0); PG8_BAR; PG8_MMAF(FL, 0, 0, At, B0); PG8_MMAF(FL, 0, 1, At, B1); PG8_BAR; PG8_SCHED; \
            PG8_LDA(At, 0, 1); PG8_STAGE(PG8_SB(0, 0), b2, voffB); PG8_STAGE(PG8_SB(0, 1), b2 + hstep, voffB); PG8_STAGE(PG8_SA(0, 0), a2, v20); \
            PG8_WAIT_V(8); PG8_WAIT_L(0); PG8_BAR; PG8_MMAF(FL, 1, 0, At, B0); PG8_MMAF(FL, 1, 1, At, B1); PG8_BAR; PG8_SCHED; \
            PG8_LDB(B0, 1, 0); PG8_LDB(B1, 1, 1); PG8_SCHED; PG8_LDA(At, 1, 0); PG8_STAGE(PG8_SA(0, 1), a2 + hstepA, v21); \
            PG8_WAIT_V(8); PG8_WAIT_L(0); PG8_BAR; PG8_MMAF(FL, 0, 0, At, B0); PG8_MMAF(FL, 0, 1, At, B1); PG8_BAR; PG8_SCHED; \
            PG8_LDA(At, 1, 1); PG8_STAGE(PG8_SB(1, 0), b3, voffB); PG8_STAGE(PG8_SB(1, 1), b3 + hstep, voffB); PG8_STAGE(PG8_SA(1, 0), a3, v20); \
            PG8_WAIT_V(8); PG8_WAIT_L(0); PG8_BAR; PG8_MMAF(FL, 1, 0, At, B0); PG8_MMAF(FL, 1, 1, At, B1); PG8_BAR; PG8_SCHED; } while (0)
        if (st_on && (PG8_STAMP) == 1) st_a = __builtin_amdgcn_s_memrealtime();
        if constexpr (MIX) {
            int t = 0;
            for (; t < g.k8; t += 2) PG8_TRIP(1);
#pragma unroll
            for (int a = 0; a < 2; ++a)
#pragma unroll
                for (int m = 0; m < 4; ++m) { const float ra = ((const PG8_LAS float*)(lds + STAGE_BYTES))[ui * BM + wr * 64 + fr + a * HALF + m * 16];
#pragma unroll
                    for (int b = 0; b < 2; ++b)
#pragma unroll
                        for (int n = 0; n < 2; ++n) acc[a][b][m][n] = __builtin_bit_cast(acc_t, __builtin_convertvector(__builtin_bit_cast(pg8_v4i, acc[a][b][m][n]), f32x4) * ra); }
            for (; t < nt; t += 2) PG8_TRIP(0);
        } else {
            for (int t = 0; t < nt; t += 2) PG8_TRIP(0);
        }
#undef PG8_TRIP
        if (st_on) { const unsigned long long tn = __builtin_amdgcn_s_memrealtime(); if ((PG8_STAMP) == 1) st_acc += tn - st_a; st_a = tn; }
        if constexpr (ALIGN_EPI) { if (wr == 0) PG8_BAR; }
        if (st_on) { const unsigned long long tn = __builtin_amdgcn_s_memrealtime(); if ((PG8_STAMP) == 2) st_acc += tn - st_a; st_a = tn; }
        if constexpr (!Epi::AFTER_DRAIN) { E(acc, cur, wr, wc, fr, fq); S.done(cur); }
        if (st_on && (PG8_STAMP) == 3) { asm volatile("" ::: "memory"); st_acc += __builtin_amdgcn_s_memrealtime() - st_a; }
        if (!has_next) break;
#pragma unroll
        for (int a = 0; a < 2; ++a)
#pragma unroll
            for (int b = 0; b < 2; ++b)
#pragma unroll
                for (int m = 0; m < 4; ++m)
#pragma unroll
                    for (int n = 0; n < 2; ++n) acc[a][b][m][n] = (acc_t){0, 0, 0, 0};
        cur = nxt; cA = nA; cB = nB; ++ui;
        if constexpr (GATHER) { vC0[0] = vN0[0]; vC0[1] = vN0[1]; vC1[0] = vN1[0]; vC1[1] = vN1[1]; }
        if constexpr (ALIGN_EPI) { if (wr == 1) PG8_BAR; }
    }
    if (st_on) { const float tot = (float)(__builtin_amdgcn_s_memrealtime() - st_t0); __hip_atomic_store(g.stamp, floorf((float)st_acc / tot * 20.f + (PG8_STAMP_OFF)) * 0.05f, __ATOMIC_RELAXED, __HIP_MEMORY_SCOPE_AGENT); }
    PG8_WAIT_V(0);
    if constexpr (!ALIGN_EPI) { if (wr == 0) PG8_BAR; }
    PG8_BAR;
    if constexpr (Epi::AFTER_DRAIN) { E.fused(acc, cur, wr, wc, fr, fq, lds, wid, lane); S.done(cur); }
#undef PG8_GOFF
#undef PG8_SA
#undef PG8_SB
#undef PG8_STAGE
#undef PG8_LDA
#undef PG8_LDB
#undef PG8_MMAF
#undef PG8_HALF
#undef PG8_HALFI
#undef PG8_PIN
#undef PG8_LD16
#undef PG8_WAIT_V
#undef PG8_WAIT_L
#undef PG8_BAR
#undef PG8_SCHED
}
}
typedef unsigned short bf16;
#define DEVI __device__ __forceinline__
#define LAS __attribute__((address_space(3)))
#define GAS __attribute__((address_space(1)))
typedef unsigned v4u __attribute__((ext_vector_type(4)));
typedef float f32x4 __attribute__((ext_vector_type(4)));
typedef short s16x4 __attribute__((ext_vector_type(4)));
typedef unsigned u32x2 __attribute__((ext_vector_type(2)));
typedef short bf16x8 __attribute__((ext_vector_type(8)));
#define RLX_AGENT __ATOMIC_RELAXED, __HIP_MEMORY_SCOPE_AGENT
#define LDS_WAIT() asm volatile("s_waitcnt lgkmcnt(0)" ::: "memory")
#define VM_WAIT() asm volatile("s_waitcnt vmcnt(0)" ::: "memory")

constexpr int NWAVES = 8;
constexpr int DM = 1024, NB = 8, SEQ = 4096, CTX = 256;
constexpr int TL = NB * SEQ, TC = NB * CTX, TA = TL + TC;
constexpr int CONVD = 2048, DPROJ = 3616, NIN = 3840, C_XBC = 1024, C_F = 3072, C_DT = 3584, FOFF = 3104, DMIX = 1536, MIXLD = 1024  , NE = 32, DE = 512;
constexpr int RPAD = 65536 + NE * 256;
constexpr float EPS = 1e-6f;
constexpr size_t MiB = 1u << 20;
constexpr size_t WS_CTL = 0, CTL_ZERO_BYTES = 64 * 1024;
constexpr size_t WS_WR = 9 * MiB + 512 * 1024  , WS_BR = 1 * MiB + 256 * 1024  , WS_SB = 14 * MiB  , WS_WIN = 2 * MiB, WS_WOUT = 11 * MiB, WS_MODP = 149 * MiB  , WS_WC = 15 * MiB, WS_ROUTE = 15 * MiB + 512 * 1024, WS_MOD = 1 * MiB, WS_SAI = 6 * MiB  , WS_SBI = 7 * MiB  , WS_SAO = 6 * MiB + 256 * 1024  , WS_SBO = 7 * MiB + 64 * 1024  ;
constexpr size_t WS_XN = 17 * MiB, WS_AP = 17 * MiB, WS_WDN = 17 * MiB, WS_ZS = 85 * MiB, WS_WUP = 277 * MiB, WS_YBUF = 213 * MiB, WS_X1 = 149 * MiB, WS_XBC = 149 * MiB, WS_YF = 149 * MiB, WS_YB = 213 * MiB, WS_H2 = 149 * MiB;
constexpr size_t WS_HPERM = 213 * MiB, WS_YZ = 285 * MiB, WS_DTV = 350 * MiB, WS_XC = 355 * MiB, WS_MIX = 355 * MiB, WS_ACT = 358 * MiB, WS_ELIST = 492 * MiB  , WS_EGATE = 500 * MiB  , WS_END = 512 * MiB;
constexpr int CW_CNT = 0, CW_BAR = 4096, CW_CMAX = 8192  , CW_CMAXO = 12288  , CW_P5F = 13312  ;
constexpr int RING_BYTES = 131072, LDSCTL_OFF = 155648, LDS_BYTES = 163840;
constexpr int LC_MISC = 0  , LC_TILE = 256  , LC_CNT = 2048  , LC_RT = 4096  , LC_PTR = 6144  , LC_TS = 6400  ;

DEVI float bf2f(bf16 v) { return __uint_as_float(((unsigned)v) << 16); }
typedef float f32x2_t __attribute__((ext_vector_type(2)));
typedef __bf16 bf16x2_t __attribute__((ext_vector_type(2)));
DEVI unsigned pk2(float lo, float hi) { const f32x2_t v = {lo, hi}; return __builtin_bit_cast(unsigned, __builtin_convertvector(v, bf16x2_t)); }
DEVI unsigned f2bf(float f) { return pk2(f, f) & 0xffffu; }
DEVI float siluf(float v) { return v / (1.f + __expf(-v)); }
DEVI float wave_sum(float v) {
#pragma unroll
    for (int o = 1; o < 64; o <<= 1) v += __shfl_xor(v, o);
    return v;
}
struct Ptrs {
    const float *x, *c, *ctx, *c_ctx, *w_mod, *b_mod, *norm1, *w_in, *conv_w, *conv_b, *dt_bias, *a_log, *d_skip, *ssd_norm, *w_four, *w_out, *norm2,
        *w_rg, *b_rg, *w_re, *b_re, *w_eg, *w_eu, *w_ed, *final_norm;
    float* out; unsigned char* ws;
};
struct Frame { LAS unsigned char* lds; int tid, lane, wave, vcu, G; };
#define XB_TMO      128
#define XB_XCNT(j)  (256  + 64 * (j))
#define XB_XSUB(j)  (1280 + 64 * (j))
#define XB_XGEN(j)  (2304 + 64 * (j))
#define XB_TOP      3328
#define XB_TOPGEN   3392
#define XCD_BAR_WORDS 3456
#define XB_SPIN_CAP (1u << 18)

__device__ __forceinline__ unsigned xb_ld(unsigned* p)              { return __hip_atomic_load(p, __ATOMIC_RELAXED, __HIP_MEMORY_SCOPE_AGENT); }
__device__ __forceinline__ unsigned xb_add(unsigned* p, unsigned v) { return __hip_atomic_fetch_add(p, v, __ATOMIC_RELAXED, __HIP_MEMORY_SCOPE_AGENT); }
__device__ __forceinline__ unsigned xb_xcc_id() { return (unsigned)__builtin_amdgcn_s_getreg((3 << 11) | 20) & 0xFu; }
#define XB_SPIN(cond, bar) do { unsigned _sp = 0; while (cond) { __builtin_amdgcn_s_sleep(1); \
    if ((++_sp & 255u) == 0u) { if (xb_ld(&(bar)[XB_TMO])) break; if (_sp > XB_SPIN_CAP) { atomicAdd(&(bar)[XB_TMO], 1u); break; } } } } while (0)

struct XcdBarrier {
    unsigned* bar; unsigned x;
    volatile LAS unsigned* st;
};

__device__ __forceinline__ XcdBarrier xcd_barrier_post(unsigned* bar, volatile LAS unsigned* st) {
    XcdBarrier b; b.bar = bar; b.x = xb_xcc_id(); b.st = st;
    if (threadIdx.x == 0) (void)xb_add(&bar[XB_XCNT(b.x)], 1u);
    return b;
}
__device__ __forceinline__ void xcd_barrier_complete(unsigned* bar, unsigned x, unsigned& nloc, unsigned& nx) {
    const unsigned G = gridDim.x * gridDim.y * gridDim.z;
    unsigned sum, cnt, mine, sp = 0u;
    for (;;) {
        sum = 0u; cnt = 0u; mine = 0u;
#pragma unroll
        for (unsigned j = 0; j < 16; ++j) { const unsigned c = xb_ld(&bar[XB_XCNT(j)]); sum += c; cnt += (c > 0u) ? 1u : 0u; mine = (j == x) ? c : mine; }
        if (sum == G) break;
        __builtin_amdgcn_s_sleep(1);
        if ((++sp & 255u) == 0u) { if (xb_ld(&bar[XB_TMO])) break; if (sp > XB_SPIN_CAP) { atomicAdd(&bar[XB_TMO], 1u); break; } }
    }
    nloc = mine > 0u ? mine : 1u; nx = cnt > 0u ? cnt : 1u;
}

__device__ __forceinline__ void xcd_barrier(const XcdBarrier& b) {
    asm volatile("s_waitcnt vmcnt(0)" ::: "memory");
    __syncthreads();
    if (threadIdx.x == 0) {
        unsigned* bar = b.bar;
        __builtin_amdgcn_s_waitcnt(0);
        unsigned nloc = b.st[0], nx = b.st[1];
        if (nloc == 0u) { xcd_barrier_complete(bar, b.x, nloc, nx); b.st[0] = nloc; b.st[1] = nx; }
        const unsigned old = xb_add(&bar[XB_XSUB(b.x)], 1u);
        const unsigned gen = old / nloc;
        if (old + 1u == (gen + 1u) * nloc) {
            __builtin_amdgcn_fence(__ATOMIC_RELEASE, "agent");
            asm volatile("s_waitcnt vmcnt(0)" ::: "memory");
            const unsigned og = xb_add(&bar[XB_TOP], 1u);
            const unsigned tg = og / nx;
            if (og + 1u == (tg + 1u) * nx) xb_add(&bar[XB_TOPGEN], 1u);
            else XB_SPIN(xb_ld(&bar[XB_TOPGEN]) == tg, bar);
            __builtin_amdgcn_fence(__ATOMIC_ACQUIRE, "agent");
            xb_add(&bar[XB_XGEN(b.x)], 1u);
            asm volatile("s_waitcnt vmcnt(0)" ::: "memory");
        } else {
            XB_SPIN(xb_ld(&bar[XB_XGEN(b.x)]) == gen, bar);
            __builtin_amdgcn_fence(__ATOMIC_ACQUIRE, "agent");
            asm volatile("s_waitcnt vmcnt(0)" ::: "memory");
        }
    }
    __syncthreads();
}
DEVI void transpose_load(const float* W, int N, int k0, int n0, int lane, float (&v)[32]) {
#pragma unroll
    for (int i = 0; i < 32; ++i) v[i] = __builtin_nontemporal_load(W + (size_t)(k0 + 2 * i + (lane >> 5)) * N + n0 + (lane & 31));
}
DEVI unsigned pk4_fp8(float a, float b, float c, float d) { int w = __builtin_amdgcn_cvt_pk_fp8_f32(a, b, 0, false); return (unsigned)__builtin_amdgcn_cvt_pk_fp8_f32(c, d, w, true); }
template <bool F8 = false>
DEVI void transpose_store(const float (&v)[32], bf16* WT, int Kt, int row_off, int k0, int n0, LAS float* scr, int lane) {
#pragma unroll
    for (int i = 0; i < 32; ++i) scr[(2 * i + (lane >> 5)) * 33 + (lane & 31)] = v[i];
    LDS_WAIT(); asm volatile("" ::: "memory");
    const int c = lane & 7;
#pragma unroll
    for (int j = 0; j < 4; ++j) { const int n = (lane >> 3) + 8 * j; const LAS float* s = scr + (8 * c) * 33 + n;
        if constexpr (F8) { u32x2 o; o.x = pk4_fp8(32.f * s[0 * 33], 32.f * s[1 * 33], 32.f * s[2 * 33], 32.f * s[3 * 33]); o.y = pk4_fp8(32.f * s[4 * 33], 32.f * s[5 * 33], 32.f * s[6 * 33], 32.f * s[7 * 33]);
            *(u32x2*)((unsigned char*)WT + (size_t)(row_off + n0 + n) * Kt + k0 + 8 * c) = o; }
        else { v4u o; o.x = pk2(s[0 * 33], s[1 * 33]); o.y = pk2(s[2 * 33], s[3 * 33]); o.z = pk2(s[4 * 33], s[5 * 33]); o.w = pk2(s[6 * 33], s[7 * 33]);
            *(v4u*)(WT + (size_t)(row_off + n0 + n) * Kt + k0 + 8 * c) = o; } }
    LDS_WAIT(); asm volatile("" ::: "memory");
}
struct TrItem { const float* W; bf16* WT; int N, Kt, row_off, k0, n0; };
template <bool F8 = false, class Desc>
DEVI void transpose_items(int it0, int stride, int n_items, const Desc& desc, LAS float* scr, int lane) {
    if (it0 >= n_items) return;
    float cur[32], nxt[32]; TrItem a = desc(it0), b = a;
    transpose_load(a.W, a.N, a.k0, a.n0, lane, cur);
    for (int it = it0; it < n_items; it += stride) {
        const bool more = it + stride < n_items;
        if (more) { b = desc(it + stride); transpose_load(b.W, b.N, b.k0, b.n0, lane, nxt); }
        transpose_store<F8>(cur, a.WT, a.Kt, a.row_off, a.k0, a.n0, scr, lane);
        if (more) { a = b;
#pragma unroll
            for (int i = 0; i < 32; ++i) cur[i] = nxt[i]; }
    }
}
DEVI int win_row(int n) { return n < 3072 ? n : (n < FOFF ? C_DT + (n - 3072) : C_F + (n - FOFF)); }
DEVI unsigned pk4_i8(float a, float b, float c, float d) {
    const unsigned ua = __float_as_uint(a + 12582912.f), ub = __float_as_uint(b + 12582912.f), uc = __float_as_uint(c + 12582912.f), ud = __float_as_uint(d + 12582912.f);
    return __builtin_amdgcn_perm(ub, ua, 0x0c0c0400u) | __builtin_amdgcn_perm(ud, uc, 0x04000c0cu); }
DEVI float wave_max(float v) {
#pragma unroll
    for (int o = 1; o < 64; o <<= 1) v = fmaxf(v, __shfl_xor(v, o));
    return v;
}
#ifndef HAD_BIT0
#define HAD_BIT0 1
#endif
#define HAD_NORM ((16.f / HAD_BIT0) * 8.f)
DEVI void had_mix(float (&v)[16], int lane) {
#pragma unroll
    for (int bit = HAD_BIT0; bit < 16; bit <<= 1)
#pragma unroll
        for (int e = 0; e < 16; ++e) if (!(e & bit)) { const float a = v[e], b = v[e | bit]; v[e] = a + b; v[e | bit] = a - b; }
    const float s8 = (lane & 8) ? -1.f : 1.f, s16 = (lane & 16) ? -1.f : 1.f, s32 = (lane & 32) ? -1.f : 1.f;
#pragma unroll
    for (int e = 0; e < 16; ++e) { const float p = __builtin_bit_cast(float, __builtin_amdgcn_mov_dpp(__builtin_bit_cast(int, v[e]), 0x128, 0xf, 0xf, true)); v[e] = fmaf(v[e], s8, p); }
#pragma unroll
    for (int e = 0; e < 16; ++e) { const auto r = __builtin_amdgcn_permlane16_swap(__float_as_uint(v[e]), __float_as_uint(v[e]), false, false); v[e] = fmaf(__uint_as_float(r[1]), s16, __uint_as_float(r[0])); }
#pragma unroll
    for (int e = 0; e < 16; ++e) { const auto r = __builtin_amdgcn_permlane32_swap(__float_as_uint(v[e]), __float_as_uint(v[e]), false, false); v[e] = fmaf(__uint_as_float(r[1]), s32, __uint_as_float(r[0])); }
}
DEVI void wout_had_items(const Ptrs& P, int it0, int stride, int lane, bool pass1) {
    unsigned* cmax = (unsigned*)(P.ws + WS_CTL) + CW_CMAXO;
    for (int u = it0; u < 1024; u += stride) { const int n = (u >> 3) * 8 + (lane & 7), kf = 8 * (u & 7) + 64 * (lane >> 3); float v[16];
#pragma unroll
        for (int e = 0; e < 16; ++e) v[e] = P.w_out[(size_t)((e & 7) + kf + 512 * (e >> 3)) * DM + n];
        had_mix(v, lane);
        if (!pass1) { float m = 0.f;
#pragma unroll
            for (int e = 0; e < 16; ++e) m = fmaxf(m, fabsf(v[e]));
            m = fmaxf(m, __shfl_xor(m, 8)); m = fmaxf(m, __shfl_xor(m, 16)); m = fmaxf(m, __shfl_xor(m, 32));
            if (lane < 8) __hip_atomic_fetch_max(cmax + n, __float_as_uint(m), RLX_AGENT); }
        else { const float cm = fmaxf(__uint_as_float(__hip_atomic_load(cmax + n, RLX_AGENT)), 1e-30f), inv = 127.f / cm;
#pragma unroll
            for (int j = 0; j < 2; ++j) { u32x2 o; o.x = pk4_i8(inv * v[j * 8 + 0], inv * v[j * 8 + 1], inv * v[j * 8 + 2], inv * v[j * 8 + 3]); o.y = pk4_i8(inv * v[j * 8 + 4], inv * v[j * 8 + 5], inv * v[j * 8 + 6], inv * v[j * 8 + 7]);
                *(u32x2*)(P.ws + WS_WOUT + (size_t)n * 2048 + kf + 512 * j) = o; }
            if ((u & 7) == 0 && (lane >> 3) == 0) ((float*)(P.ws + WS_SBO))[n] = cm * (1.f / (127.f * HAD_NORM)); } }
}
DEVI void phase0a(const Ptrs& P, const Frame& F) {
    const int gt = F.vcu * 512 + F.tid, NT = F.G * 512;
    { int* rowdest = (int*)(P.ws + WS_ROUTE + 3 * 262144); for (int i = gt; i < RPAD; i += NT) rowdest[i] = -1; }
    { LAS float* tab = (LAS float*)F.lds; LAS float* wl = tab + 256;
      __syncthreads();
      if (F.tid < 128) { const float ang = (float)F.tid * (2.0f / 128.0f); tab[F.tid] = cospif(ang); tab[128 + F.tid] = -sinpif(ang); }
      int g_loaded = -1;
      for (int u = F.vcu; u < 256; u += F.G) { const int g = u >> 6, ri = (u >> 5) & 1, c = (u & 31) * 4 + (F.tid >> 7), d = F.tid & 127;
        if (g != g_loaded) { __syncthreads(); for (int i = F.tid; i < 128 * 128 / 4; i += 512) ((LAS f32x4*)wl)[i] = ((const f32x4*)(P.w_four + (size_t)g * 128 * 128))[i]; g_loaded = g; }
        __syncthreads();
        float acc = 0.f;
#pragma unroll 8
        for (int m = 0; m < 128; ++m) acc += tab[ri * 128 + ((m * c) & 127)] * wl[m * 128 + d];
        ((bf16*)(P.ws + WS_WC))[((size_t)g * 256 + ri * 128 + d) * 128 + c] = (bf16)f2bf(acc * 0.08838834764831845f); }
      __syncthreads(); }
    { LAS float* svec = (LAS float*)F.lds; LAS float* red = svec + 9 * 128;
      float* modp = (float*)(P.ws + WS_MODP);
      const int NCB = (F.G + 7) / 8;
      const int kc = F.vcu % 8;
      __syncthreads();
      for (int i = F.tid; i < 9 * 128; i += 512) { const int r = i >> 7, k = kc * 128 + (i & 127); svec[i] = siluf(r < 8 ? P.c[r * DM + k] : P.c_ctx[k]); }
      __syncthreads();
      for (int cc0 = F.vcu / 8; cc0 < 96; cc0 += 3 * NCB) {
        float wv[3][16];
#pragma unroll
        for (int j = 0; j < 3; ++j) { const int cc = cc0 + j * NCB; if (cc < 96) {
#pragma unroll
            for (int i = 0; i < 16; ++i) wv[j][i] = __builtin_nontemporal_load(P.w_mod + (size_t)(kc * 128 + F.wave * 16 + i) * 6144 + cc * 64 + F.lane); } }
#pragma unroll
        for (int j = 0; j < 3; ++j) { const int cc = cc0 + j * NCB; if (cc < 96) { float acc[9];
#pragma unroll
            for (int r = 0; r < 9; ++r) acc[r] = 0.f;
#pragma unroll
            for (int i = 0; i < 16; ++i)
#pragma unroll
                for (int r = 0; r < 9; ++r) acc[r] += svec[r * 128 + F.wave * 16 + i] * wv[j][i];
            __syncthreads();
#pragma unroll
            for (int r = 0; r < 9; ++r) red[(F.wave * 9 + r) * 64 + F.lane] = acc[r];
            __syncthreads();
            for (int i = F.tid; i < 576; i += 512) { float sm = 0.f;
#pragma unroll
                for (int w = 0; w < 8; ++w) sm += red[w * 576 + i];
                modp[((size_t)kc * 9 + (i >> 6)) * 6144 + cc * 64 + (i & 63)] = sm; } } }
      }
      __syncthreads(); }
    { const int gw = F.vcu * NWAVES + F.wave, NGW = F.G * NWAVES;
      constexpr int I_IN = 16 * 113;
      unsigned* cmax = (unsigned*)(P.ws + WS_CTL);
      for (int it = gw; it < I_IN; it += NGW) { const int kb = it / 113, nb = it % 113, k0 = kb * 64, n0 = nb * 32; float m = 0.f;
#pragma unroll
          for (int i = 0; i < 32; ++i) m = fmaxf(m, fabsf(P.w_in[(size_t)(k0 + 2 * i + (F.lane >> 5)) * DPROJ + n0 + (F.lane & 31)]));
          m = fmaxf(m, __shfl_xor(m, 32));
          if (F.lane < 32) __hip_atomic_fetch_max(cmax + CW_CMAX + win_row(n0 + F.lane), __float_as_uint(m), RLX_AGENT); }
      wout_had_items(P, (gw + NGW / 2) % NGW, NGW, F.lane, false);
      for (int i = gt; i < (NIN - C_DT - 32) * DM / 16; i += NT) ((v4u*)(P.ws + WS_WIN + (size_t)(C_DT + 32) * DM))[i] = (v4u){0u, 0u, 0u, 0u}; }
}
DEVI float modp_sum(const Ptrs& P, int r, int idx) { const float* mp = (const float*)(P.ws + WS_MODP) + (size_t)r * 6144 + idx; constexpr int S = 9 * 6144;
    return P.b_mod[idx] + (((mp[0] + mp[S]) + (mp[2 * S] + mp[3 * S])) + ((mp[4 * S] + mp[5 * S]) + (mp[6 * S] + mp[7 * S]))); }
template <int R>
DEVI void xn_rows(const float* const (&src)[R], const int (&row)[R], unsigned char* xn8, float* sa, const float* norm1, const LAS float* mrow, int lane) {
    f32x4 v[R][4];
#pragma unroll
    for (int r = 0; r < R; ++r)
#pragma unroll
        for (int j = 0; j < 4; ++j) v[r][j] = __builtin_nontemporal_load((const f32x4*)src[r] + lane + 64 * j);
    f32x4 nwv[4];
#pragma unroll
    for (int j = 0; j < 4; ++j) nwv[j] = *(const f32x4*)(norm1 + (lane + 64 * j) * 4);
#pragma unroll
    for (int r = 0; r < R; ++r) { float s = 0.f;
#pragma unroll
        for (int j = 0; j < 4; ++j) s += (v[r][j][0] * v[r][j][0] + v[r][j][1] * v[r][j][1]) + (v[r][j][2] * v[r][j][2] + v[r][j][3] * v[r][j][3]);
        const float rstd = rsqrtf(wave_sum(s) * (1.f / DM) + EPS); float mx = 0.f;
#pragma unroll
        for (int j = 0; j < 4; ++j) { const int c0 = (lane + 64 * j) * 4; const f32x4 nw = nwv[j];
#pragma unroll
            for (int i = 0; i < 4; ++i) { v[r][j][i] = v[r][j][i] * rstd * nw[i] * (1.f + mrow[1024 + c0 + i]) + mrow[c0 + i]; mx = fmaxf(mx, fabsf(v[r][j][i])); } }
        mx = wave_max(mx); const float inv = mx > 0.f ? 127.f / mx : 0.f;
        if (lane == 0) sa[row[r]] = mx * (1.f / 127.f);
#pragma unroll
        for (int j = 0; j < 4; ++j) *(unsigned*)(xn8 + (size_t)row[r] * DM + (lane + 64 * j) * 4) = pk4_i8(v[r][j][0] * inv, v[r][j][1] * inv, v[r][j][2] * inv, v[r][j][3] * inv); }
}
DEVI void quant_items(const Ptrs& P, int it0, int stride, LAS float* scr, int lane) {
    constexpr int I_IN = 16 * 113, I_OUTF = 8 * 32;
    const unsigned* cmw = (const unsigned*)(P.ws + WS_CTL);
    for (int it = it0; it < I_IN + I_OUTF; it += stride) {
        const int kind = it < I_IN ? 0 : 2; const int r = kind == 0 ? it : it - I_IN, NBk = kind == 0 ? 113 : 32;
        const int kb = r / NBk, nb = r % NBk, k0 = kb * 64 + (kind == 2 ? 1024 : 0), n0 = nb * 32; float v[32];
        transpose_load(kind == 0 ? P.w_in : P.w_out, kind == 0 ? DPROJ : DM, k0, n0, lane, v);
#pragma unroll
        for (int i = 0; i < 32; ++i) scr[(2 * i + (lane >> 5)) * 33 + (lane & 31)] = v[i];
        LDS_WAIT(); asm volatile("" ::: "memory");
        const int c = lane & 7;
#pragma unroll
        for (int j = 0; j < 4; ++j) { const int n = (lane >> 3) + 8 * j, row = kind == 0 ? win_row(n0 + n) : n0 + n; const LAS float* s = scr + (8 * c) * 33 + n;
            const float cm = fmaxf(__uint_as_float(__hip_atomic_load(cmw + (kind == 0 ? CW_CMAX : CW_CMAXO) + row, RLX_AGENT)), 1e-30f), inv = (kind == 0 ? 127.f : 127.f * HAD_NORM) / cm;
            if (kind == 2) { v4u o; o.x = pk2(inv * s[0 * 33], inv * s[1 * 33]); o.y = pk2(inv * s[2 * 33], inv * s[3 * 33]); o.z = pk2(inv * s[4 * 33], inv * s[5 * 33]); o.w = pk2(inv * s[6 * 33], inv * s[7 * 33]);
                *(v4u*)(P.ws + WS_WOUT + (size_t)row * 2048 + 1024 + (size_t)(k0 - 1024 + 8 * c) * 2) = o; }
            else { u32x2 o; o.x = pk4_i8(inv * s[0 * 33], inv * s[1 * 33], inv * s[2 * 33], inv * s[3 * 33]); o.y = pk4_i8(inv * s[4 * 33], inv * s[5 * 33], inv * s[6 * 33], inv * s[7 * 33]);
                *(u32x2*)(P.ws + WS_WIN + (size_t)row * DM + k0 + 8 * c) = o;
                if (kb == 0 && c == 0) ((float*)(P.ws + WS_SBI))[row] = cm * (1.f / 127.f); } }
        LDS_WAIT(); asm volatile("" ::: "memory"); }
}
DEVI void phase0b(const Ptrs& P, const Frame& F) {
    const int gt = F.vcu * 512 + F.tid, NT = F.G * 512;
    quant_items(P, F.vcu * NWAVES + F.wave, F.G * NWAVES, (LAS float*)(F.lds + 16384 + F.wave * 16384), F.lane);
    wout_had_items(P, (F.vcu * NWAVES + F.wave + F.G * NWAVES / 2) % (F.G * NWAVES), F.G * NWAVES, F.lane, true);
    { float* mod = (float*)(P.ws + WS_MOD); for (int i = gt; i < 9 * 6144; i += NT) mod[i] = modp_sum(P, i / 6144, i % 6144); }
    { bf16* WRh = (bf16*)(P.ws + WS_WR); bf16* WRl = WRh + 8 * 48 * 1024;
      for (int o = gt; o < 8 * 48 * 1024; o += NT) { const int k = o & 1023, n = (o >> 10) % 48, b = o / (48 * 1024); float wv = 0.f;
          if (n < 36) { const float wc = n < 4 ? P.w_rg[k * 4 + n] : P.w_re[((size_t)((n - 4) >> 3) * DM + k) * 8 + ((n - 4) & 7)]; wv = P.norm2[k] * (1.f + modp_sum(P, b, 4096 + k)) * wc; }
          const unsigned hi = f2bf(wv); const float rem = wv - __uint_as_float(hi << 16); WRh[o] = (bf16)hi; WRl[o] = (bf16)f2bf(rem); }
      { float* sb = (float*)(P.ws + WS_SB); for (int o = gt; o < 8 * 1024; o += NT) { const int k = o & 1023, b = o >> 10; sb[(b * 2) * 1024 + k] = P.norm2[k] * (1.f + modp_sum(P, b, 4096 + k)); sb[(b * 2 + 1) * 1024 + k] = modp_sum(P, b, 3072 + k); } }
      const int gwv = F.vcu * NWAVES + F.wave;
      for (int o = gwv; o < 8 * 48; o += F.G * NWAVES) { const int n = o % 48, b = o / 48; float a = 0.f;
          if (n < 36) { for (int k = F.lane; k < DM; k += 64) { const float wc = n < 4 ? P.w_rg[k * 4 + n] : P.w_re[((size_t)((n - 4) >> 3) * DM + k) * 8 + ((n - 4) & 7)]; a += modp_sum(P, b, 3072 + k) * wc; }
              a = wave_sum(a) + (n < 4 ? P.b_rg[n] : P.b_re[n - 4]); }
          if (F.lane == 0) ((float*)(P.ws + WS_BR))[o] = a; } }
    LAS float* mrow = (LAS float*)F.lds;
    for (int rb = F.vcu; rb < 256; rb += F.G) {
        __syncthreads();
        for (int i = F.tid; i < 2048; i += 512) mrow[i] = modp_sum(P, rb >> 5, i);
        __syncthreads();
        for (int r = F.wave * 4; r < 128; r += NWAVES * 4) { const float* src[4]; int row[4];
#pragma unroll
            for (int k = 0; k < 4; ++k) { row[k] = rb * 128 + r + k; src[k] = P.x + (size_t)row[k] * DM; }
            xn_rows<4>(src, row, P.ws + WS_XN, (float*)(P.ws + WS_SAI), P.norm1, mrow, F.lane); }
        __syncthreads();
        for (int i = F.tid; i < 2048; i += 512) mrow[i] = modp_sum(P, 8, i);
        __syncthreads();
        { const int rowc = rb * 8 + F.wave; const float* src[1] = {P.ctx + (size_t)rowc * DM}; const int row[1] = {TL + rowc}; xn_rows<1>(src, row, P.ws + WS_XN, (float*)(P.ws + WS_SAI), P.norm1, mrow, F.lane); }
    }
}
DEVI void phase_conv(const Ptrs& P, const Frame& F) {
    const bf16* xbc = (const bf16*)(P.ws + WS_XBC); bf16* xc = (bf16*)(P.ws + WS_XC);
    for (int u = F.vcu; u < (TA / 16) * 2; u += F.G) {
        const int tb = u >> 1, ch = (u & 1) * 1024 + 2 * F.tid; const int row0 = tb * 16;
        const int len = row0 < TL ? SEQ : CTX; const int t0 = row0 < TL ? (row0 & (SEQ - 1)) : ((row0 - TL) & (CTX - 1));
        float cw[5][2], cb[2];
        { const float2 bb = *(const float2*)(P.conv_b + ch); cb[0] = bb.x; cb[1] = bb.y;
#pragma unroll
          for (int t = 0; t < 5; ++t) { const float2 ww = *(const float2*)(P.conv_w + t * CONVD + ch); cw[t][0] = ww.x; cw[t][1] = ww.y; } }
        unsigned raw[20];
        const bf16* src = xbc + (size_t)(row0 - 2) * 2048 + ch;
#pragma unroll
        for (int i = 0; i < 20; ++i) raw[i] = __builtin_nontemporal_load((const unsigned*)(src + (size_t)i * 2048));
#pragma unroll
        for (int i = 0; i < 2; ++i) { asm volatile("" : "+v"(raw[i]), "+v"(raw[18 + i]));
            if (t0 - 2 + i < 0) raw[i] = 0u; if (t0 + 16 + i >= len) raw[18 + i] = 0u; }
        bf16* dst = xc + (size_t)row0 * 2048 + ch;
#pragma unroll
        for (int o = 0; o < 16; ++o) { float a0 = cb[0], a1 = cb[1];
#pragma unroll
            for (int t = 0; t < 5; ++t) { a0 += __uint_as_float(raw[o + t] << 16) * cw[t][0]; a1 += __uint_as_float(raw[o + t] & 0xffff0000u) * cw[t][1]; }
            a0 = a0 * __builtin_amdgcn_rcpf(1.f + __expf(-a0)); a1 = a1 * __builtin_amdgcn_rcpf(1.f + __expf(-a1));
            *(unsigned*)(dst + (size_t)o * 2048) = pk2(a0, a1); }
    }
}
template <bool LIGHT = false>
DEVI void phase_combine(const Ptrs& P, const Frame& F) {
    const int gw = F.vcu * NWAVES + F.wave, NGW = F.G * NWAVES, lane = F.lane;
    constexpr int R = 4;
    v4u ya[R][2], yb[R][2], zz[R][2];
#define COMBINE_LOAD(row0_) do { _Pragma("unroll") for (int r = 0; r < R; ++r) { const size_t ro = (size_t)((row0_) + r) * 1024; \
        _Pragma("unroll") for (int j = 0; j < 2; ++j) { const int c0 = (lane + 64 * j) * 8; ya[r][j] = __builtin_nontemporal_load((const v4u*)((const bf16*)(P.ws + WS_YF) + ro + c0)); \
            yb[r][j] = __builtin_nontemporal_load((const v4u*)((const bf16*)(P.ws + WS_YB) + ro + c0)); zz[r][j] = __builtin_nontemporal_load((const v4u*)((const bf16*)(P.ws + WS_ZS) + ro + c0)); } } } while (0)
    f32x4 nrm[2][2];
#pragma unroll
    for (int j = 0; j < 2; ++j) { const int c0 = (lane + 64 * j) * 8; nrm[j][0] = *(const f32x4*)(P.ssd_norm + c0); nrm[j][1] = *(const f32x4*)(P.ssd_norm + c0 + 4); }
    COMBINE_LOAD(gw * R);
    for (int row0 = gw * R; row0 < TL; row0 += R * NGW) {
        float vv[R][16], ss[R];
#pragma unroll
        for (int r = 0; r < R; ++r) { float s = 0.f;
#pragma unroll
            for (int j = 0; j < 2; ++j)
#pragma unroll
                for (int i = 0; i < 4; ++i) { const float z0 = __uint_as_float(zz[r][j][i] << 16), z1 = __uint_as_float(zz[r][j][i] & 0xffff0000u);
                    const float y0 = (__uint_as_float(ya[r][j][i] << 16) + __uint_as_float(yb[r][j][i] << 16)) * (LIGHT ? z0 : z0 * __builtin_amdgcn_rcpf(1.f + __expf(-z0)));
                    const float y1 = (__uint_as_float(ya[r][j][i] & 0xffff0000u) + __uint_as_float(yb[r][j][i] & 0xffff0000u)) * (LIGHT ? z1 : z1 * __builtin_amdgcn_rcpf(1.f + __expf(-z1)));
                    vv[r][j * 8 + 2 * i] = y0; vv[r][j * 8 + 2 * i + 1] = y1; s += y0 * y0 + y1 * y1; }
            ss[r] = s; }
        COMBINE_LOAD(row0 + R * NGW);
#pragma unroll
        for (int r = 0; r < R; ++r) { float (&v)[16] = vv[r];
            const float rstd = rsqrtf(wave_sum(ss[r]) * (1.f / 1024.f) + EPS); float mx = 0.f;
#pragma unroll
            for (int j = 0; j < 2; ++j) {
#pragma unroll
                for (int i = 0; i < 4; ++i) { v[j * 8 + i] *= rstd * nrm[j][0][i]; v[j * 8 + 4 + i] *= rstd * nrm[j][1][i]; } }
            if constexpr (!LIGHT) had_mix(v, lane);
#pragma unroll
            for (int e = 0; e < 16; ++e) mx = fmaxf(mx, fabsf(v[e]));
            mx = wave_max(mx); const float inv = mx > 0.f ? 127.f / mx : 0.f; const int row = row0 + r;
            if (lane == 0) ((float*)(P.ws + WS_SAO))[row] = mx * (1.f / 127.f);
#pragma unroll
            for (int j = 0; j < 2; ++j) { u32x2 o; o.x = pk4_i8(v[j * 8 + 0] * inv, v[j * 8 + 1] * inv, v[j * 8 + 2] * inv, v[j * 8 + 3] * inv); o.y = pk4_i8(v[j * 8 + 4] * inv, v[j * 8 + 5] * inv, v[j * 8 + 6] * inv, v[j * 8 + 7] * inv);
                *(u32x2*)(P.ws + WS_MIX + (size_t)row * 2048 + (lane + 64 * j) * 8) = o; } }
    }
#undef COMBINE_LOAD
}
DEVI void phase_expert_weights(const Ptrs& P, const Frame& F, int it_lo, int it_hi, int widx, int nw) {
    LAS float* scr = (LAS float*)(F.lds + F.wave * 16384);
    bf16* Wdn = (bf16*)(P.ws + WS_WDN);
    const float* w_ed = P.w_ed;
    auto desc = [&](int it) { TrItem t; const int e = it >> 8, r = it & 255, kb = r >> 5, nb = r & 31;
        t.W = w_ed + (size_t)e * DE * DM; t.WT = Wdn; t.N = DM; t.Kt = DE; t.row_off = e * 1024; t.k0 = kb * 64; t.n0 = nb * 32; return t; };
    transpose_items<true>(it_lo + widx, nw, it_hi, desc, scr, F.lane);
}
DEVI void phase_route(const Ptrs& P, const Frame& F, bool dry) {
    const int lane = F.lane, w = F.wave, c16 = lane & 15, q = lane >> 4;
    LAS unsigned* lcnt = (LAS unsigned*)(F.lds + LDSCTL_OFF + LC_CNT);
    LAS unsigned char* LW = F.lds;
    int* eid = (int*)(P.ws + WS_ROUTE); int* pos = eid + 65536; float* gate = (float*)(pos + 65536);
    const bf16* WRh = (const bf16*)(P.ws + WS_WR);
    for (int rb = F.vcu; rb < TL / 128; rb += F.G) {
        const int b = rb >> 5, row = rb * 128 + 16 * w + c16;
        __syncthreads();
        if (F.tid < 64) lcnt[F.tid] = 0u;
        f32x4 acc[3] = {(f32x4){0.f, 0.f, 0.f, 0.f}, (f32x4){0.f, 0.f, 0.f, 0.f}, (f32x4){0.f, 0.f, 0.f, 0.f}}; float ssq = 0.f;
#pragma unroll 1
        for (int hh = 0; hh < 2; ++hh) {
            bf16x8 af[16];
#pragma unroll
            for (int ks = 0; ks < 16; ++ks) af[ks] = *(const bf16x8*)((const bf16*)(P.ws + WS_X1) + (size_t)row * DM + 512 * hh + 32 * ks + 8 * q);
            __syncthreads();
            for (int cid = F.tid; cid < 2 * 48 * 64; cid += 512) { const int pl = cid / (48 * 64), r = (cid >> 6) % 48, ch = cid & 63;
                *(LAS v4u*)(LW + (pl * 48 + r) * 1024 + ((ch ^ (r & 15)) << 4)) = *(const v4u*)(WRh + (size_t)pl * 8 * 48 * 1024 + ((size_t)b * 48 + r) * 1024 + 512 * hh + ch * 8); }
            __syncthreads();
#pragma unroll
            for (int ks = 0; ks < 16; ++ks) {
#pragma unroll
                for (int i = 0; i < 8; ++i) { const float xv = __uint_as_float(((unsigned)(unsigned short)af[ks][i]) << 16); ssq += xv * xv; }
#pragma unroll
                for (int ct = 0; ct < 3; ++ct) { const int r = 16 * ct + c16; const int off = ((4 * ks + q) ^ c16) << 4;
                    const bf16x8 bh = *(const LAS bf16x8*)(LW + r * 1024 + off), bl = *(const LAS bf16x8*)(LW + (48 + r) * 1024 + off);
                    acc[ct] = __builtin_amdgcn_mfma_f32_16x16x32_bf16(af[ks], bh, acc[ct], 0, 0, 0); acc[ct] = __builtin_amdgcn_mfma_f32_16x16x32_bf16(af[ks], bl, acc[ct], 0, 0, 0); } }
        }
        ssq += __shfl_xor(ssq, 16); ssq += __shfl_xor(ssq, 32);
        const float rstd = rsqrtf(ssq * (1.f / DM) + EPS);
        { LAS float* sct = (LAS float*)(F.lds + 98304);
          for (int i = F.tid; i < 2048; i += 512) sct[i] = ((const float*)(P.ws + WS_SB))[(size_t)b * 2048 + i];
          __syncthreads();
          const bf16* xr = (const bf16*)(P.ws + WS_X1) + (size_t)row * DM; unsigned char* hr = (unsigned char*)(P.ws + WS_HPERM) + (size_t)row * DM;
#pragma unroll 1
          for (int hh = 0; hh < 2; ++hh) { v4u xq[16];
#pragma unroll
              for (int ks = 0; ks < 16; ++ks) xq[ks] = *(const v4u*)(xr + 512 * hh + 32 * ks + 8 * q);
#pragma unroll
              for (int ks = 0; ks < 16; ++ks) { const int k0 = 512 * hh + 32 * ks + 8 * q; const v4u xv = xq[ks];
                  const f32x4 s0 = *(const LAS f32x4*)(sct + k0), s1 = *(const LAS f32x4*)(sct + k0 + 4), h0 = *(const LAS f32x4*)(sct + 1024 + k0), h1 = *(const LAS f32x4*)(sct + 1024 + k0 + 4);
                  const float sc[8] = {s0[0], s0[1], s0[2], s0[3], s1[0], s1[1], s1[2], s1[3]}, sh[8] = {h0[0], h0[1], h0[2], h0[3], h1[0], h1[1], h1[2], h1[3]}; float hv[8];
#pragma unroll
                  for (int i = 0; i < 4; ++i) { hv[2 * i] = __uint_as_float(xv[i] << 16) * rstd * sc[2 * i] + sh[2 * i]; hv[2 * i + 1] = __uint_as_float(xv[i] & 0xffff0000u) * rstd * sc[2 * i + 1] + sh[2 * i + 1]; }
                  u32x2 o; o.x = pk4_fp8(hv[0], hv[1], hv[2], hv[3]); o.y = pk4_fp8(hv[4], hv[5], hv[6], hv[7]);
                  if (!dry) *(u32x2*)(hr + k0) = o; else asm volatile("" :: "v"(o[0]), "v"(o[1])); } } }
        __syncthreads();
        LAS float* lgt = (LAS float*)F.lds;
        { const float* br = (const float*)(P.ws + WS_BR) + b * 48;
#pragma unroll
          for (int r = 0; r < 4; ++r) { const float rs = __shfl(rstd, 4 * q + r);
#pragma unroll
            for (int ct = 0; ct < 3; ++ct) lgt[(16 * w + 4 * q + r) * 48 + 16 * ct + c16] = acc[ct][r] * rs + br[16 * ct + c16]; } }
        LDS_WAIT(); asm volatile("" ::: "memory");
        LAS int* rt = (LAS int*)(F.lds + LDSCTL_OFF + LC_RT) + (w * 16 + c16) * 4;
        if (lane < 16) { const LAS float* lr = lgt + (16 * w + lane) * 48; const int trow = rb * 128 + 16 * w + lane;
            int grp = 0; float mx = lr[0];
#pragma unroll
            for (int g = 1; g < 4; ++g) if (lr[g] > mx) { mx = lr[g]; grp = g; }
            float den = 0.f;
#pragma unroll
            for (int g = 0; g < 4; ++g) den += __expf(lr[g] - mx);
            const float pgrp = 1.f / den;
            float le[8];
#pragma unroll
            for (int e = 0; e < 8; ++e) le[e] = lr[4 + grp * 8 + e];
            int j0 = 0; float m0 = le[0];
#pragma unroll
            for (int e = 1; e < 8; ++e) if (le[e] > m0) { m0 = le[e]; j0 = e; }
            int j1 = 0; float m1 = -3.0e38f;
#pragma unroll
            for (int e = 0; e < 8; ++e) if (e != j0 && le[e] > m1) { m1 = le[e]; j1 = e; }
            const float e1 = __expf(m1 - m0);
            if (!dry) { const int ea = grp * 8 + j0, eb = grp * 8 + j1;
                LAS float* lw_ = lgt + (16 * w + lane) * 48; lw_[0] = pgrp / (1.f + e1); lw_[1] = pgrp * e1 / (1.f + e1);
                rt[0] = ea; rt[1] = eb; rt[2] = (int)__hip_atomic_fetch_add(&lcnt[ea], 1u, __ATOMIC_RELAXED, __HIP_MEMORY_SCOPE_WORKGROUP); rt[3] = (int)__hip_atomic_fetch_add(&lcnt[eb], 1u, __ATOMIC_RELAXED, __HIP_MEMORY_SCOPE_WORKGROUP); }
            else asm volatile("" :: "v"(e1), "v"(j0), "v"(j1), "v"(pgrp)); }
        __syncthreads();
        if (!dry) {
            if (F.tid < 32) lcnt[32 + F.tid] = __hip_atomic_fetch_add((unsigned*)(P.ws + WS_CTL) + CW_CNT + F.tid, lcnt[F.tid], RLX_AGENT);
            __syncthreads();
            if (lane < 16) { const int trow = rb * 128 + 16 * w + lane; const LAS float* lw_ = lgt + (16 * w + lane) * 48;
                int* elist = (int*)(P.ws + WS_ELIST); float* egate = (float*)(P.ws + WS_EGATE);
                const int pa = rt[0] * 65536 + rt[2] + (int)lcnt[32 + rt[0]], pb = rt[1] * 65536 + rt[3] + (int)lcnt[32 + rt[1]];
                elist[pa] = trow * 2; egate[pa] = lw_[0]; elist[pb] = trow * 2 + 1; egate[pb] = lw_[1]; } }
    }
    __syncthreads();
}
DEVI int build_tile_table(const Ptrs& P, const Frame& F) {
    LAS int* tile_e = (LAS int*)(F.lds + LDSCTL_OFF + LC_TILE); LAS unsigned* lcnt = (LAS unsigned*)(F.lds + LDSCTL_OFF + LC_CNT);
    __syncthreads();
    if (F.tid < 32) lcnt[F.tid] = __hip_atomic_load((unsigned*)(P.ws + WS_CTL) + CW_CNT + F.tid, RLX_AGENT);
    __syncthreads();
    if (F.tid == 0) { int s = 0; for (int e = 0; e < NE; ++e) { const int nt = (int)((lcnt[e] + 255u) >> 8); lcnt[64 + e] = (unsigned)(s * 256); for (int i = 0; i < nt; ++i) tile_e[s + i] = e; s += nt; } lcnt[96] = (unsigned)s; }
    __syncthreads();
    return (int)lcnt[96];
}
DEVI void tile_rows(const Ptrs& P, const Frame& F, int rt) {
    const LAS int* tile_e = (const LAS int*)(F.lds + LDSCTL_OFF + LC_TILE); const LAS unsigned* lcnt = (const LAS unsigned*)(F.lds + LDSCTL_OFF + LC_CNT);
    if (F.tid < 256) { const int e = tile_e[rt], p = rt * 256 - (int)lcnt[64 + e] + F.tid; const bool ok = p < (int)lcnt[e];
        int* rowdest = (int*)(P.ws + WS_ROUTE + 3 * 262144); float* rowgate = (float*)(rowdest + RPAD);
        rowdest[rt * 256 + F.tid] = ok ? ((const int*)(P.ws + WS_ELIST))[e * 65536 + p] : -1; rowgate[rt * 256 + F.tid] = ok ? ((const float*)(P.ws + WS_EGATE))[e * 65536 + p] : 0.f; }
}
DEVI void phase_gather(const Ptrs& P, const Frame& F) {
    build_tile_table(P, F);
    const LAS unsigned* lcnt = (const LAS unsigned*)(F.lds + LDSCTL_OFF + LC_CNT);
    const int gw = F.vcu * NWAVES + F.wave, NGW = F.G * NWAVES, lane = F.lane;
    constexpr int R = 4;
    const int* eid = (const int*)(P.ws + WS_ROUTE); const int* pos = eid + 65536; const float* gate = (const float*)(pos + 65536);
    int* rowdest = (int*)(P.ws + WS_ROUTE + 3 * 262144); float* rowgate = (float*)(rowdest + RPAD);
    for (int a = F.vcu * 512 + F.tid; a < 65536; a += F.G * 512) { const int r = (int)lcnt[64 + eid[a]] + pos[a]; rowdest[r] = a; rowgate[r] = gate[a]; }
}
DEVI void phase_final(const Ptrs& P, const Frame& F, float* outp, float oscale) {
    const int gw = F.vcu * NWAVES + F.wave, NGW = F.G * NWAVES, lane = F.lane;
    constexpr int R = 4;
    f32x4 fnv[2][2];
#pragma unroll
    for (int j = 0; j < 2; ++j)
#pragma unroll
        for (int hh = 0; hh < 2; ++hh) fnv[j][hh] = *(const f32x4*)(P.final_norm + (lane + 64 * j) * 8 + 4 * hh);
    for (int rb = gw; rb < TL / R; rb += NGW) { const int row0 = rb * R;
        v4u xa[R][2]; u32x2 ya[R][2], yb[R][2]; f32x4 gq[2][2];
        const float* g2 = (const float*)(P.ws + WS_MOD) + (row0 / SEQ) * 6144 + 5120;
#pragma unroll
        for (int r = 0; r < R; ++r) { const size_t row = (size_t)(row0 + r);
#pragma unroll
            for (int j = 0; j < 2; ++j) { const int c0 = (lane + 64 * j) * 8; xa[r][j] = __builtin_nontemporal_load((const v4u*)((const bf16*)(P.ws + WS_X1) + row * DM + c0));
                ya[r][j] = __builtin_nontemporal_load((const u32x2*)(P.ws + WS_YBUF + row * 2 * DM + c0)); yb[r][j] = __builtin_nontemporal_load((const u32x2*)(P.ws + WS_YBUF + row * 2 * DM + DM + c0)); } }
#pragma unroll
        for (int j = 0; j < 2; ++j) { const int c0 = (lane + 64 * j) * 8; gq[j][0] = *(const f32x4*)(g2 + c0) * (1.f / 16.f); gq[j][1] = *(const f32x4*)(g2 + c0 + 4) * (1.f / 16.f); }
#pragma unroll
        for (int r = 0; r < R; ++r) { const int row = row0 + r;
            float v[16]; float s = 0.f;
#pragma unroll
            for (int j = 0; j < 2; ++j) { const f32x4 ga = gq[j][0], gb = gq[j][1];
                const float gg[8] = {ga[0], ga[1], ga[2], ga[3], gb[0], gb[1], gb[2], gb[3]};
                float ys[8];
#pragma unroll
                for (int d = 0; d < 2; ++d) { const auto a0 = __builtin_amdgcn_cvt_pk_f32_fp8((int)ya[r][j][d], false), a1 = __builtin_amdgcn_cvt_pk_f32_fp8((int)ya[r][j][d], true);
                    const auto b0 = __builtin_amdgcn_cvt_pk_f32_fp8((int)yb[r][j][d], false), b1 = __builtin_amdgcn_cvt_pk_f32_fp8((int)yb[r][j][d], true);
                    ys[4 * d] = a0[0] + b0[0]; ys[4 * d + 1] = a0[1] + b0[1]; ys[4 * d + 2] = a1[0] + b1[0]; ys[4 * d + 3] = a1[1] + b1[1]; }
#pragma unroll
                for (int i = 0; i < 4; ++i) {
                    const float o0 = __uint_as_float(xa[r][j][i] << 16) + gg[2 * i] * ys[2 * i];
                    const float o1 = __uint_as_float(xa[r][j][i] & 0xffff0000u) + gg[2 * i + 1] * ys[2 * i + 1];
                    v[j * 8 + 2 * i] = o0; v[j * 8 + 2 * i + 1] = o1; s += o0 * o0 + o1 * o1; } }
            const float rstd = rsqrtf(wave_sum(s) * (1.f / DM) + EPS) * oscale;
#pragma unroll
            for (int j = 0; j < 2; ++j) { const int c0 = (lane + 64 * j) * 8;
#pragma unroll
                for (int hh = 0; hh < 2; ++hh) { const f32x4 fn = fnv[j][hh]; f32x4 o;
#pragma unroll
                    for (int i = 0; i < 4; ++i) o[i] = v[j * 8 + hh * 4 + i] * rstd * fn[i];
                    *(f32x4*)(outp + (size_t)row * DM + c0 + 4 * hh) = o; } } }
    }
}
typedef short s16x4_t __attribute__((ext_vector_type(4)));
constexpr int S_BS = 0, S_BT = 32768, S_CS = 65536, S_XT = 98304, S_HB = 114688, S_YS = 131072, S_YS_W = 2304, S_SM = S_YS + 8 * S_YS_W;
static_assert(S_SM + 1536 <= LDSCTL_OFF, "ssd LDS map");
DEVI int ssd_sw(int row, int colbyte) { return row * 256 + (colbyte ^ ((row & 15) << 4)); }
DEVI bf16x8 ssd_frag(const LAS unsigned char* tile, int row, int ks, int q) { return *(const LAS bf16x8*)(tile + ssd_sw(row, 64 * ks + 16 * q)); }
DEVI float fast_exp(float x) { return __expf(x); }
DEVI void ssd_weight_load(const Ptrs& P, int item, int lane, float (&v)[8]) {
    const int kb = item & 63, nb = (item >> 6) & 15, half = (item >> 10) & 1, e = item >> 11;
    const float* W = (half ? P.w_eu : P.w_eg) + (size_t)e * DM * DE + (size_t)(kb * 16 + (lane >> 5)) * DE + nb * 32 + (lane & 31);
#pragma unroll
    for (int i = 0; i < 8; ++i) v[i] = __builtin_nontemporal_load(W + (size_t)(2 * i) * DE);
}
DEVI void ssd_weight_store(const Ptrs& P, int item, int lane, const float (&v)[8], LAS float* scr) {
    const int kb = item & 63, nb = (item >> 6) & 15, half = (item >> 10) & 1, e = item >> 11, n0 = nb * 32;
    asm volatile("" ::: "memory");
#pragma unroll
    for (int i = 0; i < 8; ++i) scr[(2 * i + (lane >> 5)) * 33 + (lane & 31)] = v[i];
    LDS_WAIT(); asm volatile("" ::: "memory");
    const int n = lane >> 1, hf = lane & 1; const LAS float* sp = scr + (8 * hf) * 33 + n;
    u32x2 o; o.x = pk4_fp8(32.f * sp[0], 32.f * sp[33], 32.f * sp[2 * 33], 32.f * sp[3 * 33]); o.y = pk4_fp8(32.f * sp[4 * 33], 32.f * sp[5 * 33], 32.f * sp[6 * 33], 32.f * sp[7 * 33]);
    unsigned char* WT = (unsigned char*)(P.ws + WS_WUP) + ((size_t)e * 1024 + (n0 >> 7) * 256 + half * 128 + (n0 & 127) + n) * DM + kb * 16 + 8 * hf;
    *(u32x2*)WT = o;
    LDS_WAIT(); asm volatile("" ::: "memory");
}
#ifndef SSD_STAMP
#define SSD_STAMP 0
#define SSD_STAMP_WAVE 0
#endif
DEVI void phase_ssd(const Ptrs& P, const Frame& F) {
    LAS unsigned char* L = F.lds;
    LAS float* acs = (LAS float*)(L + S_SM); LAS float* dtj = acs + 128; LAS float* wj = acs + 256;
    const int w = F.wave;
    const bf16* xbc = (const bf16*)(P.ws + WS_XC); const float* dtv = (const float*)(P.ws + WS_DTV);
    for (int id = F.vcu; id < 256; id += F.G) {
    const int dir = id & 1, h = (id >> 1) & 15, b = id >> 5, g = h >> 2;
    bf16* yout = (bf16*)(P.ws + (dir ? WS_YB : WS_YF));
    const float Aneg = -__expf(P.a_log[dir * 16 + h]); const float Dsk = dir == 0 ? P.d_skip[h] : 0.f;
    const int jt = (w < 4) ? 2 * w : 15 - 2 * w;
    const bool light = jt < 4; const int li = w < 2 ? w : w - 4;
    f32x4 acc_h[2][4];
#pragma unroll
    for (int nt = 0; nt < 2; ++nt)
#pragma unroll
        for (int pt = 0; pt < 4; ++pt) acc_h[nt][pt] = (f32x4){0.f, 0.f, 0.f, 0.f};
    float dA, dB; unsigned raw[5][8];
#define SSD_GEOM(stp) const bool isx = (stp) >= 2; const int len = isx ? SEQ : CTX; const size_t rbase = isx ? (size_t)b * SEQ : (size_t)TL + (size_t)b * CTX; \
        const int t0 = 128 * (isx ? (dir ? 31 - ((stp) - 2) : (stp) - 2) : (dir ? 1 - (stp) : (stp)));
#define SSD_ISSUE(stp, i_lo, i_hi, with_dt) do { SSD_GEOM(stp) int ln = F.lane; asm volatile("" : "+v"(ln)); \
        if (with_dt) { const int tA = t0 + (dir ? 127 - ln : ln), tB = t0 + (dir ? 63 - ln : 64 + ln); dA = dtv[(rbase + tA) * 32 + dir * 16 + h]; dB = dtv[(rbase + tB) * 32 + dir * 16 + h]; } \
        _Pragma("unroll") for (int i5 = (i_lo); i5 < (i_hi); ++i5) { const int kind = i5 < 2 ? 0 : (i5 < 3 ? 2 : 1); const int tg = kind == 2 ? 2 * w + (ln >> 5) : (w + 8 * (i5 & 1)); \
            const int ch = kind == 0 ? 1024 + g * 128 + 2 * ln : (kind == 1 ? 1536 + g * 128 + 2 * ln : h * 64 + 2 * (ln & 31)); \
            const bf16* src = xbc + (rbase + t0 + 8 * tg) * 2048 + ch; \
            _Pragma("unroll") for (int i = 0; i < 8; ++i) raw[i5][i] = kind == 2 ? __builtin_nontemporal_load((const unsigned*)(src + (size_t)i * 2048)) : *(const unsigned*)(src + (size_t)i * 2048); } } while (0)
    __syncthreads();
    SSD_ISSUE(0, 0, 5, true);
    unsigned long long tacc0 = 0, tacc1 = 0, tacc2 = 0, tsub0 = 0, tsub1 = 0, tsub2 = 0;
    for (int stp = 0; stp < 34; ++stp) {
        const unsigned long long tm0 = (SSD_STAMP) ? __builtin_amdgcn_s_memtime() : 0ull;
        SSD_GEOM(stp)
        int lane = F.lane; asm volatile("" : "+v"(lane));
        const int c = lane & 15, q = lane >> 4, cq4 = (q ^ c) << 4;
        float a_tot;
        { float sA = dA * Aneg, sB = dB * Aneg;
#define SSD_DPP_ADD(v, sh) v += __builtin_bit_cast(float, __builtin_amdgcn_update_dpp(0, __builtin_bit_cast(int, v), 0x110 + (sh), 0xf, 0xf, true))
          SSD_DPP_ADD(sA, 1); SSD_DPP_ADD(sB, 1); SSD_DPP_ADD(sA, 2); SSD_DPP_ADD(sB, 2); SSD_DPP_ADD(sA, 4); SSD_DPP_ADD(sB, 4); SSD_DPP_ADD(sA, 8); SSD_DPP_ADD(sB, 8);
#undef SSD_DPP_ADD
#define RDL(v, l) __builtin_bit_cast(float, __builtin_amdgcn_readlane(__builtin_bit_cast(int, v), l))
          { const float a0 = RDL(sA, 15), a1 = RDL(sA, 31), a2 = RDL(sA, 47), a3 = RDL(sA, 63);
            const float b0 = RDL(sB, 15), b1 = RDL(sB, 31), b2 = RDL(sB, 47), b3 = RDL(sB, 63);
            const int rw = lane >> 4; const float totA = ((a0 + a1) + a2) + a3;
            sA += rw == 0 ? 0.f : (rw == 1 ? a0 : (rw == 2 ? a0 + a1 : (a0 + a1) + a2));
            sB += totA + (rw == 0 ? 0.f : (rw == 1 ? b0 : (rw == 2 ? b0 + b1 : (b0 + b1) + b2)));
            a_tot = totA + (((b0 + b1) + b2) + b3); }
#undef RDL
          acs[lane] = sA; acs[64 + lane] = sB; dtj[lane] = dA; dtj[64 + lane] = dB; wj[lane] = fast_exp(a_tot - sA); wj[64 + lane] = fast_exp(a_tot - sB); }
        LDS_WAIT(); asm volatile("" ::: "memory");
#pragma unroll
        for (int i5 = 0; i5 < 5; ++i5) {
            const int kind = i5 < 2 ? 0 : (i5 < 3 ? 2 : 1);
            const int tg = kind == 2 ? 2 * w + (lane >> 5) : (w + 8 * (i5 & 1));
            if (kind == 1 && !isx) continue;
            float v[8][2];
#pragma unroll
            for (int o = 0; o < 8; ++o) { v[o][0] = __uint_as_float(raw[i5][o] << 16); v[o][1] = __uint_as_float(raw[i5][o] & 0xffff0000u); }
            const int jg = dir ? 15 - tg : tg;
            if (kind < 2) { LAS unsigned char* rm = L + (kind == 0 ? S_BS : S_CS);
#pragma unroll
                for (int o = 0; o < 8; ++o) { const int j = dir ? 127 - (8 * tg + o) : 8 * tg + o; *(LAS unsigned*)(rm + ssd_sw(j, 4 * lane)) = raw[i5][o]; } }
            if (kind != 1) { const f32x4 s0 = *(const LAS f32x4*)((kind == 0 ? wj : dtj) + 8 * jg), s1 = *(const LAS f32x4*)((kind == 0 ? wj : dtj) + 8 * jg + 4);
                const float sc[8] = {s0[0], s0[1], s0[2], s0[3], s1[0], s1[1], s1[2], s1[3]};
                LAS unsigned char* tt = L + (kind == 0 ? S_BT : S_XT); const int r0 = kind == 0 ? 2 * lane : 2 * (lane & 31);
#pragma unroll
                for (int cc = 0; cc < 2; ++cc) { float e[8];
#pragma unroll
                    for (int ee = 0; ee < 8; ++ee) e[ee] = (dir ? v[7 - ee][cc] : v[ee][cc]) * sc[ee];
                    v4u o4; o4.x = pk2(e[0], e[1]); o4.y = pk2(e[2], e[3]); o4.z = pk2(e[4], e[5]); o4.w = pk2(e[6], e[7]);
                    *(LAS v4u*)(tt + ssd_sw(r0 + cc, 16 * jg)) = o4; } }
        }
        const unsigned long long tm1 = (SSD_STAMP) ? __builtin_amdgcn_s_memtime() : 0ull;
        __syncthreads();
        const unsigned long long tm2 = (SSD_STAMP) ? __builtin_amdgcn_s_memtime() : 0ull;
        const float e_tot = fast_exp(a_tot);
        if (stp + 1 < 34) SSD_ISSUE(stp + 1, 0, 2, true);
#define SSD_FRAG(tile_off, rowt, ks) (*(const LAS bf16x8*)(L + (tile_off) + (16 * (rowt) + c) * 256 + ((64 * (ks)) ^ cq4)))
        if (isx) {
            bf16x8 cf[4];
#pragma unroll
            for (int ks = 0; ks < 4; ++ks) cf[ks] = SSD_FRAG(S_CS, jt, ks);
            const int npair = (jt >> 1) + 1;
            bf16x8 bs0[4], bs1[4]; f32x4 as0, as1;
#define SSD_LOADPAIR(t_) do { const int st0_ = 2 * (t_), st1_ = (2 * (t_) + 1 <= jt) ? 2 * (t_) + 1 : 2 * (t_); \
                _Pragma("unroll") for (int ks = 0; ks < 4; ++ks) { bs0[ks] = SSD_FRAG(S_BS, st0_, ks); bs1[ks] = SSD_FRAG(S_BS, st1_, ks); } \
                as0 = *(const LAS f32x4*)(acs + 16 * st0_ + 4 * q); as1 = *(const LAS f32x4*)(acs + 16 * st1_ + 4 * q); } while (0)
            SSD_LOADPAIR(0);
            f32x4 acc_y[4];
            { f32x4 acc_o[4]; bf16x8 hb[4][4];
#pragma unroll
              for (int ks = 0; ks < 4; ++ks)
#pragma unroll
                for (int pt = 0; pt < 4; ++pt) hb[ks][pt] = SSD_FRAG(S_HB, pt, ks);
              const f32x4 aj = *(const LAS f32x4*)(acs + 16 * jt + 4 * q);
#pragma unroll
              for (int pt = 0; pt < 4; ++pt) acc_o[pt] = (f32x4){0.f, 0.f, 0.f, 0.f};
#pragma unroll
              for (int ks = 0; ks < 4; ++ks)
#pragma unroll
                for (int pt = 0; pt < 4; ++pt) acc_o[pt] = __builtin_amdgcn_mfma_f32_16x16x32_bf16(cf[ks], hb[ks][pt], acc_o[pt], 0, 0, 0);
#pragma unroll
              for (int r = 0; r < 4; ++r) { const float ej = fast_exp(aj[r]);
#pragma unroll
                for (int pt = 0; pt < 4; ++pt) acc_y[pt][r] = ej * acc_o[pt][r]; } }
            const unsigned long long tmA = (SSD_STAMP) ? __builtin_amdgcn_s_memtime() : 0ull;
            const float acs_j = acs[16 * jt + c]; const float dsk_j = Dsk * __builtin_amdgcn_rcpf(dtj[16 * jt + c]);
            for (int t = 0; t < npair; ++t) {
                const int st0 = 2 * t, st1 = 2 * t + 1; const bool has1 = st1 <= jt;
                s16x4_t xb[4][2];
#pragma unroll
                for (int pt = 0; pt < 4; ++pt) { const int p = 16 * pt + c; xb[pt][0] = *(const LAS s16x4_t*)(L + S_XT + ssd_sw(p, 64 * t + 8 * q)); xb[pt][1] = *(const LAS s16x4_t*)(L + S_XT + ssd_sw(p, 64 * t + 32 + 8 * q)); }
                f32x4 X0 = (f32x4){0.f, 0.f, 0.f, 0.f}, X1 = (f32x4){0.f, 0.f, 0.f, 0.f};
#pragma unroll
                for (int ks = 0; ks < 4; ++ks) { X0 = __builtin_amdgcn_mfma_f32_16x16x32_bf16(bs0[ks], cf[ks], X0, 0, 0, 0); X1 = __builtin_amdgcn_mfma_f32_16x16x32_bf16(bs1[ks], cf[ks], X1, 0, 0, 0); }
                const f32x4 a0v = as0, a1v = as1;
                { const int tn = t + 1 < npair ? t + 1 : t; SSD_LOADPAIR(tn); }
#pragma unroll
                for (int r = 0; r < 4; ++r) { const int sl = 4 * q + r;
                    const float d0 = fast_exp(fminf(acs_j - a0v[r], 0.f)), d1 = fast_exp(fminf(acs_j - a1v[r], 0.f));
                    float x0 = X0[r] * d0, x1 = X1[r] * d1;
                    if (st0 == jt) { x0 = sl < c ? x0 : (sl == c ? x0 + dsk_j : 0.f); }
                    if (st1 == jt) { x1 = sl < c ? x1 : (sl == c ? x1 + dsk_j : 0.f); }
                    if (!has1) x1 = 0.f;
                    X0[r] = x0; X1[r] = x1; }
                bf16x8 af; { const unsigned a0 = pk2(X0[0], X0[1]), a1 = pk2(X0[2], X0[3]), a2 = pk2(X1[0], X1[1]), a3 = pk2(X1[2], X1[3]);
                    af = (bf16x8){(short)(a0 & 0xffff), (short)(a0 >> 16), (short)(a1 & 0xffff), (short)(a1 >> 16), (short)(a2 & 0xffff), (short)(a2 >> 16), (short)(a3 & 0xffff), (short)(a3 >> 16)}; }
#pragma unroll
                for (int pt = 0; pt < 4; ++pt) { const bf16x8 bfr = (bf16x8){xb[pt][0][0], xb[pt][0][1], xb[pt][0][2], xb[pt][0][3], xb[pt][1][0], xb[pt][1][1], xb[pt][1][2], xb[pt][1][3]};
                    acc_y[pt] = __builtin_amdgcn_mfma_f32_16x16x32_bf16(af, bfr, acc_y[pt], 0, 0, 0); }
            }
#undef SSD_LOADPAIR
            const unsigned long long tmB = (SSD_STAMP) ? __builtin_amdgcn_s_memtime() : 0ull;
            { LAS unsigned char* ys = L + S_YS + w * S_YS_W;
#pragma unroll
              for (int r = 0; r < 4; ++r)
#pragma unroll
                for (int pt = 0; pt < 4; ++pt) *(LAS bf16*)(ys + (4 * q + r) * 144 + (16 * pt + c) * 2) = (bf16)f2bf(acc_y[pt][r]);
              LDS_WAIT(); asm volatile("" ::: "memory");
              const int row = lane >> 2, cbk = (lane & 3) * 32; const v4u o0 = *(const LAS v4u*)(ys + row * 144 + cbk), o1 = *(const LAS v4u*)(ys + row * 144 + cbk + 16);
              const int j = 16 * jt + row; const int tk = t0 + (dir ? 127 - j : j);
              bf16* dst = yout + (rbase + tk) * 1024 + h * 64 + (lane & 3) * 16; *(v4u*)dst = o0; *(v4u*)(dst + 8) = o1; }
            if (SSD_STAMP) { const unsigned long long tmC = __builtin_amdgcn_s_memtime(); tsub0 += tmA - tm2; tsub1 += tmB - tmA; tsub2 += tmC - tmB; }
        }
        if (stp + 1 < 34) SSD_ISSUE(stp + 1, 2, 5, false);
        float wv0[8], wv1[8]; const int witem = ((stp * 256 + id) * 4 + li) * 2;
        if (light && witem < 65536) { ssd_weight_load(P, witem, lane, wv0); ssd_weight_load(P, witem + 1, lane, wv1); }
        if (light) {
#pragma unroll
            for (int nt = 0; nt < 2; ++nt)
#pragma unroll
                for (int pt = 0; pt < 4; ++pt) acc_h[nt][pt] = acc_h[nt][pt] * e_tot;
            bf16x8 xt[4][4];
#pragma unroll
            for (int ks = 0; ks < 4; ++ks)
#pragma unroll
                for (int pt = 0; pt < 4; ++pt) xt[ks][pt] = SSD_FRAG(S_XT, pt, ks);
#pragma unroll
            for (int nt = 0; nt < 2; ++nt) { bf16x8 bt[4];
#pragma unroll
                for (int ks = 0; ks < 4; ++ks) bt[ks] = SSD_FRAG(S_BT, 2 * li + nt, ks);
#pragma unroll
                for (int ks = 0; ks < 4; ++ks)
#pragma unroll
                    for (int pt = 0; pt < 4; ++pt) acc_h[nt][pt] = __builtin_amdgcn_mfma_f32_16x16x32_bf16(bt[ks], xt[ks][pt], acc_h[nt][pt], 0, 0, 0); }
            if (witem < 65536) { LAS float* scr = (LAS float*)(L + S_YS + w * S_YS_W); ssd_weight_store(P, witem, lane, wv0, scr); ssd_weight_store(P, witem + 1, lane, wv1, scr); } }
        const unsigned long long tm3 = (SSD_STAMP) ? __builtin_amdgcn_s_memtime() : 0ull;
        __syncthreads();
        if (SSD_STAMP) { const unsigned long long tm4 = __builtin_amdgcn_s_memtime(); tacc0 += tm1 - tm0; tacc1 += (tm2 - tm1) + (tm4 - tm3); tacc2 += tm3 - tm2; }
        if (light) {
#pragma unroll
            for (int nt = 0; nt < 2; ++nt)
#pragma unroll
                for (int pt = 0; pt < 4; ++pt) { u32x2 hv; hv.x = pk2(acc_h[nt][pt][0], acc_h[nt][pt][1]); hv.y = pk2(acc_h[nt][pt][2], acc_h[nt][pt][3]); *(LAS u32x2*)(L + S_HB + ssd_sw(16 * pt + c, 32 * (2 * li + nt) + 8 * q)) = hv; } }
    }
    __syncthreads();
    if ((SSD_STAMP) && blockIdx.x == 0 && F.tid == (SSD_STAMP_WAVE) * 64) { const float tot = (float)(tacc0 + tacc1 + tacc2); const float sel = (SSD_STAMP) == 1 ? (float)tacc0 : ((SSD_STAMP) == 2 ? (float)tacc1 : ((SSD_STAMP) == 3 ? (float)tacc2 : ((SSD_STAMP) == 4 ? (float)tsub0 : ((SSD_STAMP) == 5 ? (float)tsub1 : (float)tsub2))));
        __hip_atomic_store((float*)(P.ws + WS_CTL) + 64, floorf(sel / tot * 25.f + 0.5f) * 0.04f, RLX_AGENT); }
    }
#undef SSD_GEOM
#undef SSD_ISSUE
#undef SSD_FRAG
}
constexpr size_t WS_T1 = 1 * MiB + 512 * 1024;
constexpr int FT_ROWB = 288, FT_TILE = 128 * FT_ROWB;
DEVI int four_rho(int k) { const int kk = k >> 5, gq = (k >> 3) & 3, jj = k & 7; return 32 * kk + 16 * (jj >> 2) + 4 * gq + (jj & 3); }
DEVI void phase_four_tables(const Ptrs& P, const Frame& F) {
    const int gt = F.vcu * 512 + F.tid, NT = F.G * 512;
    bf16* T1 = (bf16*)(P.ws + WS_T1); bf16* T3 = T1 + 128 * 128;
    for (int o = gt; o < 128 * 128 + 64 * 128; o += NT) {
        if (o < 128 * 128) { const int i = o >> 7, k = o & 127, ks = k >> 5, kq = (k >> 3) & 3, kj = k & 7, ro = i >> 6, k1 = i & 63, ri = ks >> 1, l1 = 16 * (2 * (ks & 1) + (kj >> 2)) + 4 * kq + (kj & 3);
            const float ang = (float)((k1 * l1) & 63) * (2.0f / 64.0f), c = cospif(ang), s = sinpif(ang);
            const float v = ro == 0 ? (ri == 0 ? c : s) : (ri == 0 ? -s : c); T1[o] = (bf16)f2bf(v * 0.125f); }
        else { const int o2 = o - 128 * 128, k2 = o2 >> 7, k = o2 & 127, rho = four_rho(k), ri = rho >> 6, l2 = rho & 63;
            const float ang = (float)((k2 * l2) & 63) * (2.0f / 64.0f); T3[o2] = (bf16)f2bf((ri == 0 ? cospif(ang) : sinpif(ang)) * (0.125f / 16.f)); }
    }
}
DEVI void four_load_T(const bf16* T, int rows, LAS unsigned char* dst, int tid) {
    for (int cid = tid; cid < rows * 16; cid += 512) { const int r = cid >> 4, ch = cid & 15; *(LAS v4u*)(dst + r * 256 + ((ch ^ (r & 15)) << 4)) = *(const v4u*)(T + r * 128 + ch * 8); }
}
DEVI bf16x8 four_Afrag(const LAS unsigned char* T, int it, int ks, int lane) { const int r = 16 * it + (lane & 15), ch = 4 * ks + (lane >> 4); return *(const LAS bf16x8*)(T + r * 256 + ((ch ^ (r & 15)) << 4)); }
DEVI bf16x8 four_Bfrag(const LAS unsigned char* tile, int dt, int ks, int lane) {
    const int gq = lane >> 4, qq = (lane & 15) >> 2, pp = lane & 3;
    const LAS unsigned char* p = tile + (32 * ks + 4 * gq + qq) * FT_ROWB + (16 * dt + 4 * pp) * 2;
    const s16x4 a = __builtin_amdgcn_ds_read_tr16_b64_v4i16((LAS s16x4*)p), b = __builtin_amdgcn_ds_read_tr16_b64_v4i16((LAS s16x4*)(p + 16 * FT_ROWB));
    return (bf16x8){a[0], a[1], a[2], a[3], b[0], b[1], b[2], b[3]};
}
DEVI void phase_four1(const Ptrs& P, const Frame& F) {
    LAS unsigned char* T = F.lds; LAS unsigned char* WcL = F.lds + 32768; LAS unsigned char* buf0 = F.lds + 98304;
    const int g = F.vcu & 3;
    __syncthreads();
    four_load_T((const bf16*)(P.ws + WS_T1), 128, T, F.tid);
    four_load_T((const bf16*)(P.ws + WS_WC) + (size_t)g * 256 * 128, 256, WcL, F.tid);
    const bf16* Fz = (const bf16*)(P.ws + WS_YZ); bf16* AP = (bf16*)(P.ws + WS_AP);
    const int w = F.wave, lane = F.lane, c = lane & 15, q = lane >> 4;
    v4u stA[2], stB[2];
#define F1_ISSUE(ST, u_) do { const int l2_ = ((u_) >> 2) & 63, b_ = (u_) >> 8; \
        _Pragma("unroll") for (int i = 0; i < 2; ++i) { const int cid = F.tid + 512 * i, l1 = cid >> 4, ch = cid & 15; ST[i] = __builtin_nontemporal_load((const v4u*)(Fz + ((size_t)b_ * SEQ + 64 * l1 + l2_) * 512 + g * 128 + ch * 8)); } } while (0)
#define F1_COMMIT(ST, buf_) do { _Pragma("unroll") for (int i = 0; i < 2; ++i) { const int cid = F.tid + 512 * i, l1 = cid >> 4, ch = cid & 15; *(LAS v4u*)((buf_) + l1 * 256 + ((ch ^ (l1 & 15)) << 4)) = ST[i]; } } while (0)
    auto compute = [&](int u, const LAS unsigned char* tile) { const int l2 = (u >> 2) & 63, b = u >> 8;
        f32x4 z[2][4];
#pragma unroll
        for (int ri = 0; ri < 2; ++ri)
#pragma unroll
            for (int it = 0; it < 4; ++it) z[ri][it] = (f32x4){0.f, 0.f, 0.f, 0.f};
#pragma unroll
        for (int ks = 0; ks < 4; ++ks) { const bf16x8 w0 = four_Afrag(WcL, w, ks, lane), w1 = four_Afrag(WcL, 8 + w, ks, lane);
#pragma unroll
            for (int it = 0; it < 4; ++it) { const bf16x8 ff = four_Afrag(tile, it, ks, lane);
                z[0][it] = __builtin_amdgcn_mfma_f32_16x16x32_bf16(ff, w0, z[0][it], 0, 0, 0); z[1][it] = __builtin_amdgcn_mfma_f32_16x16x32_bf16(ff, w1, z[1][it], 0, 0, 0); } }
        bf16x8 zb[4];
#pragma unroll
        for (int s4 = 0; s4 < 4; ++s4) { const f32x4 za = z[s4 >> 1][2 * (s4 & 1)], zc = z[s4 >> 1][2 * (s4 & 1) + 1];
            const unsigned a0 = pk2(za[0], za[1]), a1 = pk2(za[2], za[3]), a2 = pk2(zc[0], zc[1]), a3 = pk2(zc[2], zc[3]);
            zb[s4] = (bf16x8){(short)(a0 & 0xffff), (short)(a0 >> 16), (short)(a1 & 0xffff), (short)(a1 >> 16), (short)(a2 & 0xffff), (short)(a2 >> 16), (short)(a3 & 0xffff), (short)(a3 >> 16)}; }
        f32x4 acc[8];
#pragma unroll
        for (int it = 0; it < 8; ++it) acc[it] = (f32x4){0.f, 0.f, 0.f, 0.f};
#pragma unroll
        for (int ks = 0; ks < 4; ++ks)
#pragma unroll
            for (int it = 0; it < 8; ++it) acc[it] = __builtin_amdgcn_mfma_f32_16x16x32_bf16(four_Afrag(T, it, ks, lane), zb[ks], acc[it], 0, 0, 0);
#pragma unroll
        for (int it = 0; it < 4; ++it)
#pragma unroll
            for (int r = 0; r < 4; ++r) { const int k1 = 16 * it + 4 * q + r; const float ang = (float)((l2 * k1) & 4095) * (1.0f / 4096.0f);
                const float ct = __builtin_amdgcn_cosf(ang), sn = __builtin_amdgcn_sinf(ang); const float ar = acc[it][r], ai = acc[it + 4][r];
                unsigned char* dst = (unsigned char*)AP + (((((size_t)b * 4 + g) * 64 + k1) * 2) * 64 + l2) * 128 + 16 * w + c;
                const int pr = __builtin_amdgcn_cvt_pk_fp8_f32(16.f * (ar * ct + ai * sn), 16.f * (ai * ct - ar * sn), 0, false);
                dst[0] = (unsigned char)(pr & 0xff); dst[64 * 128] = (unsigned char)((pr >> 8) & 0xff); }
    };
    int u = F.vcu;
    if (u < 2048) { F1_ISSUE(stA, u); F1_COMMIT(stA, buf0); }
    if (u + F.G < 2048) F1_ISSUE(stB, u + F.G);
    __syncthreads();
    for (; u < 2048; u += 2 * F.G) {
        const int u1 = u + F.G, u2 = u + 2 * F.G, u3 = u + 3 * F.G;
        if (u2 < 2048) F1_ISSUE(stA, u2);
        compute(u, buf0);
        if (u1 < 2048) F1_COMMIT(stB, buf0 + 16384);
        __syncthreads();
        if (u1 >= 2048) break;
        if (u3 < 2048) F1_ISSUE(stB, u3);
        compute(u1, buf0 + 16384);
        if (u2 < 2048) F1_COMMIT(stA, buf0);
        __syncthreads();
    }
#undef F1_ISSUE
#undef F1_COMMIT
}
DEVI void phase_four3(const Ptrs& P, const Frame& F) {
    LAS unsigned char* T = F.lds; LAS unsigned char* buf0 = F.lds + 32768;
    __syncthreads();
    four_load_T((const bf16*)(P.ws + WS_T1) + 128 * 128, 64, T, F.tid);
    const bf16* AP = (const bf16*)(P.ws + WS_AP); bf16* mix = (bf16*)(P.ws + WS_MIX);
    const int w = F.wave, lane = F.lane, c = lane & 15, q = lane >> 4;
    v4u stA[2], stB[2];
#define F3_ISSUE(ST, u_) do { const int g_ = (u_) & 3, k1_ = ((u_) >> 2) & 63, b_ = (u_) >> 8; const unsigned char* src_ = (const unsigned char*)AP + ((((size_t)b_ * 4 + g_) * 64 + k1_) * 128) * 128; \
        _Pragma("unroll") for (int i = 0; i < 2; ++i) ST[i] = __builtin_nontemporal_load((const v4u*)(src_ + (size_t)(F.tid + 512 * i) * 16)); } while (0)
#define F3_COMMIT(ST, buf_) do { _Pragma("unroll") for (int i = 0; i < 2; ++i) { const int cid = F.tid + 512 * i, rho = cid >> 3, ch = 2 * (cid & 7); v4u lo_, hi_; \
        { const auto a0 = __builtin_amdgcn_cvt_pk_f32_fp8((int)ST[i].x, false), a1 = __builtin_amdgcn_cvt_pk_f32_fp8((int)ST[i].x, true), a2 = __builtin_amdgcn_cvt_pk_f32_fp8((int)ST[i].y, false), a3 = __builtin_amdgcn_cvt_pk_f32_fp8((int)ST[i].y, true); \
          lo_.x = pk2(a0[0], a0[1]); lo_.y = pk2(a1[0], a1[1]); lo_.z = pk2(a2[0], a2[1]); lo_.w = pk2(a3[0], a3[1]); } \
        { const auto a0 = __builtin_amdgcn_cvt_pk_f32_fp8((int)ST[i].z, false), a1 = __builtin_amdgcn_cvt_pk_f32_fp8((int)ST[i].z, true), a2 = __builtin_amdgcn_cvt_pk_f32_fp8((int)ST[i].w, false), a3 = __builtin_amdgcn_cvt_pk_f32_fp8((int)ST[i].w, true); \
          hi_.x = pk2(a0[0], a0[1]); hi_.y = pk2(a1[0], a1[1]); hi_.z = pk2(a2[0], a2[1]); hi_.w = pk2(a3[0], a3[1]); } \
        *(LAS v4u*)((buf_) + rho * FT_ROWB + ch * 16) = lo_; *(LAS v4u*)((buf_) + rho * FT_ROWB + ch * 16 + 16) = hi_; } } while (0)
#define F3_COMPUTE(u_, tile_) do { const int g = (u_) & 3, k1 = ((u_) >> 2) & 63, b = (u_) >> 8; f32x4 acc[4]; \
        _Pragma("unroll") for (int it = 0; it < 4; ++it) acc[it] = (f32x4){0.f, 0.f, 0.f, 0.f}; \
        _Pragma("unroll") for (int ks = 0; ks < 4; ++ks) { const bf16x8 bf = four_Bfrag((tile_), w, ks, lane); \
            _Pragma("unroll") for (int it = 0; it < 4; ++it) acc[it] = __builtin_amdgcn_mfma_f32_16x16x32_bf16(four_Afrag(T, it, ks, lane), bf, acc[it], 0, 0, 0); } \
        _Pragma("unroll") for (int it = 0; it < 4; ++it) _Pragma("unroll") for (int r = 0; r < 4; ++r) { const int k2 = 16 * it + 4 * q + r; mix[((size_t)b * SEQ + k1 + 64 * k2) * MIXLD + 512 + g * 128 + 16 * w + c] = (bf16)f2bf(acc[it][r]); } } while (0)
    int u = F.vcu;
    if (u < 2048) { F3_ISSUE(stA, u); F3_COMMIT(stA, buf0); }
    if (u + F.G < 2048) F3_ISSUE(stB, u + F.G);
    __syncthreads();
    for (; u < 2048; u += 2 * F.G) {
        const int u1 = u + F.G, u2 = u + 2 * F.G, u3 = u + 3 * F.G;
        if (u2 < 2048) F3_ISSUE(stA, u2);
        F3_COMPUTE(u, buf0);
        if (u1 < 2048) F3_COMMIT(stB, buf0 + FT_TILE);
        __syncthreads();
        if (u1 >= 2048) break;
        if (u3 < 2048) F3_ISSUE(stB, u3);
        F3_COMPUTE(u1, buf0 + FT_TILE);
        if (u2 < 2048) F3_COMMIT(stA, buf0);
        __syncthreads();
    }
#undef F3_ISSUE
#undef F3_COMMIT
#undef F3_COMPUTE
}
#ifndef MK_N_LAUNCHES
#define MK_N_LAUNCHES 1
#endif
constexpr int NPHASE = 11;
#ifndef DUPMASK
#define DUPMASK 0
#endif
#ifndef PG8_STAMP_PHASE
#define PG8_STAMP_PHASE 2
#endif
#ifndef STAMPK
#define STAMPK -1
#endif
#define DUP(k) for (int _d = 0; _d < (((DUPMASK) >> (k)) & 1) + 1; ++_d)
DEVI unsigned long long rfl64(unsigned long long v) { const unsigned lo = __builtin_amdgcn_readfirstlane((unsigned)v), hi = __builtin_amdgcn_readfirstlane((unsigned)(v >> 32)); return ((unsigned long long)hi << 32) | lo; }
DEVI void store_ptrs(const Ptrs& A, LAS unsigned long long* lp) { lp[0] = (unsigned long long)A.x; lp[1] = (unsigned long long)A.c; lp[2] = (unsigned long long)A.ctx; lp[3] = (unsigned long long)A.c_ctx; lp[4] = (unsigned long long)A.w_mod; lp[5] = (unsigned long long)A.b_mod; lp[6] = (unsigned long long)A.norm1; lp[7] = (unsigned long long)A.w_in; lp[8] = (unsigned long long)A.conv_w; lp[9] = (unsigned long long)A.conv_b; lp[10] = (unsigned long long)A.dt_bias; lp[11] = (unsigned long long)A.a_log; lp[12] = (unsigned long long)A.d_skip; lp[13] = (unsigned long long)A.ssd_norm; lp[14] = (unsigned long long)A.w_four; lp[15] = (unsigned long long)A.w_out; lp[16] = (unsigned long long)A.norm2; lp[17] = (unsigned long long)A.w_rg; lp[18] = (unsigned long long)A.b_rg; lp[19] = (unsigned long long)A.w_re; lp[20] = (unsigned long long)A.b_re; lp[21] = (unsigned long long)A.w_eg; lp[22] = (unsigned long long)A.w_eu; lp[23] = (unsigned long long)A.w_ed; lp[24] = (unsigned long long)A.final_norm; lp[25] = (unsigned long long)A.out; lp[26] = (unsigned long long)A.ws; }
DEVI void load_ptrs(Ptrs& P, const LAS unsigned long long* lp) { P.x = (const float*)(const GAS float*)rfl64(lp[0]); P.c = (const float*)(const GAS float*)rfl64(lp[1]); P.ctx = (const float*)(const GAS float*)rfl64(lp[2]); P.c_ctx = (const float*)(const GAS float*)rfl64(lp[3]); P.w_mod = (const float*)(const GAS float*)rfl64(lp[4]); P.b_mod = (const float*)(const GAS float*)rfl64(lp[5]); P.norm1 = (const float*)(const GAS float*)rfl64(lp[6]); P.w_in = (const float*)(const GAS float*)rfl64(lp[7]); P.conv_w = (const float*)(const GAS float*)rfl64(lp[8]); P.conv_b = (const float*)(const GAS float*)rfl64(lp[9]); P.dt_bias = (const float*)(const GAS float*)rfl64(lp[10]); P.a_log = (const float*)(const GAS float*)rfl64(lp[11]); P.d_skip = (const float*)(const GAS float*)rfl64(lp[12]); P.ssd_norm = (const float*)(const GAS float*)rfl64(lp[13]); P.w_four = (const float*)(const GAS float*)rfl64(lp[14]); P.w_out = (const float*)(const GAS float*)rfl64(lp[15]); P.norm2 = (const float*)(const GAS float*)rfl64(lp[16]); P.w_rg = (const float*)(const GAS float*)rfl64(lp[17]); P.b_rg = (const float*)(const GAS float*)rfl64(lp[18]); P.w_re = (const float*)(const GAS float*)rfl64(lp[19]); P.b_re = (const float*)(const GAS float*)rfl64(lp[20]); P.w_eg = (const float*)(const GAS float*)rfl64(lp[21]); P.w_eu = (const float*)(const GAS float*)rfl64(lp[22]); P.w_ed = (const float*)(const GAS float*)rfl64(lp[23]); P.final_norm = (const float*)(const GAS float*)rfl64(lp[24]); P.out = (float*)(GAS float*)rfl64(lp[25]); P.ws = (unsigned char*)(GAS unsigned char*)rfl64(lp[26]); }
struct Args { Ptrs P; int ph_lo, ph_hi; };
__global__ void __launch_bounds__(NWAVES * 64, 2) fwd_megakernel(Args args) {
    extern __shared__ __attribute__((aligned(16))) unsigned char lds_raw[];
    Frame F; F.lds = (LAS unsigned char*)lds_raw;
    F.tid = threadIdx.x; F.lane = F.tid & 63; F.wave = __builtin_amdgcn_readfirstlane(F.tid >> 6);
    F.G = gridDim.x; { const int bx = blockIdx.x; F.vcu = (F.G % 8 == 0) ? (bx % 8) * (F.G / 8) + bx / 8 : bx; }
    for (int u = F.tid; u < (LDS_BYTES - LDSCTL_OFF) / 4; u += NWAVES * 64) ((LAS unsigned*)(F.lds + LDSCTL_OFF))[u] = 0u;
    __syncthreads();
    LAS unsigned long long* lp = (LAS unsigned long long*)(F.lds + LDSCTL_OFF + LC_PTR);
    if (F.tid == 0) store_ptrs(args.P, lp);
    unsigned char* const ws0 = args.P.ws;
    __syncthreads();
#define LOADP Ptrs P; load_ptrs(P, lp); asm volatile("" : "+v"(F.tid) :: "memory"); F.lane = F.tid & 63
    XcdBarrier bar; bar.bar = (unsigned*)(ws0 + WS_CTL) + CW_BAR; bar.x = 0; bar.st = nullptr;
    const bool one = (args.ph_hi - args.ph_lo) > 1;
    if (one) bar = xcd_barrier_post((unsigned*)(ws0 + WS_CTL) + CW_BAR, (volatile LAS unsigned*)(F.lds + LDSCTL_OFF + LC_MISC) + 8);
    const int lo = args.ph_lo, hi = args.ph_hi;
    if (STAMPK >= 0 && blockIdx.x == 0 && F.tid == 0) ((LAS unsigned long long*)(F.lds + LDSCTL_OFF + LC_TS))[0] = __builtin_amdgcn_s_memrealtime();
#define IN(k) (lo <= (k) && (k) < hi)
#define SEAM(k) do { if (IN(k) && IN((k) + 1)) { if (STAMPK >= 0 && (k) == 10 && blockIdx.x == 0 && F.tid == 0) { const unsigned long long tn = __builtin_amdgcn_s_memrealtime(); LAS unsigned long long* tsl = (LAS unsigned long long*)(F.lds + LDSCTL_OFF + LC_TS); \
            const float tot = (float)(tn - tsl[0]); const float tk = STAMPK == 10 ? (float)(tn - tsl[10]) : (float)(tsl[STAMPK + 1] - tsl[STAMPK]); __hip_atomic_store((float*)(ws0 + WS_CTL) + 64, floorf(tk / tot * 50.f + 0.5f) * 0.02f, RLX_AGENT); }     \
        xcd_barrier(bar); if ((DUPMASK >> 14) & 1) xcd_barrier(bar); \
        if (STAMPK >= 0 && blockIdx.x == 0 && F.tid == 0) ((LAS unsigned long long*)(F.lds + LDSCTL_OFF + LC_TS))[(k) + 1] = __builtin_amdgcn_s_memrealtime(); } } while (0)
    if (IN(0)) { LOADP; DUP(0) { phase0a(P, F); phase_four_tables(P, F); } } SEAM(0);
    if (IN(1)) { LOADP; DUP(1) phase0b(P, F); } SEAM(1);
    if (IN(2)) { LOADP;
        pg8::Gemm g{(const bf16*)(P.ws + WS_XN), (const bf16*)(P.ws + WS_WIN), TA, NIN, DM / 2}; if ((PG8_STAMP) && (PG8_STAMP_PHASE) == 2) g.stamp = (float*)(ws0 + WS_CTL) + 64; pg8::InProjOrder S{F.G, (int)blockIdx.x};
        LAS float* stab = (LAS float*)(F.lds + pg8::STAGE_BYTES);
        { pg8::Unit su; __syncthreads(); for (int i = 0; i < 8 && S.next(i, su); ++i) stab[i * 512 + F.tid] = F.tid < 256 ? ((const float*)(P.ws + WS_SAI))[su.pm * 256 + F.tid] : ((const float*)(P.ws + WS_SBI))[su.pn * 256 + F.tid - 256]; __syncthreads(); }
        pg8::EpiInProjI8 E{(bf16*)(P.ws + WS_ZS), (bf16*)(P.ws + WS_XBC), (bf16*)(P.ws + WS_YZ), (float*)(P.ws + WS_DTV), P.dt_bias, (const float*)(P.ws + WS_SAI), (const float*)(P.ws + WS_SBI), (const LAS float*)stab, 0};
        if ((DUPMASK >> 2) & 1) { pg8::gemm_phase<pg8::EpiInProjI8, pg8::InProjOrder, true, true, false, false, true>(F.lds, g, S, E); __syncthreads(); asm volatile("" : "+v"(F.tid) :: "memory"); }
        pg8::gemm_phase<pg8::EpiInProjI8, pg8::InProjOrder, true, true, false, false, true>(F.lds, g, S, E);
    } SEAM(2);
    if (IN(3)) { LOADP; DUP(11) phase_conv(P, F); asm volatile("" : "+v"(F.tid) :: "memory"); F.lane = F.tid & 63; DUP(4) phase_four1(P, F); } SEAM(3);
    if (IN(4)) { LOADP; DUP(3) phase_ssd(P, F); } SEAM(4);
    if (IN(5)) { LOADP; DUP(4) phase_four3(P, F); if ((DUPMASK >> 5) & 1) { phase_combine<((DUPMASK >> 15) & 1) != 0>(P, F); asm volatile("" : "+v"(F.tid) :: "memory"); F.lane = F.tid & 63; } phase_combine(P, F); } SEAM(5);
    if (IN(6)) { LOADP;
        int ko = MIXLD, k8 = 8; asm volatile("" : "+s"(ko), "+s"(k8));
        pg8::Gemm g{(const bf16*)(P.ws + WS_MIX), (const bf16*)(P.ws + WS_WOUT), TL, DM, ko, nullptr, 0x7f7f7f7f, 0x7f7f7f7f, k8, (const float*)(P.ws + WS_SAO)}; pg8::StaticOrder S; S.init(TL, DM, F.G, (int)blockIdx.x);
        LAS float* gtab = (LAS float*)(F.lds + pg8::STAGE_BYTES + 8192);
        { pg8::Unit su; __syncthreads(); for (int i = 0; i < 8 && S.next(i, su); ++i) if (F.tid < 256) gtab[i * 256 + F.tid] = ((const float*)(P.ws + WS_MOD))[(size_t)(su.pm >> 4) * 6144 + 2048 + su.pn * 256 + F.tid] * ((const float*)(P.ws + WS_SBO))[su.pn * 256 + F.tid]; __syncthreads(); }
        pg8::EpiOutProj E{P.x, (bf16*)(P.ws + WS_X1), (const float*)(P.ws + WS_MOD), (const float*)(P.ws + WS_SBO), (const LAS float*)gtab, 0};
        if ((DUPMASK >> 6) & 1) { pg8::gemm_phase<pg8::EpiOutProj, pg8::StaticOrder, true, true, false, false, false, true>(F.lds, g, S, E); __syncthreads(); asm volatile("" : "+v"(F.tid) :: "memory"); }
        pg8::gemm_phase<pg8::EpiOutProj, pg8::StaticOrder, true, true, false, false, false, true>(F.lds, g, S, E);
    } SEAM(6);
    if (IN(7)) { LOADP; if ((DUPMASK >> 12) & 1) phase_route(P, F, true); phase_route(P, F, false); } SEAM(7);
    if (IN(9)) { LOADP;
        const int nt = build_tile_table(P, F);
        pg8::MoeOrder S{(const LAS int*)(F.lds + LDSCTL_OFF + LC_TILE), nt, F.G, (int)blockIdx.x};
        { pg8::Unit su; for (int i = 0; S.next(i, su); ++i) tile_rows(P, F, su.pm); asm volatile("s_waitcnt vmcnt(0)" ::: "memory"); __syncthreads(); }
        pg8::Gemm g{(const bf16*)(P.ws + WS_HPERM), (const bf16*)(P.ws + WS_WUP), RPAD, NE * 1024, DM / 2, (const int*)(P.ws + WS_ROUTE + 3 * 262144), 0x7f7f7f7f, 0x7a7a7a7a};
        pg8::EpiUp E{(unsigned char*)(P.ws + WS_ACT)};
        if ((DUPMASK >> 9) & 1) { pg8::gemm_phase<pg8::EpiUp, pg8::MoeOrder, true, true, true, true>(F.lds, g, S, E); __syncthreads(); asm volatile("" : "+v"(F.tid) :: "memory"); }
        pg8::gemm_phase<pg8::EpiUp, pg8::MoeOrder, true, true, true, true>(F.lds, g, S, E);
        {
          constexpr int I_DN = 32 * 256, PER_WG = 64;
          const int nwg = nt * 4, R = (nwg + F.G - 1) / F.G, first_idle = nwg - (R - 1) * F.G, n_idle = R * F.G - nwg, c = (int)blockIdx.x;
          const int n_tail = n_idle * PER_WG < I_DN ? n_idle * PER_WG : I_DN;
          __syncthreads();
          if (n_idle > 0 && c >= first_idle) phase_expert_weights(P, F, 0, n_tail, (c - first_idle) * NWAVES + F.wave, n_idle * NWAVES);
          if (n_tail < I_DN) phase_expert_weights(P, F, n_tail, I_DN, F.vcu * NWAVES + F.wave, F.G * NWAVES); }
    } SEAM(9);
    if (IN(10)) { LOADP;
        const int nt = build_tile_table(P, F);
        pg8::MoeOrder S{(const LAS int*)(F.lds + LDSCTL_OFF + LC_TILE), nt, F.G, (int)blockIdx.x};
        int kd = DE / 2; asm volatile("" : "+s"(kd));
        pg8::Gemm g{(const bf16*)(P.ws + WS_ACT), (const bf16*)(P.ws + WS_WDN), RPAD, NE * 1024, kd, nullptr, 0x7d7d7d7d, 0x7a7a7a7a};
        LAS int* dtab = (LAS int*)(F.lds + pg8::STAGE_BYTES);
        { pg8::Unit su; __syncthreads(); for (int i = 0; i < 8 && S.next(i, su); ++i) dtab[i * 512 + F.tid] = ((const int*)(P.ws + WS_ROUTE + 3 * 262144))[(F.tid < 256 ? 0 : RPAD - 256) + su.pm * 256 + F.tid]; __syncthreads(); }
        pg8::EpiDown E{(bf16*)(P.ws + WS_YBUF), (const int*)(P.ws + WS_ROUTE + 3 * 262144), (const float*)(P.ws + WS_ROUTE + 3 * 262144 + 4 * RPAD), (const LAS int*)dtab, 0};
        DUP(10) pg8::gemm_phase<pg8::EpiDown, pg8::MoeOrder, true, true, false, true>(F.lds, g, S, E);
    } SEAM(10);
    if (IN(11)) { LOADP; if ((DUPMASK >> 13) & 1) phase_final(P, F, (float*)(P.ws + WS_XC), 1.f); phase_final(P, F, P.out, (STAMPK >= 0 || (SSD_STAMP) || (PG8_STAMP)) ? 1.f + __hip_atomic_load((float*)(ws0 + WS_CTL) + 64, RLX_AGENT) : 1.f); }
#undef IN
#undef SEAM
}

extern "C" void kernel_launch(void* const* d_in, const int* in_sizes, int n_in, void* d_out, int out_size, void* d_ws, size_t ws_size, hipStream_t stream) {
    static int grid = 0;
    if (grid == 0) {
        if (n_in != 25 || in_sizes[0] != TL * DM || out_size != TL * DM || ws_size < WS_END) { fprintf(stderr, "kernel_launch: unexpected shapes (n_in %d, ws %zu)\n", n_in, ws_size); grid = -1; return; }
        int dev = 0, cus = 0, per_cu = 0;
        if (hipGetDevice(&dev) != hipSuccess || hipDeviceGetAttribute(&cus, hipDeviceAttributeMultiprocessorCount, dev) != hipSuccess) { grid = -1; return; }
        if (hipFuncSetAttribute((const void*)fwd_megakernel, hipFuncAttributeMaxDynamicSharedMemorySize, LDS_BYTES) != hipSuccess) { fprintf(stderr, "kernel_launch: hipFuncSetAttribute failed\n"); grid = -1; return; }
        if (hipOccupancyMaxActiveBlocksPerMultiprocessor(&per_cu, (const void*)fwd_megakernel, NWAVES * 64, LDS_BYTES) != hipSuccess || per_cu < 1) fprintf(stderr, "kernel_launch: occupancy query reports %d\n", per_cu);
        (void)hipGetLastError();
        grid = cus;
        if (grid != 256) fprintf(stderr, "kernel_launch: built for 256 CUs, got %d\n", grid);
    }
    if (grid < 0) return;
    (void)hipMemsetAsync((char*)d_ws + WS_CTL, 0, CTL_ZERO_BYTES, stream);
    Args a{};
    const float** pp = (const float**)&a.P;
    for (int i = 0; i < 25; ++i) pp[i] = (const float*)d_in[i];
    a.P.out = (float*)d_out; a.P.ws = (unsigned char*)d_ws;
#if MK_N_LAUNCHES == 1
    a.ph_lo = 0; a.ph_hi = NPHASE + 1;
    hipLaunchKernelGGL(fwd_megakernel, dim3(grid), dim3(NWAVES * 64), LDS_BYTES, stream, a);
#else
    for (int ph = 0; ph <= NPHASE; ++ph) { a.ph_lo = ph; a.ph_hi = ph + 1; hipLaunchKernelGGL(fwd_megakernel, dim3(grid), dim3(NWAVES * 64), LDS_BYTES, stream, a); }
#endif
}
```

```cpp
#include <hip/hip_runtime.h>
#include <cstdio>
#include <cstdint>
namespace pg8 {
#define PG8_LAS __attribute__((address_space(3)))
typedef unsigned short bf16_t;
typedef short bf16x8 __attribute__((ext_vector_type(8)));
typedef float f32x4 __attribute__((ext_vector_type(4)));
typedef unsigned u32x4 __attribute__((ext_vector_type(4)));
constexpr int BM = 256, BK = 64, HALF = 128, HTB = HALF * BK * 2  , STAGE_BYTES = 8 * HTB, NXCD = 8, WGM = 8;

__host__ __device__ __forceinline__ int lds_byte(int r, int c) { const int st = (r >> 4) * 2 + (c >> 5), rr = r & 15, cc = c & 31, ob = rr * 64 + cc * 2; return st * 1024 + (ob ^ (((ob >> 9) & 1) << 5)); }
__host__ __device__ __forceinline__ void stage_rc(int b, int& R, int& C) { const int st = b / 1024, sb = b % 1024, swz = sb ^ (((sb >> 9) & 1) << 5); R = (st >> 1) * 16 + swz / 64; C = (st & 1) * 32 + (swz % 64) / 2; }
__host__ __device__ __forceinline__ int perm32(int rho) { const int n = rho >> 4, i = rho & 15; return 8 * (i >> 2) + 4 * n + (i & 3); }

struct Unit { int pm, pn; };
struct Gemm { const bf16_t* A; const bf16_t* Bt; int M, N, K; const int* gat = nullptr; int scale_a = 0x7f7f7f7f, scale_b = 0x7f7f7f7f; int k8 = 0; const float* sa = nullptr; float* stamp = nullptr; };

struct OneUnit {
    int pm, pn;
    __device__ __forceinline__ bool next(int i, Unit& u) const { if (i != 0) return false; u.pm = pm; u.pn = pn; return true; }
    __device__ __forceinline__ void a_ready(const Unit&) const {}
    __device__ __forceinline__ void done(const Unit&) const {}
};
struct StaticOrder {
    int nM, nN, nwg, G, c;
    __host__ __device__ void init(int M, int N, int G_, int c_) { nM = M / BM; nN = N / BM; nwg = nM * nN; G = G_; c = c_; }
    __host__ __device__ bool next(int i, Unit& u) const {
        const long L = (long)i * G + c; if (L >= nwg) return false;
        int wgid = (int)L; { const int q = nwg / NXCD, r = nwg % NXCD, xcd = wgid % NXCD, off = wgid / NXCD; wgid = (xcd < r ? xcd * (q + 1) : r * (q + 1) + (xcd - r) * q) + off; }
        const int nig = WGM * nN, gid = wgid / nig, fm = gid * WGM, gsz = (nM - fm) < WGM ? (nM - fm) : WGM;
        u.pm = fm + ((wgid % nig) % gsz); u.pn = (wgid % nig) / gsz; return true;
    }
    __device__ __forceinline__ void a_ready(const Unit&) const {}
    __device__ __forceinline__ void done(const Unit&) const {}
};

__device__ __forceinline__ unsigned cvt_pk_bf16(float lo, float hi) { unsigned r; asm volatile("v_cvt_pk_bf16_f32 %0, %1, %2" : "=v"(r) : "v"(lo), "v"(hi)); return r; }
typedef float f32x2 __attribute__((ext_vector_type(2)));
__device__ __forceinline__ float silu_f(float v) { return v * __builtin_amdgcn_rcpf(1.f + __expf(-v)); }
__device__ __forceinline__ float softplus_f(float v) { return v > 20.f ? v : log1pf(__expf(v)); }
struct EpiInProj {
    static constexpr bool PERM = true, AFTER_DRAIN = false, HAS_PRE = false;
    bf16_t* zs; bf16_t* xbc; bf16_t* yz; float* dtv; const float* dt_bias;
    __device__ __forceinline__ void operator()(const f32x4 (&acc)[2][2][4][2], const Unit& u, int wr, int wc, int fr, int fq) const {
        const int row0 = u.pm * BM + wr * 64 + fr; const int pn = u.pn;
        if (pn == 14) {
            if (wc == 0) {
                f32x4 bv[2];
#pragma unroll
                for (int n = 0; n < 2; ++n) bv[n] = *(const f32x4*)(dt_bias + 8 * fq + 4 * n);
#pragma unroll
                for (int ai = 0; ai < 2; ++ai)
#pragma unroll
                    for (int m = 0; m < 4; ++m) { float* rp = dtv + (size_t)(row0 + ai * HALF + m * 16) * 32 + 8 * fq;
#pragma unroll
                        for (int n = 0; n < 2; ++n) { const f32x4 v = acc[ai][0][m][n] + bv[n]; f32x4 o; o[0] = softplus_f(v[0]); o[1] = softplus_f(v[1]); o[2] = softplus_f(v[2]); o[3] = softplus_f(v[3]); *(f32x4*)(rp + 4 * n) = o; } }
            }
            return;
        }
        bf16_t* base; int ldc, colt; bool act = false;
        if (pn < 4) { base = zs; ldc = 1024; colt = pn * 256; act = true; } else if (pn < 12) { base = xbc; ldc = 2048; colt = (pn - 4) * 256; } else { base = yz; ldc = 512; colt = (pn - 12) * 256; }
        const int col0 = colt + wc * 32 + 8 * fq;
#pragma unroll
        for (int ai = 0; ai < 2; ++ai)
#pragma unroll
            for (int m = 0; m < 4; ++m) { bf16_t* rowp = base + (size_t)(row0 + ai * HALF + m * 16) * ldc + col0;
#pragma unroll
                for (int bj = 0; bj < 2; ++bj) { f32x4 v0 = acc[ai][bj][m][0], v1 = acc[ai][bj][m][1];
                    if (act) { v0[0] = silu_f(v0[0]); v0[1] = silu_f(v0[1]); v0[2] = silu_f(v0[2]); v0[3] = silu_f(v0[3]); v1[0] = silu_f(v1[0]); v1[1] = silu_f(v1[1]); v1[2] = silu_f(v1[2]); v1[3] = silu_f(v1[3]); }
                    u32x4 w; w.x = cvt_pk_bf16(v0[0], v0[1]); w.y = cvt_pk_bf16(v0[2], v0[3]); w.z = cvt_pk_bf16(v1[0], v1[1]); w.w = cvt_pk_bf16(v1[2], v1[3]);
                    *(u32x4*)(rowp + bj * HALF) = w; } }
    }
};
typedef int pg8_v4i __attribute__((ext_vector_type(4)));
struct EpiInProjI8 {
    static constexpr bool PERM = true, AFTER_DRAIN = false, HAS_PRE = false;
    bf16_t* zs; bf16_t* xbc; bf16_t* yz; float* dtv; const float* dt_bias; const float* sa; const float* sb;
    const PG8_LAS float* tab; mutable int k;
    __device__ __forceinline__ void operator()(const pg8_v4i (&acc)[2][2][4][2], const Unit& u, int wr, int wc, int fr, int fq) const {
        const int row0 = u.pm * BM + wr * 64 + fr; const int pn = u.pn;
        const PG8_LAS float* sap = tab + k * 512 + wr * 64 + fr; const PG8_LAS float* sbp = tab + k * 512 + 256 + wc * 32 + 8 * fq; ++k;
        float rav[2][4];
#pragma unroll
        for (int ai = 0; ai < 2; ++ai)
#pragma unroll
            for (int m = 0; m < 4; ++m) rav[ai][m] = sap[ai * HALF + m * 16];
        if (pn == 14) {
            if (wc == 0) {
                f32x4 bv[2], sv[2];
#pragma unroll
                for (int n = 0; n < 2; ++n) { bv[n] = *(const f32x4*)(dt_bias + 8 * fq + 4 * n); sv[n] = *(const PG8_LAS f32x4*)(sbp + 4 * n); }
#pragma unroll
                for (int ai = 0; ai < 2; ++ai)
#pragma unroll
                    for (int m = 0; m < 4; ++m) { const int row = row0 + ai * HALF + m * 16; const float ra = rav[ai][m]; float* rp = dtv + (size_t)row * 32 + 8 * fq;
#pragma unroll
                        for (int n = 0; n < 2; ++n) { const f32x4 v = __builtin_convertvector(acc[ai][0][m][n], f32x4) * (sv[n] * ra) + bv[n]; f32x4 o; o[0] = softplus_f(v[0]); o[1] = softplus_f(v[1]); o[2] = softplus_f(v[2]); o[3] = softplus_f(v[3]); *(f32x4*)(rp + 4 * n) = o; } }
            }
            return;
        }
        bf16_t* base; int ldc, colt;
        if (pn < 4) { base = zs; ldc = 1024; colt = pn * 256; } else if (pn < 12) { base = xbc; ldc = 2048; colt = (pn - 4) * 256; } else { base = yz; ldc = 512; colt = (pn - 12) * 256; }
        const int col0 = colt + wc * 32 + 8 * fq;
        f32x4 sv[2][2];
#pragma unroll
        for (int bj = 0; bj < 2; ++bj)
#pragma unroll
            for (int n = 0; n < 2; ++n) sv[bj][n] = *(const PG8_LAS f32x4*)(sbp + bj * HALF + 4 * n);
#pragma unroll
        for (int ai = 0; ai < 2; ++ai)
#pragma unroll
            for (int m = 0; m < 4; ++m) { const int row = row0 + ai * HALF + m * 16; const float ra = rav[ai][m]; bf16_t* rowp = base + (size_t)row * ldc + col0;
#pragma unroll
                for (int bj = 0; bj < 2; ++bj) { f32x4 v0 = __builtin_convertvector(acc[ai][bj][m][0], f32x4) * (sv[bj][0] * ra), v1 = __builtin_convertvector(acc[ai][bj][m][1], f32x4) * (sv[bj][1] * ra);
                    u32x4 w; w.x = cvt_pk_bf16(v0[0], v0[1]); w.y = cvt_pk_bf16(v0[2], v0[3]); w.z = cvt_pk_bf16(v1[0], v1[1]); w.w = cvt_pk_bf16(v1[2], v1[3]);
                    *(u32x4*)(rowp + bj * HALF) = w; } }
    }
};
#ifndef OUTPROJ_PRE
#define OUTPROJ_PRE false
#endif
struct EpiOutProj {
    static constexpr bool PERM = true, AFTER_DRAIN = false, HAS_PRE = OUTPROJ_PRE;
    const float* x; bf16_t* x1; const float* mod; const float* sb;
    const PG8_LAS float* tab; mutable int k;
    mutable f32x4 xp[2][2];
    __device__ __forceinline__ void pre(const Unit& u, int wr, int wc, int fr, int fq) const {
        const size_t off = (size_t)(u.pm * BM + wr * 64 + fr) * 1024 + u.pn * BM + wc * 32 + 8 * fq;
#pragma unroll
        for (int bj = 0; bj < 2; ++bj) { xp[bj][0] = __builtin_nontemporal_load((const f32x4*)(x + off + bj * HALF)); xp[bj][1] = __builtin_nontemporal_load((const f32x4*)(x + off + bj * HALF + 4)); }
    }
    __device__ __forceinline__ void operator()(const f32x4 (&acc)[2][2][4][2], const Unit& u, int wr, int wc, int fr, int fq) const {
        const int row0 = u.pm * BM + wr * 64 + fr, col0 = u.pn * BM + wc * 32 + 8 * fq;
        f32x4 gv[2][2];
#pragma unroll
        for (int bj = 0; bj < 2; ++bj)
#pragma unroll
            for (int n = 0; n < 2; ++n) gv[bj][n] = *(const PG8_LAS f32x4*)(tab + k * 256 + wc * 32 + 8 * fq + bj * HALF + n * 4);
        ++k;
        f32x4 xv[2][2][2];
#define EPI_XLOAD(par_, it_) do { const size_t off_ = (size_t)(row0 + ((it_) >> 2) * HALF + ((it_) & 3) * 16) * 1024 + col0; _Pragma("unroll") for (int bj = 0; bj < 2; ++bj) { \
            xv[par_][bj][0] = __builtin_nontemporal_load((const f32x4*)(x + off_ + bj * HALF)); xv[par_][bj][1] = __builtin_nontemporal_load((const f32x4*)(x + off_ + bj * HALF + 4)); } } while (0)
        if constexpr (HAS_PRE) {
#pragma unroll
            for (int bj = 0; bj < 2; ++bj) { xv[0][bj][0] = xp[bj][0]; xv[0][bj][1] = xp[bj][1]; }
        } else EPI_XLOAD(0, 0);
#pragma unroll
        for (int it = 0; it < 8; ++it) { const int ai = it >> 2, m = it & 3; const size_t off = (size_t)(row0 + ai * HALF + m * 16) * 1024 + col0;
            if (it < 7) EPI_XLOAD((it + 1) & 1, it + 1);
#pragma unroll
            for (int bj = 0; bj < 2; ++bj) { const f32x4 v0 = xv[it & 1][bj][0] + gv[bj][0] * acc[ai][bj][m][0], v1 = xv[it & 1][bj][1] + gv[bj][1] * acc[ai][bj][m][1];
                u32x4 w; w.x = cvt_pk_bf16(v0[0], v0[1]); w.y = cvt_pk_bf16(v0[2], v0[3]); w.z = cvt_pk_bf16(v1[0], v1[1]); w.w = cvt_pk_bf16(v1[2], v1[3]);
                *(u32x4*)(x1 + off + bj * HALF) = w; } }
#undef EPI_XLOAD
    }
};
__device__ __forceinline__ unsigned pk4_fp8(float a, float b, float c, float d) { int w = __builtin_amdgcn_cvt_pk_fp8_f32(a, b, 0, false); return (unsigned)__builtin_amdgcn_cvt_pk_fp8_f32(c, d, w, true); }
struct EpiUp {
    static constexpr bool PERM = true, AFTER_DRAIN = false, HAS_PRE = false;
    unsigned char* act;
    __device__ __forceinline__ void operator()(const f32x4 (&acc)[2][2][4][2], const Unit& u, int wr, int wc, int fr, int fq) const {
        const int row0 = u.pm * BM + wr * 64 + fr, col0 = (u.pn & 3) * 128 + wc * 32 + 8 * fq;
#pragma unroll
        for (int ai = 0; ai < 2; ++ai)
#pragma unroll
            for (int m = 0; m < 4; ++m) { float a[8];
#pragma unroll
                for (int n = 0; n < 2; ++n)
#pragma unroll
                    for (int i = 0; i < 4; ++i) a[n * 4 + i] = 4.f * silu_f(acc[ai][0][m][n][i]) * acc[ai][1][m][n][i];
                typedef unsigned u32x2e __attribute__((ext_vector_type(2)));
                u32x2e w; w.x = pk4_fp8(a[0], a[1], a[2], a[3]); w.y = pk4_fp8(a[4], a[5], a[6], a[7]);
                *(u32x2e*)(act + (size_t)(row0 + ai * HALF + m * 16) * 512 + col0) = w; }
    }
};
struct EpiDown {
    static constexpr bool PERM = true, AFTER_DRAIN = false, HAS_PRE = false;
    bf16_t* ybuf; const int* rowdest; const float* rowgate;
    const PG8_LAS int* tab; mutable int k;
    __device__ __forceinline__ void operator()(const f32x4 (&acc)[2][2][4][2], const Unit& u, int wr, int wc, int fr, int fq) const {
        const int row0 = u.pm * BM + wr * 64 + fr, col0 = (u.pn & 3) * 256 + wc * 32 + 8 * fq;
        int dsv[2][4]; float gtv[2][4];
#pragma unroll
        for (int ai = 0; ai < 2; ++ai)
#pragma unroll
            for (int m = 0; m < 4; ++m) { const int rl = k * 512 + wr * 64 + fr + ai * HALF + m * 16; dsv[ai][m] = tab[rl]; gtv[ai][m] = __builtin_bit_cast(float, tab[rl + 256]); }
        ++k;
#pragma unroll
        for (int ai = 0; ai < 2; ++ai)
#pragma unroll
            for (int m = 0; m < 4; ++m) { const int dest = dsv[ai][m]; const float gt = gtv[ai][m];
                if (dest >= 0) {
#pragma unroll
                    for (int bj = 0; bj < 2; ++bj) { const f32x4 v0 = acc[ai][bj][m][0] * (gt * 16.f), v1 = acc[ai][bj][m][1] * (gt * 16.f);
                        typedef unsigned u32x2d __attribute__((ext_vector_type(2)));
                        u32x2d w; w.x = pk4_fp8(v0[0], v0[1], v0[2], v0[3]); w.y = pk4_fp8(v1[0], v1[1], v1[2], v1[3]);
                        *(u32x2d*)((unsigned char*)ybuf + (size_t)dest * 1024 + col0 + bj * HALF) = w; } } }
    }
};
struct InProjOrder {
    int G, c;
    __device__ __forceinline__ bool next(int i, Unit& u) const {
        const int L = i * G + c;
        if (L < 1920) { const int wgid = (L % NXCD) * 240 + L / NXCD; const int r = wgid % 120; u.pm = (wgid / 120) * 8 + (r & 7); u.pn = r >> 3; return true; }
        const int L2 = L - 1920; if (L2 >= 72) return false;
        u.pm = 128 + L2 / 9; const int j = L2 % 9; u.pn = j < 8 ? 4 + j : 14; return true;
    }
    __device__ __forceinline__ void a_ready(const Unit&) const {}
    __device__ __forceinline__ void done(const Unit&) const {}
};
struct MoeOrder {
    const PG8_LAS int* tile_e; int ntiles, G, c;
    __device__ __forceinline__ bool next(int i, Unit& u) const {
        const int nwg = ntiles * 4, L0 = i * G + c; if (L0 >= nwg) return false;
        const int q = nwg / NXCD, r = nwg % NXCD, xcd = L0 % NXCD, off = L0 / NXCD;
        const int L = (xcd < r ? xcd * (q + 1) : r * (q + 1) + (xcd - r) * q) + off;
        const int rt = L >> 2; u.pm = rt; u.pn = tile_e[rt] * 4 + (L & 3); return true;
    }
    __device__ __forceinline__ void a_ready(const Unit&) const {}
    __device__ __forceinline__ void done(const Unit&) const {}
};
#ifndef PG8_STAMP_OFF
#define PG8_STAMP_OFF 0.5f
#endif
#ifndef PG8_STAMP
#define PG8_STAMP 0
#endif
typedef int pg8_v4i __attribute__((ext_vector_type(4)));
typedef int pg8_v8i __attribute__((ext_vector_type(8)));
template <bool I8> struct AccSel { typedef f32x4 type; };
template <> struct AccSel<true> { typedef pg8_v4i type; };
template <class Epi, class Sched, bool ALIGN_EPI = false, bool SP2 = false, bool GATHER = false, bool FP8 = false, bool I8 = false, bool MIX = false>
__device__ __forceinline__ void gemm_phase(PG8_LAS unsigned char* lds, const Gemm g, const Sched& S, const Epi& E) {
    const int tid = threadIdx.x, wid = __builtin_amdgcn_readfirstlane(tid >> 6), lane = tid & 63, wr = wid >> 2, wc = wid & 3, fr = lane & 15, fq = lane >> 4;
    const int K = g.K, nt = K / BK;
    unsigned voffA[2], voffB[2];
#pragma unroll
    for (int i = 0; i < 2; ++i) { int R, C; stage_rc(tid * 16 + i * 8192, R, C); const int Rb = Epi::PERM ? ((R & ~31) + perm32(R & 31)) : R;
        voffA[i] = (unsigned)(R * K + C) * 2u; voffB[i] = (unsigned)(Rb * K + C) * 2u; }
    int gR[2], gC[2];
#pragma unroll
    for (int i = 0; i < 2; ++i) stage_rc(tid * 16 + i * 8192, gR[i], gC[i]);
    unsigned vC0[2] = {voffA[0], voffA[1]}, vC1[2] = {voffA[0], voffA[1]}, vN0[2] = {voffA[0], voffA[1]}, vN1[2] = {voffA[0], voffA[1]};
#define PG8_GOFF(dst0, dst1, pm_) do { _Pragma("unroll") for (int _i = 0; _i < 2; ++_i) { const int r0_ = g.gat[(pm_) * BM + gR[_i]], r1_ = g.gat[(pm_) * BM + HALF + gR[_i]]; \
        dst0[_i] = (unsigned)(((r0_ < 0 ? 0 : r0_) >> 1) * K + gC[_i]) * 2u; dst1[_i] = (unsigned)(((r1_ < 0 ? 0 : r1_) >> 1) * K + gC[_i]) * 2u; } } while (0)
    const size_t kstep = (size_t)(BK * 2);
    const size_t hstep = (size_t)HALF * K * 2;
    const size_t hstepA = GATHER ? 0 : hstep;
    const size_t tstep = 2 * hstep;
    const unsigned ldsw = (unsigned)wid * 1024u;
    const int aoff = lds_byte(wr * 64 + fr, fq * 8), boff = lds_byte(wc * 32 + fr, fq * 8);
#define PG8_SA(b, h) (((b) * 2 + (h)) * HTB)
#define PG8_SB(b, h) ((4 + (b) * 2 + (h)) * HTB)
#define PG8_STAGE(bufoff, gbase, voff) do { _Pragma("unroll") for (int _i = 0; _i < 2; ++_i) \
        __builtin_amdgcn_global_load_lds((const unsigned*)((const char*)(gbase) + (voff)[_i]), (PG8_LAS unsigned*)(lds + (bufoff) + ldsw + _i * 8192), 16, 0, 0); } while (0)
#define PG8_LD16(off) (*(const PG8_LAS pg8_v4i*)(lds + (off)))
#define PG8_LDA(dst, b, h) do { _Pragma("unroll") for (int m = 0; m < 4; ++m) dst[m] = __builtin_shufflevector(PG8_LD16(PG8_SA(b, h) + aoff + m * 2048), PG8_LD16(PG8_SA(b, h) + aoff + m * 2048 + 1024), 0, 1, 2, 3, 4, 5, 6, 7); } while (0)
#define PG8_LDB(dst, b, h) do { _Pragma("unroll") for (int n = 0; n < 2; ++n) dst[n] = __builtin_shufflevector(PG8_LD16(PG8_SB(b, h) + boff + n * 2048), PG8_LD16(PG8_SB(b, h) + boff + n * 2048 + 1024), 0, 1, 2, 3, 4, 5, 6, 7); } while (0)
#define PG8_HALF(x, k) __builtin_bit_cast(bf16x8, (k) == 0 ? __builtin_shufflevector((x), (x), 0, 1, 2, 3) : __builtin_shufflevector((x), (x), 4, 5, 6, 7))
#define PG8_HALFI(x, k) ((k) == 0 ? __builtin_shufflevector((x), (x), 0, 1, 2, 3) : __builtin_shufflevector((x), (x), 4, 5, 6, 7))
#define PG8_PIN (FP8 || I8 || MIX)
#define PG8_MMAF(FL, ai, bj, At, Bt) do { if constexpr (PG8_PIN) asm volatile("" : "+v"(At[0]), "+v"(At[1]), "+v"(At[2]), "+v"(At[3]), "+v"(Bt[0]), "+v"(Bt[1])); \
        __builtin_amdgcn_s_setprio(1); _Pragma("unroll") for (int m = 0; m < 4; ++m) _Pragma("unroll") for (int n = 0; n < 2; ++n) { \
        if constexpr (FP8) acc[ai][bj][m][n] = __builtin_amdgcn_mfma_scale_f32_16x16x128_f8f6f4(Bt[n], At[m], acc[ai][bj][m][n], 0, 0, 0, g.scale_b, 0, g.scale_a); \
        else if constexpr (I8 || (FL)) { pg8_v4i c_ = __builtin_amdgcn_mfma_i32_16x16x64_i8(PG8_HALFI(Bt[n], 0), PG8_HALFI(At[m], 0), __builtin_bit_cast(pg8_v4i, acc[ai][bj][m][n]), 0, 0, 0); \
               acc[ai][bj][m][n] = __builtin_bit_cast(acc_t, __builtin_amdgcn_mfma_i32_16x16x64_i8(PG8_HALFI(Bt[n], 1), PG8_HALFI(At[m], 1), c_, 0, 0, 0)); } \
        else { acc[ai][bj][m][n] = __builtin_amdgcn_mfma_f32_16x16x32_bf16(PG8_HALF(Bt[n], 0), PG8_HALF(At[m], 0), acc[ai][bj][m][n], 0, 0, 0); \
               acc[ai][bj][m][n] = __builtin_amdgcn_mfma_f32_16x16x32_bf16(PG8_HALF(Bt[n], 1), PG8_HALF(At[m], 1), acc[ai][bj][m][n], 0, 0, 0); } } \
        __builtin_amdgcn_s_setprio(0); \
        if constexpr (PG8_PIN) asm volatile("" : "+v"(acc[ai][bj][0][0]), "+v"(acc[ai][bj][0][1]), "+v"(acc[ai][bj][1][0]), "+v"(acc[ai][bj][1][1]), "+v"(acc[ai][bj][2][0]), "+v"(acc[ai][bj][2][1]), "+v"(acc[ai][bj][3][0]), "+v"(acc[ai][bj][3][1])); } while (0)
#define PG8_WAIT_V(n) asm volatile("s_waitcnt vmcnt(" #n ")" ::: "memory")
#define PG8_WAIT_L(n) asm volatile("s_waitcnt lgkmcnt(" #n ")" ::: "memory")
#define PG8_BAR __builtin_amdgcn_s_barrier()
#define PG8_SCHED __builtin_amdgcn_sched_barrier(0)
    Unit cur, nxt; int ui = 0;
    unsigned long long st_t0 = 0, st_acc = 0, st_a = 0; const bool st_on = (PG8_STAMP) && g.stamp != nullptr && blockIdx.x == 0 && tid == 0; if (st_on) st_t0 = __builtin_amdgcn_s_memrealtime();
    if (!S.next(0, cur)) return;
    if constexpr (MIX) { Unit su; for (int i = 0; i < 8 && S.next(i, su); ++i) if (tid < BM) ((PG8_LAS float*)(lds + STAGE_BYTES))[i * BM + tid] = g.sa[su.pm * BM + tid]; }
    typedef typename AccSel<I8>::type acc_t;
    acc_t acc[2][2][4][2];
#pragma unroll
    for (int a = 0; a < 2; ++a)
#pragma unroll
        for (int b = 0; b < 2; ++b)
#pragma unroll
            for (int m = 0; m < 4; ++m)
#pragma unroll
                for (int n = 0; n < 2; ++n) acc[a][b][m][n] = (acc_t){0, 0, 0, 0};
    pg8_v8i At[4], B0[2], B1[2];
    const char* cA = (const char*)g.A + (GATHER ? (size_t)0 : (size_t)cur.pm * tstep); const char* cB = (const char*)g.Bt + (size_t)cur.pn * tstep;
    if constexpr (GATHER) PG8_GOFF(vC0, vC1, cur.pm);
    S.a_ready(cur);
    static_assert(SP2, "only the two-super-phase schedule is kept in this file");
    PG8_STAGE(PG8_SB(0, 0), cB, voffB); PG8_STAGE(PG8_SB(0, 1), cB + hstep, voffB); PG8_STAGE(PG8_SA(0, 0), cA, vC0); PG8_STAGE(PG8_SA(0, 1), cA + hstepA, vC1);
    if (wr == 1) PG8_BAR;
    PG8_WAIT_V(2); PG8_BAR;
    PG8_STAGE(PG8_SB(1, 0), cB + kstep, voffB); PG8_STAGE(PG8_SA(1, 0), cA + kstep, vC0); PG8_STAGE(PG8_SB(1, 1), cB + hstep + kstep, voffB);
    PG8_WAIT_V(6); PG8_BAR;
    for (;;) {
        const bool has_next = S.next(ui + 1, nxt);
        const char* nA = (has_next && !GATHER) ? (const char*)g.A + (size_t)nxt.pm * tstep : cA;
        if constexpr (GATHER) { if (has_next) PG8_GOFF(vN0, vN1, nxt.pm); else { vN0[0] = vC0[0]; vN0[1] = vC0[1]; vN1[0] = vC1[0]; vN1[1] = vC1[1]; } } const char* nB = has_next ? (const char*)g.Bt + (size_t)nxt.pn * tstep : cB;
#define PG8_TRIP(FL) do { \
            const bool last = (t == nt - 2); \
            const char* a1 = cA + (size_t)(t + 1) * kstep; \
            const char* a2 = last ? nA : cA + (size_t)(t + 2) * kstep; const char* b2 = last ? nB : cB + (size_t)(t + 2) * kstep; \
            const char* a3 = a2 + kstep; const char* b3 = b2 + kstep; \
            if (last && has_next) S.a_ready(nxt); \
            if constexpr (Epi::HAS_PRE) { if (last) E.pre(cur, wr, wc, fr, fq); } \
            const unsigned v20[2] = {last ? vN0[0] : vC0[0], last ? vN0[1] : vC0[1]}, v21[2] = {last ? vN1[0] : vC1[0], last ? vN1[1] : vC1[1]}; \
            PG8_LDB(B0, 0, 0); PG8_LDB(B1, 0, 1); PG8_SCHED; PG8_LDA(At, 0, 0); PG8_STAGE(PG8_SA(1, 1), a1 + hstepA, vC1); \
            PG8_WAIT_V(8); PG8_WAIT_L(0); PG8_BAR; PG8_MMAF(FL, 0, 0, At, B0); PG8_MMAF(FL, 0, 1, At, B1); PG8_BAR; PG8_SCHED; \
            PG8_LDA(At, 0, 1); PG8_STAGE(PG8_SB(0, 0), b2, voffB); PG8_STAGE(PG8_SB(0, 1), b2 + hstep, voffB); PG8_STAGE(PG8_SA(0, 0), a2, v20); \
            PG8_WAIT_V(8); PG8_WAIT_L(0); PG8_BAR; PG8_MMAF(FL, 1, 0, At, B0); PG8_MMAF(FL, 1, 1, At, B1); PG8_BAR; PG8_SCHED; \
            PG8_LDB(B0, 1, 0); PG8_LDB(B1, 1, 1); PG8_SCHED; PG8_LDA(At, 1, 0); PG8_STAGE(PG8_SA(0, 1), a2 + hstepA, v21); \
            PG8_WAIT_V(8); PG8_WAIT_L(0); PG8_BAR; PG8_MMAF(FL, 0, 0, At, B0); PG8_MMAF(FL, 0, 1, At, B1); PG8_BAR; PG8_SCHED; \
            PG8_LDA(At, 1, 1); PG8_STAGE(PG8_SB(1, 0), b3, voffB); PG8_STAGE(PG8_SB(1, 1), b3 + hstep, voffB); PG8_STAGE(PG8_SA(1, 0), a3, v20); \
            PG8_WAIT_V(8); PG8_WAIT_L(0); PG8_BAR; PG8_MMAF(FL, 1, 0, At, B0); PG8_MMAF(FL, 1, 1, At, B1); PG8_BAR; PG8_SCHED; } while (0)
        if (st_on && (PG8_STAMP) == 1) st_a = __builtin_amdgcn_s_memrealtime();
        if constexpr (MIX) {
            int t = 0;
            for (; t < g.k8; t += 2) PG8_TRIP(1);
#pragma unroll
            for (int a = 0; a < 2; ++a)
#pragma unroll
                for (int m = 0; m < 4; ++m) { const float ra = ((const PG8_LAS float*)(lds + STAGE_BYTES))[ui * BM + wr * 64 + fr + a * HALF + m * 16];
#pragma unroll
                    for (int b = 0; b < 2; ++b)
#pragma unroll
                        for (int n = 0; n < 2; ++n) acc[a][b][m][n] = __builtin_bit_cast(acc_t, __builtin_convertvector(__builtin_bit_cast(pg8_v4i, acc[a][b][m][n]), f32x4) * ra); }
            for (; t < nt; t += 2) PG8_TRIP(0);
        } else {
            for (int t = 0; t < nt; t += 2) PG8_TRIP(0);
        }
#undef PG8_TRIP
        if (st_on) { const unsigned long long tn = __builtin_amdgcn_s_memrealtime(); if ((PG8_STAMP) == 1) st_acc += tn - st_a; st_a = tn; }
        if constexpr (ALIGN_EPI) { if (wr == 0) PG8_BAR; }
        if (st_on) { const unsigned long long tn = __builtin_amdgcn_s_memrealtime(); if ((PG8_STAMP) == 2) st_acc += tn - st_a; st_a = tn; }
        if constexpr (!Epi::AFTER_DRAIN) { E(acc, cur, wr, wc, fr, fq); S.done(cur); }
        if (st_on && (PG8_STAMP) == 3) { asm volatile("" ::: "memory"); st_acc += __builtin_amdgcn_s_memrealtime() - st_a; }
        if (!has_next) break;
#pragma unroll
        for (int a = 0; a < 2; ++a)
#pragma unroll
            for (int b = 0; b < 2; ++b)
#pragma unroll
                for (int m = 0; m < 4; ++m)
#pragma unroll
                    for (int n = 0; n < 2; ++n) acc[a][b][m][n] = (acc_t){0, 0, 0, 0};
        cur = nxt; cA = nA; cB = nB; ++ui;
        if constexpr (GATHER) { vC0[0] = vN0[0]; vC0[1] = vN0[1]; vC1[0] = vN1[0]; vC1[1] = vN1[1]; }
        if constexpr (ALIGN_EPI) { if (wr == 1) PG8_BAR; }
    }
    if (st_on) { const float tot = (float)(__builtin_amdgcn_s_memrealtime() - st_t0); __hip_atomic_store(g.stamp, floorf((float)st_acc / tot * 20.f + (PG8_STAMP_OFF)) * 0.05f, __ATOMIC_RELAXED, __HIP_MEMORY_SCOPE_AGENT); }
    PG8_WAIT_V(0);
    if constexpr (!ALIGN_EPI) { if (wr == 0) PG8_BAR; }
    PG8_BAR;
    if constexpr (Epi::AFTER_DRAIN) { E.fused(acc, cur, wr, wc, fr, fq, lds, wid, lane); S.done(cur); }
#undef PG8_GOFF
#undef PG8_SA
#undef PG8_SB
#undef PG8_STAGE
#undef PG8_LDA
#undef PG8_LDB
#undef PG8_MMAF
#undef PG8_HALF
#undef PG8_HALFI
#undef PG8_PIN
#undef PG8_LD16
#undef PG8_WAIT_V
#undef PG8_WAIT_L
#undef PG8_BAR
#undef PG8_SCHED
}
}
typedef unsigned short bf16;
#define DEVI __device__ __forceinline__
#define LAS __attribute__((address_space(3)))
#define GAS __attribute__((address_space(1)))
typedef unsigned v4u __attribute__((ext_vector_type(4)));
typedef float f32x4 __attribute__((ext_vector_type(4)));
typedef short s16x4 __attribute__((ext_vector_type(4)));
typedef unsigned u32x2 __attribute__((ext_vector_type(2)));
typedef short bf16x8 __attribute__((ext_vector_type(8)));
#define RLX_AGENT __ATOMIC_RELAXED, __HIP_MEMORY_SCOPE_AGENT
#define LDS_WAIT() asm volatile("s_waitcnt lgkmcnt(0)" ::: "memory")
#define VM_WAIT() asm volatile("s_waitcnt vmcnt(0)" ::: "memory")

constexpr int NWAVES = 8;
constexpr int DM = 1024, NB = 8, SEQ = 4096, CTX = 256;
constexpr int TL = NB * SEQ, TC = NB * CTX, TA = TL + TC;
constexpr int CONVD = 2048, DPROJ = 3616, NIN = 3840, C_XBC = 1024, C_F = 3072, C_DT = 3584, FOFF = 3104, DMIX = 1536, MIXLD = 1024  , NE = 32, DE = 512;
constexpr int RPAD = 65536 + NE * 256;
constexpr float EPS = 1e-6f;
constexpr size_t MiB = 1u << 20;
constexpr size_t WS_CTL = 0, CTL_ZERO_BYTES = 64 * 1024;
constexpr size_t WS_WR = 9 * MiB + 512 * 1024  , WS_BR = 1 * MiB + 256 * 1024  , WS_SB = 14 * MiB  , WS_WIN = 2 * MiB, WS_WOUT = 11 * MiB, WS_MODP = 149 * MiB  , WS_WC = 15 * MiB, WS_ROUTE = 15 * MiB + 512 * 1024, WS_MOD = 1 * MiB, WS_SAI = 6 * MiB  , WS_SBI = 7 * MiB  , WS_SAO = 6 * MiB + 256 * 1024  , WS_SBO = 7 * MiB + 64 * 1024  ;
constexpr size_t WS_XN = 17 * MiB, WS_AP = 17 * MiB, WS_WDN = 17 * MiB, WS_ZS = 85 * MiB, WS_WUP = 277 * MiB, WS_YBUF = 213 * MiB, WS_X1 = 149 * MiB, WS_XBC = 149 * MiB, WS_YF = 149 * MiB, WS_YB = 213 * MiB, WS_H2 = 149 * MiB;
constexpr size_t WS_HPERM = 213 * MiB, WS_YZ = 285 * MiB, WS_DTV = 350 * MiB, WS_XC = 355 * MiB, WS_MIX = 355 * MiB, WS_ACT = 358 * MiB, WS_ELIST = 492 * MiB  , WS_EGATE = 500 * MiB  , WS_END = 512 * MiB;
constexpr int CW_CNT = 0, CW_BAR = 4096, CW_CMAX = 8192  , CW_CMAXO = 12288  , CW_P5F = 13312  ;
constexpr int RING_BYTES = 131072, LDSCTL_OFF = 155648, LDS_BYTES = 163840;
constexpr int LC_MISC = 0  , LC_TILE = 256  , LC_CNT = 2048  , LC_RT = 4096  , LC_PTR = 6144  , LC_TS = 6400  ;

DEVI float bf2f(bf16 v) { return __uint_as_float(((unsigned)v) << 16); }
typedef float f32x2_t __attribute__((ext_vector_type(2)));
typedef __bf16 bf16x2_t __attribute__((ext_vector_type(2)));
DEVI unsigned pk2(float lo, float hi) { const f32x2_t v = {lo, hi}; return __builtin_bit_cast(unsigned, __builtin_convertvector(v, bf16x2_t)); }
DEVI unsigned f2bf(float f) { return pk2(f, f) & 0xffffu; }
DEVI float siluf(float v) { return v / (1.f + __expf(-v)); }
DEVI float wave_sum(float v) {
#pragma unroll
    for (int o = 1; o < 64; o <<= 1) v += __shfl_xor(v, o);
    return v;
}
struct Ptrs {
    const float *x, *c, *ctx, *c_ctx, *w_mod, *b_mod, *norm1, *w_in, *conv_w, *conv_b, *dt_bias, *a_log, *d_skip, *ssd_norm, *w_four, *w_out, *norm2,
        *w_rg, *b_rg, *w_re, *b_re, *w_eg, *w_eu, *w_ed, *final_norm;
    float* out; unsigned char* ws;
};
struct Frame { LAS unsigned char* lds; int tid, lane, wave, vcu, G; };
#define XB_TMO      128
#define XB_XCNT(j)  (256  + 64 * (j))
#define XB_XSUB(j)  (1280 + 64 * (j))
#define XB_XGEN(j)  (2304 + 64 * (j))
#define XB_TOP      3328
#define XB_TOPGEN   3392
#define XCD_BAR_WORDS 3456
#define XB_SPIN_CAP (1u << 18)

__device__ __forceinline__ unsigned xb_ld(unsigned* p)              { return __hip_atomic_load(p, __ATOMIC_RELAXED, __HIP_MEMORY_SCOPE_AGENT); }
__device__ __forceinline__ unsigned xb_add(unsigned* p, unsigned v) { return __hip_atomic_fetch_add(p, v, __ATOMIC_RELAXED, __HIP_MEMORY_SCOPE_AGENT); }
__device__ __forceinline__ unsigned xb_xcc_id() { return (unsigned)__builtin_amdgcn_s_getreg((3 << 11) | 20) & 0xFu; }
#define XB_SPIN(cond, bar) do { unsigned _sp = 0; while (cond) { __builtin_amdgcn_s_sleep(1); \
    if ((++_sp & 255u) == 0u) { if (xb_ld(&(bar)[XB_TMO])) break; if (_sp > XB_SPIN_CAP) { atomicAdd(&(bar)[XB_TMO], 1u); break; } } } } while (0)

struct XcdBarrier {
    unsigned* bar; unsigned x;
    volatile LAS unsigned* st;
};

__device__ __forceinline__ XcdBarrier xcd_barrier_post(unsigned* bar, volatile LAS unsigned* st) {
    XcdBarrier b; b.bar = bar; b.x = xb_xcc_id(); b.st = st;
    if (threadIdx.x == 0) (void)xb_add(&bar[XB_XCNT(b.x)], 1u);
    return b;
}
__device__ __forceinline__ void xcd_barrier_complete(unsigned* bar, unsigned x, unsigned& nloc, unsigned& nx) {
    const unsigned G = gridDim.x * gridDim.y * gridDim.z;
    unsigned sum, cnt, mine, sp = 0u;
    for (;;) {
        sum = 0u; cnt = 0u; mine = 0u;
#pragma unroll
        for (unsigned j = 0; j < 16; ++j) { const unsigned c = xb_ld(&bar[XB_XCNT(j)]); sum += c; cnt += (c > 0u) ? 1u : 0u; mine = (j == x) ? c : mine; }
        if (sum == G) break;
        __builtin_amdgcn_s_sleep(1);
        if ((++sp & 255u) == 0u) { if (xb_ld(&bar[XB_TMO])) break; if (sp > XB_SPIN_CAP) { atomicAdd(&bar[XB_TMO], 1u); break; } }
    }
    nloc = mine > 0u ? mine : 1u; nx = cnt > 0u ? cnt : 1u;
}

__device__ __forceinline__ void xcd_barrier(const XcdBarrier& b) {
    asm volatile("s_waitcnt vmcnt(0)" ::: "memory");
    __syncthreads();
    if (threadIdx.x == 0) {
        unsigned* bar = b.bar;
        __builtin_amdgcn_s_waitcnt(0);
        unsigned nloc = b.st[0], nx = b.st[1];
        if (nloc == 0u) { xcd_barrier_complete(bar, b.x, nloc, nx); b.st[0] = nloc; b.st[1] = nx; }
        const unsigned old = xb_add(&bar[XB_XSUB(b.x)], 1u);
        const unsigned gen = old / nloc;
        if (old + 1u == (gen + 1u) * nloc) {
            __builtin_amdgcn_fence(__ATOMIC_RELEASE, "agent");
            asm volatile("s_waitcnt vmcnt(0)" ::: "memory");
            const unsigned og = xb_add(&bar[XB_TOP], 1u);
            const unsigned tg = og / nx;
            if (og + 1u == (tg + 1u) * nx) xb_add(&bar[XB_TOPGEN], 1u);
            else XB_SPIN(xb_ld(&bar[XB_TOPGEN]) == tg, bar);
            __builtin_amdgcn_fence(__ATOMIC_ACQUIRE, "agent");
            xb_add(&bar[XB_XGEN(b.x)], 1u);
            asm volatile("s_waitcnt vmcnt(0)" ::: "memory");
        } else {
            XB_SPIN(xb_ld(&bar[XB_XGEN(b.x)]) == gen, bar);
            __builtin_amdgcn_fence(__ATOMIC_ACQUIRE, "agent");
            asm volatile("s_waitcnt vmcnt(0)" ::: "memory");
        }
    }
    __syncthreads();
}
DEVI void transpose_load(const float* W, int N, int k0, int n0, int lane, float (&v)[32]) {
#pragma unroll
    for (int i = 0; i < 32; ++i) v[i] = __builtin_nontemporal_load(W + (size_t)(k0 + 2 * i + (lane >> 5)) * N + n0 + (lane & 31));
}
DEVI unsigned pk4_fp8(float a, float b, float c, float d) { int w = __builtin_amdgcn_cvt_pk_fp8_f32(a, b, 0, false); return (unsigned)__builtin_amdgcn_cvt_pk_fp8_f32(c, d, w, true); }
template <bool F8 = false>
DEVI void transpose_store(const float (&v)[32], bf16* WT, int Kt, int row_off, int k0, int n0, LAS float* scr, int lane) {
#pragma unroll
    for (int i = 0; i < 32; ++i) scr[(2 * i + (lane >> 5)) * 33 + (lane & 31)] = v[i];
    LDS_WAIT(); asm volatile("" ::: "memory");
    const int c = lane & 7;
#pragma unroll
    for (int j = 0; j < 4; ++j) { const int n = (lane >> 3) + 8 * j; const LAS float* s = scr + (8 * c) * 33 + n;
        if constexpr (F8) { u32x2 o; o.x = pk4_fp8(32.f * s[0 * 33], 32.f * s[1 * 33], 32.f * s[2 * 33], 32.f * s[3 * 33]); o.y = pk4_fp8(32.f * s[4 * 33], 32.f * s[5 * 33], 32.f * s[6 * 33], 32.f * s[7 * 33]);
            *(u32x2*)((unsigned char*)WT + (size_t)(row_off + n0 + n) * Kt + k0 + 8 * c) = o; }
        else { v4u o; o.x = pk2(s[0 * 33], s[1 * 33]); o.y = pk2(s[2 * 33], s[3 * 33]); o.z = pk2(s[4 * 33], s[5 * 33]); o.w = pk2(s[6 * 33], s[7 * 33]);
            *(v4u*)(WT + (size_t)(row_off + n0 + n) * Kt + k0 + 8 * c) = o; } }
    LDS_WAIT(); asm volatile("" ::: "memory");
}
struct TrItem { const float* W; bf16* WT; int N, Kt, row_off, k0, n0; };
template <bool F8 = false, class Desc>
DEVI void transpose_items(int it0, int stride, int n_items, const Desc& desc, LAS float* scr, int lane) {
    if (it0 >= n_items) return;
    float cur[32], nxt[32]; TrItem a = desc(it0), b = a;
    transpose_load(a.W, a.N, a.k0, a.n0, lane, cur);
    for (int it = it0; it < n_items; it += stride) {
        const bool more = it + stride < n_items;
        if (more) { b = desc(it + stride); transpose_load(b.W, b.N, b.k0, b.n0, lane, nxt); }
        transpose_store<F8>(cur, a.WT, a.Kt, a.row_off, a.k0, a.n0, scr, lane);
        if (more) { a = b;
#pragma unroll
            for (int i = 0; i < 32; ++i) cur[i] = nxt[i]; }
    }
}
DEVI int win_row(int n) { return n < 3072 ? n : (n < FOFF ? C_DT + (n - 3072) : C_F + (n - FOFF)); }
DEVI unsigned pk4_i8(float a, float b, float c, float d) {
    const unsigned ua = __float_as_uint(a + 12582912.f), ub = __float_as_uint(b + 12582912.f), uc = __float_as_uint(c + 12582912.f), ud = __float_as_uint(d + 12582912.f);
    return __builtin_amdgcn_perm(ub, ua, 0x0c0c0400u) | __builtin_amdgcn_perm(ud, uc, 0x04000c0cu); }
DEVI float wave_max(float v) {
#pragma unroll
    for (int o = 1; o < 64; o <<= 1) v = fmaxf(v, __shfl_xor(v, o));
    return v;
}
#ifndef HAD_BIT0
#define HAD_BIT0 1
#endif
#define HAD_NORM ((16.f / HAD_BIT0) * 8.f)
DEVI void had_mix(float (&v)[16], int lane) {
#pragma unroll
    for (int bit = HAD_BIT0; bit < 16; bit <<= 1)
#pragma unroll
        for (int e = 0; e < 16; ++e) if (!(e & bit)) { const float a = v[e], b = v[e | bit]; v[e] = a + b; v[e | bit] = a - b; }
    const float s8 = (lane & 8) ? -1.f : 1.f, s16 = (lane & 16) ? -1.f : 1.f, s32 = (lane & 32) ? -1.f : 1.f;
#pragma unroll
    for (int e = 0; e < 16; ++e) { const float p = __builtin_bit_cast(float, __builtin_amdgcn_mov_dpp(__builtin_bit_cast(int, v[e]), 0x128, 0xf, 0xf, true)); v[e] = fmaf(v[e], s8, p); }
#pragma unroll
    for (int e = 0; e < 16; ++e) { const auto r = __builtin_amdgcn_permlane16_swap(__float_as_uint(v[e]), __float_as_uint(v[e]), false, false); v[e] = fmaf(__uint_as_float(r[1]), s16, __uint_as_float(r[0])); }
#pragma unroll
    for (int e = 0; e < 16; ++e) { const auto r = __builtin_amdgcn_permlane32_swap(__float_as_uint(v[e]), __float_as_uint(v[e]), false, false); v[e] = fmaf(__uint_as_float(r[1]), s32, __uint_as_float(r[0])); }
}
DEVI void wout_had_items(const Ptrs& P, int it0, int stride, int lane, bool pass1) {
    unsigned* cmax = (unsigned*)(P.ws + WS_CTL) + CW_CMAXO;
    for (int u = it0; u < 1024; u += stride) { const int n = (u >> 3) * 8 + (lane & 7), kf = 8 * (u & 7) + 64 * (lane >> 3); float v[16];
#pragma unroll
        for (int e = 0; e < 16; ++e) v[e] = P.w_out[(size_t)((e & 7) + kf + 512 * (e >> 3)) * DM + n];
        had_mix(v, lane);
        if (!pass1) { float m = 0.f;
#pragma unroll
            for (int e = 0; e < 16; ++e) m = fmaxf(m, fabsf(v[e]));
            m = fmaxf(m, __shfl_xor(m, 8)); m = fmaxf(m, __shfl_xor(m, 16)); m = fmaxf(m, __shfl_xor(m, 32));
            if (lane < 8) __hip_atomic_fetch_max(cmax + n, __float_as_uint(m), RLX_AGENT); }
        else { const float cm = fmaxf(__uint_as_float(__hip_atomic_load(cmax + n, RLX_AGENT)), 1e-30f), inv = 127.f / cm;
#pragma unroll
            for (int j = 0; j < 2; ++j) { u32x2 o; o.x = pk4_i8(inv * v[j * 8 + 0], inv * v[j * 8 + 1], inv * v[j * 8 + 2], inv * v[j * 8 + 3]); o.y = pk4_i8(inv * v[j * 8 + 4], inv * v[j * 8 + 5], inv * v[j * 8 + 6], inv * v[j * 8 + 7]);
                *(u32x2*)(P.ws + WS_WOUT + (size_t)n * 2048 + kf + 512 * j) = o; }
            if ((u & 7) == 0 && (lane >> 3) == 0) ((float*)(P.ws + WS_SBO))[n] = cm * (1.f / (127.f * HAD_NORM)); } }
}
DEVI void phase0a(const Ptrs& P, const Frame& F) {
    const int gt = F.vcu * 512 + F.tid, NT = F.G * 512;
    { int* rowdest = (int*)(P.ws + WS_ROUTE + 3 * 262144); for (int i = gt; i < RPAD; i += NT) rowdest[i] = -1; }
    { LAS float* tab = (LAS float*)F.lds; LAS float* wl = tab + 256;
      __syncthreads();
      if (F.tid < 128) { const float ang = (float)F.tid * (2.0f / 128.0f); tab[F.tid] = cospif(ang); tab[128 + F.tid] = -sinpif(ang); }
      int g_loaded = -1;
      for (int u = F.vcu; u < 256; u += F.G) { const int g = u >> 6, ri = (u >> 5) & 1, c = (u & 31) * 4 + (F.tid >> 7), d = F.tid & 127;
        if (g != g_loaded) { __syncthreads(); for (int i = F.tid; i < 128 * 128 / 4; i += 512) ((LAS f32x4*)wl)[i] = ((const f32x4*)(P.w_four + (size_t)g * 128 * 128))[i]; g_loaded = g; }
        __syncthreads();
        float acc = 0.f;
#pragma unroll 8
        for (int m = 0; m < 128; ++m) acc += tab[ri * 128 + ((m * c) & 127)] * wl[m * 128 + d];
        ((bf16*)(P.ws + WS_WC))[((size_t)g * 256 + ri * 128 + d) * 128 + c] = (bf16)f2bf(acc * 0.08838834764831845f); }
      __syncthreads(); }
    { LAS float* svec = (LAS float*)F.lds; LAS float* red = svec + 9 * 128;
      float* modp = (float*)(P.ws + WS_MODP);
      for (int u = F.vcu; u < 768; u += F.G) { const int cc = u % 96, kc = u / 96;
        __syncthreads();
        for (int i = F.tid; i < 9 * 128; i += 512) { const int r = i >> 7, k = kc * 128 + (i & 127); svec[i] = siluf(r < 8 ? P.c[r * DM + k] : P.c_ctx[k]); }
        __syncthreads();
        const int col = cc * 64 + F.lane; float acc[9]; float wv[16];
#pragma unroll
        for (int i = 0; i < 16; ++i) wv[i] = __builtin_nontemporal_load(P.w_mod + (size_t)(kc * 128 + F.wave * 16 + i) * 6144 + col);
#pragma unroll
        for (int r = 0; r < 9; ++r) acc[r] = 0.f;
#pragma unroll
        for (int i = 0; i < 16; ++i)
#pragma unroll
            for (int r = 0; r < 9; ++r) acc[r] += svec[r * 128 + F.wave * 16 + i] * wv[i];
#pragma unroll
        for (int r = 0; r < 9; ++r) red[(F.wave * 9 + r) * 64 + F.lane] = acc[r];
        __syncthreads();
        for (int i = F.tid; i < 576; i += 512) { float sm = 0.f;
#pragma unroll
            for (int w = 0; w < 8; ++w) sm += red[w * 576 + i];
            modp[((size_t)kc * 9 + (i >> 6)) * 6144 + cc * 64 + (i & 63)] = sm; }
      }
      __syncthreads(); }
    { const int gw = F.vcu * NWAVES + F.wave, NGW = F.G * NWAVES;
      constexpr int I_IN = 16 * 113;
      unsigned* cmax = (unsigned*)(P.ws + WS_CTL);
      for (int it = gw; it < I_IN; it += NGW) { const int kb = it / 113, nb = it % 113, k0 = kb * 64, n0 = nb * 32; float m = 0.f;
#pragma unroll
          for (int i = 0; i < 32; ++i) m = fmaxf(m, fabsf(P.w_in[(size_t)(k0 + 2 * i + (F.lane >> 5)) * DPROJ + n0 + (F.lane & 31)]));
          m = fmaxf(m, __shfl_xor(m, 32));
          if (F.lane < 32) __hip_atomic_fetch_max(cmax + CW_CMAX + win_row(n0 + F.lane), __float_as_uint(m), RLX_AGENT); }
      wout_had_items(P, (gw + NGW / 2) % NGW, NGW, F.lane, false);
      for (int i = gt; i < (NIN - C_DT - 32) * DM / 16; i += NT) ((v4u*)(P.ws + WS_WIN + (size_t)(C_DT + 32) * DM))[i] = (v4u){0u, 0u, 0u, 0u}; }
}
DEVI float modp_sum(const Ptrs& P, int r, int idx) { const float* mp = (const float*)(P.ws + WS_MODP) + (size_t)r * 6144 + idx; constexpr int S = 9 * 6144;
    return P.b_mod[idx] + (((mp[0] + mp[S]) + (mp[2 * S] + mp[3 * S])) + ((mp[4 * S] + mp[5 * S]) + (mp[6 * S] + mp[7 * S]))); }
template <int R>
DEVI void xn_rows(const float* const (&src)[R], const int (&row)[R], unsigned char* xn8, float* sa, const float* norm1, const LAS float* mrow, int lane) {
    f32x4 v[R][4];
#pragma unroll
    for (int r = 0; r < R; ++r)
#pragma unroll
        for (int j = 0; j < 4; ++j) v[r][j] = __builtin_nontemporal_load((const f32x4*)src[r] + lane + 64 * j);
    f32x4 nwv[4];
#pragma unroll
    for (int j = 0; j < 4; ++j) nwv[j] = *(const f32x4*)(norm1 + (lane + 64 * j) * 4);
#pragma unroll
    for (int r = 0; r < R; ++r) { float s = 0.f;
#pragma unroll
        for (int j = 0; j < 4; ++j) s += (v[r][j][0] * v[r][j][0] + v[r][j][1] * v[r][j][1]) + (v[r][j][2] * v[r][j][2] + v[r][j][3] * v[r][j][3]);
        const float rstd = rsqrtf(wave_sum(s) * (1.f / DM) + EPS); float mx = 0.f;
#pragma unroll
        for (int j = 0; j < 4; ++j) { const int c0 = (lane + 64 * j) * 4; const f32x4 nw = nwv[j];
#pragma unroll
            for (int i = 0; i < 4; ++i) { v[r][j][i] = v[r][j][i] * rstd * nw[i] * (1.f + mrow[1024 + c0 + i]) + mrow[c0 + i]; mx = fmaxf(mx, fabsf(v[r][j][i])); } }
        mx = wave_max(mx); const float inv = mx > 0.f ? 127.f / mx : 0.f;
        if (lane == 0) sa[row[r]] = mx * (1.f / 127.f);
#pragma unroll
        for (int j = 0; j < 4; ++j) *(unsigned*)(xn8 + (size_t)row[r] * DM + (lane + 64 * j) * 4) = pk4_i8(v[r][j][0] * inv, v[r][j][1] * inv, v[r][j][2] * inv, v[r][j][3] * inv); }
}
DEVI void quant_items(const Ptrs& P, int it0, int stride, LAS float* scr, int lane) {
    constexpr int I_IN = 16 * 113, I_OUTF = 8 * 32;
    const unsigned* cmw = (const unsigned*)(P.ws + WS_CTL);
    for (int it = it0; it < I_IN + I_OUTF; it += stride) {
        const int kind = it < I_IN ? 0 : 2; const int r = kind == 0 ? it : it - I_IN, NBk = kind == 0 ? 113 : 32;
        const int kb = r / NBk, nb = r % NBk, k0 = kb * 64 + (kind == 2 ? 1024 : 0), n0 = nb * 32; float v[32];
        transpose_load(kind == 0 ? P.w_in : P.w_out, kind == 0 ? DPROJ : DM, k0, n0, lane, v);
#pragma unroll
        for (int i = 0; i < 32; ++i) scr[(2 * i + (lane >> 5)) * 33 + (lane & 31)] = v[i];
        LDS_WAIT(); asm volatile("" ::: "memory");
        const int c = lane & 7;
#pragma unroll
        for (int j = 0; j < 4; ++j) { const int n = (lane >> 3) + 8 * j, row = kind == 0 ? win_row(n0 + n) : n0 + n; const LAS float* s = scr + (8 * c) * 33 + n;
            const float cm = fmaxf(__uint_as_float(__hip_atomic_load(cmw + (kind == 0 ? CW_CMAX : CW_CMAXO) + row, RLX_AGENT)), 1e-30f), inv = (kind == 0 ? 127.f : 127.f * HAD_NORM) / cm;
            if (kind == 2) { v4u o; o.x = pk2(inv * s[0 * 33], inv * s[1 * 33]); o.y = pk2(inv * s[2 * 33], inv * s[3 * 33]); o.z = pk2(inv * s[4 * 33], inv * s[5 * 33]); o.w = pk2(inv * s[6 * 33], inv * s[7 * 33]);
                *(v4u*)(P.ws + WS_WOUT + (size_t)row * 2048 + 1024 + (size_t)(k0 - 1024 + 8 * c) * 2) = o; }
            else { u32x2 o; o.x = pk4_i8(inv * s[0 * 33], inv * s[1 * 33], inv * s[2 * 33], inv * s[3 * 33]); o.y = pk4_i8(inv * s[4 * 33], inv * s[5 * 33], inv * s[6 * 33], inv * s[7 * 33]);
                *(u32x2*)(P.ws + WS_WIN + (size_t)row * DM + k0 + 8 * c) = o;
                if (kb == 0 && c == 0) ((float*)(P.ws + WS_SBI))[row] = cm * (1.f / 127.f); } }
        LDS_WAIT(); asm volatile("" ::: "memory"); }
}
DEVI void phase0b(const Ptrs& P, const Frame& F) {
    const int gt = F.vcu * 512 + F.tid, NT = F.G * 512;
    quant_items(P, F.vcu * NWAVES + F.wave, F.G * NWAVES, (LAS float*)(F.lds + 16384 + F.wave * 16384), F.lane);
    wout_had_items(P, (F.vcu * NWAVES + F.wave + F.G * NWAVES / 2) % (F.G * NWAVES), F.G * NWAVES, F.lane, true);
    { float* mod = (float*)(P.ws + WS_MOD); for (int i = gt; i < 9 * 6144; i += NT) mod[i] = modp_sum(P, i / 6144, i % 6144); }
    { bf16* WRh = (bf16*)(P.ws + WS_WR); bf16* WRl = WRh + 8 * 48 * 1024;
      for (int o = gt; o < 8 * 48 * 1024; o += NT) { const int k = o & 1023, n = (o >> 10) % 48, b = o / (48 * 1024); float wv = 0.f;
          if (n < 36) { const float wc = n < 4 ? P.w_rg[k * 4 + n] : P.w_re[((size_t)((n - 4) >> 3) * DM + k) * 8 + ((n - 4) & 7)]; wv = P.norm2[k] * (1.f + modp_sum(P, b, 4096 + k)) * wc; }
          const unsigned hi = f2bf(wv); const float rem = wv - __uint_as_float(hi << 16); WRh[o] = (bf16)hi; WRl[o] = (bf16)f2bf(rem); }
      { float* sb = (float*)(P.ws + WS_SB); for (int o = gt; o < 8 * 1024; o += NT) { const int k = o & 1023, b = o >> 10; sb[(b * 2) * 1024 + k] = P.norm2[k] * (1.f + modp_sum(P, b, 4096 + k)); sb[(b * 2 + 1) * 1024 + k] = modp_sum(P, b, 3072 + k); } }
      const int gwv = F.vcu * NWAVES + F.wave;
      for (int o = gwv; o < 8 * 48; o += F.G * NWAVES) { const int n = o % 48, b = o / 48; float a = 0.f;
          if (n < 36) { for (int k = F.lane; k < DM; k += 64) { const float wc = n < 4 ? P.w_rg[k * 4 + n] : P.w_re[((size_t)((n - 4) >> 3) * DM + k) * 8 + ((n - 4) & 7)]; a += modp_sum(P, b, 3072 + k) * wc; }
              a = wave_sum(a) + (n < 4 ? P.b_rg[n] : P.b_re[n - 4]); }
          if (F.lane == 0) ((float*)(P.ws + WS_BR))[o] = a; } }
    LAS float* mrow = (LAS float*)F.lds;
    for (int rb = F.vcu; rb < 256; rb += F.G) {
        __syncthreads();
        for (int i = F.tid; i < 2048; i += 512) mrow[i] = modp_sum(P, rb >> 5, i);
        __syncthreads();
        for (int r = F.wave * 4; r < 128; r += NWAVES * 4) { const float* src[4]; int row[4];
#pragma unroll
            for (int k = 0; k < 4; ++k) { row[k] = rb * 128 + r + k; src[k] = P.x + (size_t)row[k] * DM; }
            xn_rows<4>(src, row, P.ws + WS_XN, (float*)(P.ws + WS_SAI), P.norm1, mrow, F.lane); }
        __syncthreads();
        for (int i = F.tid; i < 2048; i += 512) mrow[i] = modp_sum(P, 8, i);
        __syncthreads();
        { const int rowc = rb * 8 + F.wave; const float* src[1] = {P.ctx + (size_t)rowc * DM}; const int row[1] = {TL + rowc}; xn_rows<1>(src, row, P.ws + WS_XN, (float*)(P.ws + WS_SAI), P.norm1, mrow, F.lane); }
    }
}
DEVI void phase_conv(const Ptrs& P, const Frame& F) {
    const bf16* xbc = (const bf16*)(P.ws + WS_XBC); bf16* xc = (bf16*)(P.ws + WS_XC);
    for (int u = F.vcu; u < (TA / 16) * 2; u += F.G) {
        const int tb = u >> 1, ch = (u & 1) * 1024 + 2 * F.tid; const int row0 = tb * 16;
        const int len = row0 < TL ? SEQ : CTX; const int t0 = row0 < TL ? (row0 & (SEQ - 1)) : ((row0 - TL) & (CTX - 1));
        float cw[5][2], cb[2];
        { const float2 bb = *(const float2*)(P.conv_b + ch); cb[0] = bb.x; cb[1] = bb.y;
#pragma unroll
          for (int t = 0; t < 5; ++t) { const float2 ww = *(const float2*)(P.conv_w + t * CONVD + ch); cw[t][0] = ww.x; cw[t][1] = ww.y; } }
        unsigned raw[20];
        const bf16* src = xbc + (size_t)(row0 - 2) * 2048 + ch;
#pragma unroll
        for (int i = 0; i < 20; ++i) raw[i] = __builtin_nontemporal_load((const unsigned*)(src + (size_t)i * 2048));
#pragma unroll
        for (int i = 0; i < 2; ++i) { asm volatile("" : "+v"(raw[i]), "+v"(raw[18 + i]));
            if (t0 - 2 + i < 0) raw[i] = 0u; if (t0 + 16 + i >= len) raw[18 + i] = 0u; }
        bf16* dst = xc + (size_t)row0 * 2048 + ch;
#pragma unroll
        for (int o = 0; o < 16; ++o) { float a0 = cb[0], a1 = cb[1];
#pragma unroll
            for (int t = 0; t < 5; ++t) { a0 += __uint_as_float(raw[o + t] << 16) * cw[t][0]; a1 += __uint_as_float(raw[o + t] & 0xffff0000u) * cw[t][1]; }
            a0 = a0 * __builtin_amdgcn_rcpf(1.f + __expf(-a0)); a1 = a1 * __builtin_amdgcn_rcpf(1.f + __expf(-a1));
            *(unsigned*)(dst + (size_t)o * 2048) = pk2(a0, a1); }
    }
}
template <bool LIGHT = false>
DEVI void phase_combine(const Ptrs& P, const Frame& F) {
    const int gw = F.vcu * NWAVES + F.wave, NGW = F.G * NWAVES, lane = F.lane;
    constexpr int R = 4;
    v4u ya[R][2], yb[R][2], zz[R][2];
#define COMBINE_LOAD(row0_) do { _Pragma("unroll") for (int r = 0; r < R; ++r) { const size_t ro = (size_t)((row0_) + r) * 1024; \
        _Pragma("unroll") for (int j = 0; j < 2; ++j) { const int c0 = (lane + 64 * j) * 8; ya[r][j] = __builtin_nontemporal_load((const v4u*)((const bf16*)(P.ws + WS_YF) + ro + c0)); \
            yb[r][j] = __builtin_nontemporal_load((const v4u*)((const bf16*)(P.ws + WS_YB) + ro + c0)); zz[r][j] = __builtin_nontemporal_load((const v4u*)((const bf16*)(P.ws + WS_ZS) + ro + c0)); } } } while (0)
    f32x4 nrm[2][2];
#pragma unroll
    for (int j = 0; j < 2; ++j) { const int c0 = (lane + 64 * j) * 8; nrm[j][0] = *(const f32x4*)(P.ssd_norm + c0); nrm[j][1] = *(const f32x4*)(P.ssd_norm + c0 + 4); }
    COMBINE_LOAD(gw * R);
    for (int row0 = gw * R; row0 < TL; row0 += R * NGW) {
        float vv[R][16], ss[R];
#pragma unroll
        for (int r = 0; r < R; ++r) { float s = 0.f;
#pragma unroll
            for (int j = 0; j < 2; ++j)
#pragma unroll
                for (int i = 0; i < 4; ++i) { const float z0 = __uint_as_float(zz[r][j][i] << 16), z1 = __uint_as_float(zz[r][j][i] & 0xffff0000u);
                    const float y0 = (__uint_as_float(ya[r][j][i] << 16) + __uint_as_float(yb[r][j][i] << 16)) * (LIGHT ? z0 : z0 * __builtin_amdgcn_rcpf(1.f + __expf(-z0)));
                    const float y1 = (__uint_as_float(ya[r][j][i] & 0xffff0000u) + __uint_as_float(yb[r][j][i] & 0xffff0000u)) * (LIGHT ? z1 : z1 * __builtin_amdgcn_rcpf(1.f + __expf(-z1)));
                    vv[r][j * 8 + 2 * i] = y0; vv[r][j * 8 + 2 * i + 1] = y1; s += y0 * y0 + y1 * y1; }
            ss[r] = s; }
        COMBINE_LOAD(row0 + R * NGW);
#pragma unroll
        for (int r = 0; r < R; ++r) { float (&v)[16] = vv[r];
            const float rstd = rsqrtf(wave_sum(ss[r]) * (1.f / 1024.f) + EPS); float mx = 0.f;
#pragma unroll
            for (int j = 0; j < 2; ++j) {
#pragma unroll
                for (int i = 0; i < 4; ++i) { v[j * 8 + i] *= rstd * nrm[j][0][i]; v[j * 8 + 4 + i] *= rstd * nrm[j][1][i]; } }
            if constexpr (!LIGHT) had_mix(v, lane);
#pragma unroll
            for (int e = 0; e < 16; ++e) mx = fmaxf(mx, fabsf(v[e]));
            mx = wave_max(mx); const float inv = mx > 0.f ? 127.f / mx : 0.f; const int row = row0 + r;
            if (lane == 0) ((float*)(P.ws + WS_SAO))[row] = mx * (1.f / 127.f);
#pragma unroll
            for (int j = 0; j < 2; ++j) { u32x2 o; o.x = pk4_i8(v[j * 8 + 0] * inv, v[j * 8 + 1] * inv, v[j * 8 + 2] * inv, v[j * 8 + 3] * inv); o.y = pk4_i8(v[j * 8 + 4] * inv, v[j * 8 + 5] * inv, v[j * 8 + 6] * inv, v[j * 8 + 7] * inv);
                *(u32x2*)(P.ws + WS_MIX + (size_t)row * 2048 + (lane + 64 * j) * 8) = o; } }
    }
#undef COMBINE_LOAD
}
DEVI void phase_expert_weights(const Ptrs& P, const Frame& F, int it_lo, int it_hi, int widx, int nw) {
    LAS float* scr = (LAS float*)(F.lds + F.wave * 16384);
    bf16* Wdn = (bf16*)(P.ws + WS_WDN);
    const float* w_ed = P.w_ed;
    auto desc = [&](int it) { TrItem t; const int e = it >> 8, r = it & 255, kb = r >> 5, nb = r & 31;
        t.W = w_ed + (size_t)e * DE * DM; t.WT = Wdn; t.N = DM; t.Kt = DE; t.row_off = e * 1024; t.k0 = kb * 64; t.n0 = nb * 32; return t; };
    transpose_items<true>(it_lo + widx, nw, it_hi, desc, scr, F.lane);
}
DEVI void phase_route(const Ptrs& P, const Frame& F, bool dry) {
    const int lane = F.lane, w = F.wave, c16 = lane & 15, q = lane >> 4;
    LAS unsigned* lcnt = (LAS unsigned*)(F.lds + LDSCTL_OFF + LC_CNT);
    LAS unsigned char* LW = F.lds;
    int* eid = (int*)(P.ws + WS_ROUTE); int* pos = eid + 65536; float* gate = (float*)(pos + 65536);
    const bf16* WRh = (const bf16*)(P.ws + WS_WR);
    for (int rb = F.vcu; rb < TL / 128; rb += F.G) {
        const int b = rb >> 5, row = rb * 128 + 16 * w + c16;
        __syncthreads();
        if (F.tid < 64) lcnt[F.tid] = 0u;
        f32x4 acc[3] = {(f32x4){0.f, 0.f, 0.f, 0.f}, (f32x4){0.f, 0.f, 0.f, 0.f}, (f32x4){0.f, 0.f, 0.f, 0.f}}; float ssq = 0.f;
#pragma unroll 1
        for (int hh = 0; hh < 2; ++hh) {
            bf16x8 af[16];
#pragma unroll
            for (int ks = 0; ks < 16; ++ks) af[ks] = *(const bf16x8*)((const bf16*)(P.ws + WS_X1) + (size_t)row * DM + 512 * hh + 32 * ks + 8 * q);
            __syncthreads();
            for (int cid = F.tid; cid < 2 * 48 * 64; cid += 512) { const int pl = cid / (48 * 64), r = (cid >> 6) % 48, ch = cid & 63;
                *(LAS v4u*)(LW + (pl * 48 + r) * 1024 + ((ch ^ (r & 15)) << 4)) = *(const v4u*)(WRh + (size_t)pl * 8 * 48 * 1024 + ((size_t)b * 48 + r) * 1024 + 512 * hh + ch * 8); }
            __syncthreads();
#pragma unroll
            for (int ks = 0; ks < 16; ++ks) {
#pragma unroll
                for (int i = 0; i < 8; ++i) { const float xv = __uint_as_float(((unsigned)(unsigned short)af[ks][i]) << 16); ssq += xv * xv; }
#pragma unroll
                for (int ct = 0; ct < 3; ++ct) { const int r = 16 * ct + c16; const int off = ((4 * ks + q) ^ c16) << 4;
                    const bf16x8 bh = *(const LAS bf16x8*)(LW + r * 1024 + off), bl = *(const LAS bf16x8*)(LW + (48 + r) * 1024 + off);
                    acc[ct] = __builtin_amdgcn_mfma_f32_16x16x32_bf16(af[ks], bh, acc[ct], 0, 0, 0); acc[ct] = __builtin_amdgcn_mfma_f32_16x16x32_bf16(af[ks], bl, acc[ct], 0, 0, 0); } }
        }
        ssq += __shfl_xor(ssq, 16); ssq += __shfl_xor(ssq, 32);
        const float rstd = rsqrtf(ssq * (1.f / DM) + EPS);
        { LAS float* sct = (LAS float*)(F.lds + 98304);
          for (int i = F.tid; i < 2048; i += 512) sct[i] = ((const float*)(P.ws + WS_SB))[(size_t)b * 2048 + i];
          __syncthreads();
          const bf16* xr = (const bf16*)(P.ws + WS_X1) + (size_t)row * DM; unsigned char* hr = (unsigned char*)(P.ws + WS_HPERM) + (size_t)row * DM;
#pragma unroll 1
          for (int hh = 0; hh < 2; ++hh) { v4u xq[16];
#pragma unroll
              for (int ks = 0; ks < 16; ++ks) xq[ks] = *(const v4u*)(xr + 512 * hh + 32 * ks + 8 * q);
#pragma unroll
              for (int ks = 0; ks < 16; ++ks) { const int k0 = 512 * hh + 32 * ks + 8 * q; const v4u xv = xq[ks];
                  const f32x4 s0 = *(const LAS f32x4*)(sct + k0), s1 = *(const LAS f32x4*)(sct + k0 + 4), h0 = *(const LAS f32x4*)(sct + 1024 + k0), h1 = *(const LAS f32x4*)(sct + 1024 + k0 + 4);
                  const float sc[8] = {s0[0], s0[1], s0[2], s0[3], s1[0], s1[1], s1[2], s1[3]}, sh[8] = {h0[0], h0[1], h0[2], h0[3], h1[0], h1[1], h1[2], h1[3]}; float hv[8];
#pragma unroll
                  for (int i = 0; i < 4; ++i) { hv[2 * i] = __uint_as_float(xv[i] << 16) * rstd * sc[2 * i] + sh[2 * i]; hv[2 * i + 1] = __uint_as_float(xv[i] & 0xffff0000u) * rstd * sc[2 * i + 1] + sh[2 * i + 1]; }
                  u32x2 o; o.x = pk4_fp8(hv[0], hv[1], hv[2], hv[3]); o.y = pk4_fp8(hv[4], hv[5], hv[6], hv[7]);
                  if (!dry) *(u32x2*)(hr + k0) = o; else asm volatile("" :: "v"(o[0]), "v"(o[1])); } } }
        __syncthreads();
        LAS float* lgt = (LAS float*)F.lds;
        { const float* br = (const float*)(P.ws + WS_BR) + b * 48;
#pragma unroll
          for (int r = 0; r < 4; ++r) { const float rs = __shfl(rstd, 4 * q + r);
#pragma unroll
            for (int ct = 0; ct < 3; ++ct) lgt[(16 * w + 4 * q + r) * 48 + 16 * ct + c16] = acc[ct][r] * rs + br[16 * ct + c16]; } }
        LDS_WAIT(); asm volatile("" ::: "memory");
        LAS int* rt = (LAS int*)(F.lds + LDSCTL_OFF + LC_RT) + (w * 16 + c16) * 4;
        if (lane < 16) { const LAS float* lr = lgt + (16 * w + lane) * 48; const int trow = rb * 128 + 16 * w + lane;
            int grp = 0; float mx = lr[0];
#pragma unroll
            for (int g = 1; g < 4; ++g) if (lr[g] > mx) { mx = lr[g]; grp = g; }
            float den = 0.f;
#pragma unroll
            for (int g = 0; g < 4; ++g) den += __expf(lr[g] - mx);
            const float pgrp = 1.f / den;
            float le[8];
#pragma unroll
            for (int e = 0; e < 8; ++e) le[e] = lr[4 + grp * 8 + e];
            int j0 = 0; float m0 = le[0];
#pragma unroll
            for (int e = 1; e < 8; ++e) if (le[e] > m0) { m0 = le[e]; j0 = e; }
            int j1 = 0; float m1 = -3.0e38f;
#pragma unroll
            for (int e = 0; e < 8; ++e) if (e != j0 && le[e] > m1) { m1 = le[e]; j1 = e; }
            const float e1 = __expf(m1 - m0);
            if (!dry) { const int ea = grp * 8 + j0, eb = grp * 8 + j1;
                LAS float* lw_ = lgt + (16 * w + lane) * 48; lw_[0] = pgrp / (1.f + e1); lw_[1] = pgrp * e1 / (1.f + e1);
                rt[0] = ea; rt[1] = eb; rt[2] = (int)__hip_atomic_fetch_add(&lcnt[ea], 1u, __ATOMIC_RELAXED, __HIP_MEMORY_SCOPE_WORKGROUP); rt[3] = (int)__hip_atomic_fetch_add(&lcnt[eb], 1u, __ATOMIC_RELAXED, __HIP_MEMORY_SCOPE_WORKGROUP); }
            else asm volatile("" :: "v"(e1), "v"(j0), "v"(j1), "v"(pgrp)); }
        __syncthreads();
        if (!dry) {
            if (F.tid < 32) lcnt[32 + F.tid] = __hip_atomic_fetch_add((unsigned*)(P.ws + WS_CTL) + CW_CNT + F.tid, lcnt[F.tid], RLX_AGENT);
            __syncthreads();
            if (lane < 16) { const int trow = rb * 128 + 16 * w + lane; const LAS float* lw_ = lgt + (16 * w + lane) * 48;
                int* elist = (int*)(P.ws + WS_ELIST); float* egate = (float*)(P.ws + WS_EGATE);
                const int pa = rt[0] * 65536 + rt[2] + (int)lcnt[32 + rt[0]], pb = rt[1] * 65536 + rt[3] + (int)lcnt[32 + rt[1]];
                elist[pa] = trow * 2; egate[pa] = lw_[0]; elist[pb] = trow * 2 + 1; egate[pb] = lw_[1]; } }
    }
    __syncthreads();
}
DEVI int build_tile_table(const Ptrs& P, const Frame& F) {
    LAS int* tile_e = (LAS int*)(F.lds + LDSCTL_OFF + LC_TILE); LAS unsigned* lcnt = (LAS unsigned*)(F.lds + LDSCTL_OFF + LC_CNT);
    __syncthreads();
    if (F.tid < 32) lcnt[F.tid] = __hip_atomic_load((unsigned*)(P.ws + WS_CTL) + CW_CNT + F.tid, RLX_AGENT);
    __syncthreads();
    if (F.tid == 0) { int s = 0; for (int e = 0; e < NE; ++e) { const int nt = (int)((lcnt[e] + 255u) >> 8); lcnt[64 + e] = (unsigned)(s * 256); for (int i = 0; i < nt; ++i) tile_e[s + i] = e; s += nt; } lcnt[96] = (unsigned)s; }
    __syncthreads();
    return (int)lcnt[96];
}
DEVI void tile_rows(const Ptrs& P, const Frame& F, int rt) {
    const LAS int* tile_e = (const LAS int*)(F.lds + LDSCTL_OFF + LC_TILE); const LAS unsigned* lcnt = (const LAS unsigned*)(F.lds + LDSCTL_OFF + LC_CNT);
    if (F.tid < 256) { const int e = tile_e[rt], p = rt * 256 - (int)lcnt[64 + e] + F.tid; const bool ok = p < (int)lcnt[e];
        int* rowdest = (int*)(P.ws + WS_ROUTE + 3 * 262144); float* rowgate = (float*)(rowdest + RPAD);
        rowdest[rt * 256 + F.tid] = ok ? ((const int*)(P.ws + WS_ELIST))[e * 65536 + p] : -1; rowgate[rt * 256 + F.tid] = ok ? ((const float*)(P.ws + WS_EGATE))[e * 65536 + p] : 0.f; }
}
DEVI void phase_gather(const Ptrs& P, const Frame& F) {
    build_tile_table(P, F);
    const LAS unsigned* lcnt = (const LAS unsigned*)(F.lds + LDSCTL_OFF + LC_CNT);
    const int gw = F.vcu * NWAVES + F.wave, NGW = F.G * NWAVES, lane = F.lane;
    constexpr int R = 4;
    const int* eid = (const int*)(P.ws + WS_ROUTE); const int* pos = eid + 65536; const float* gate = (const float*)(pos + 65536);
    int* rowdest = (int*)(P.ws + WS_ROUTE + 3 * 262144); float* rowgate = (float*)(rowdest + RPAD);
    for (int a = F.vcu * 512 + F.tid; a < 65536; a += F.G * 512) { const int r = (int)lcnt[64 + eid[a]] + pos[a]; rowdest[r] = a; rowgate[r] = gate[a]; }
}
DEVI void phase_final(const Ptrs& P, const Frame& F, float* outp, float oscale) {
    const int gw = F.vcu * NWAVES + F.wave, NGW = F.G * NWAVES, lane = F.lane;
    constexpr int R = 4;
    f32x4 fnv[2][2];
#pragma unroll
    for (int j = 0; j < 2; ++j)
#pragma unroll
        for (int hh = 0; hh < 2; ++hh) fnv[j][hh] = *(const f32x4*)(P.final_norm + (lane + 64 * j) * 8 + 4 * hh);
    for (int rb = gw; rb < TL / R; rb += NGW) { const int row0 = rb * R;
        v4u xa[R][2]; u32x2 ya[R][2], yb[R][2]; f32x4 gq[2][2];
        const float* g2 = (const float*)(P.ws + WS_MOD) + (row0 / SEQ) * 6144 + 5120;
#pragma unroll
        for (int r = 0; r < R; ++r) { const size_t row = (size_t)(row0 + r);
#pragma unroll
            for (int j = 0; j < 2; ++j) { const int c0 = (lane + 64 * j) * 8; xa[r][j] = __builtin_nontemporal_load((const v4u*)((const bf16*)(P.ws + WS_X1) + row * DM + c0));
                ya[r][j] = __builtin_nontemporal_load((const u32x2*)(P.ws + WS_YBUF + row * 2 * DM + c0)); yb[r][j] = __builtin_nontemporal_load((const u32x2*)(P.ws + WS_YBUF + row * 2 * DM + DM + c0)); } }
#pragma unroll
        for (int j = 0; j < 2; ++j) { const int c0 = (lane + 64 * j) * 8; gq[j][0] = *(const f32x4*)(g2 + c0) * (1.f / 16.f); gq[j][1] = *(const f32x4*)(g2 + c0 + 4) * (1.f / 16.f); }
#pragma unroll
        for (int r = 0; r < R; ++r) { const int row = row0 + r;
            float v[16]; float s = 0.f;
#pragma unroll
            for (int j = 0; j < 2; ++j) { const f32x4 ga = gq[j][0], gb = gq[j][1];
                const float gg[8] = {ga[0], ga[1], ga[2], ga[3], gb[0], gb[1], gb[2], gb[3]};
                float ys[8];
#pragma unroll
                for (int d = 0; d < 2; ++d) { const auto a0 = __builtin_amdgcn_cvt_pk_f32_fp8((int)ya[r][j][d], false), a1 = __builtin_amdgcn_cvt_pk_f32_fp8((int)ya[r][j][d], true);
                    const auto b0 = __builtin_amdgcn_cvt_pk_f32_fp8((int)yb[r][j][d], false), b1 = __builtin_amdgcn_cvt_pk_f32_fp8((int)yb[r][j][d], true);
                    ys[4 * d] = a0[0] + b0[0]; ys[4 * d + 1] = a0[1] + b0[1]; ys[4 * d + 2] = a1[0] + b1[0]; ys[4 * d + 3] = a1[1] + b1[1]; }
#pragma unroll
                for (int i = 0; i < 4; ++i) {
                    const float o0 = __uint_as_float(xa[r][j][i] << 16) + gg[2 * i] * ys[2 * i];
                    const float o1 = __uint_as_float(xa[r][j][i] & 0xffff0000u) + gg[2 * i + 1] * ys[2 * i + 1];
                    v[j * 8 + 2 * i] = o0; v[j * 8 + 2 * i + 1] = o1; s += o0 * o0 + o1 * o1; } }
            const float rstd = rsqrtf(wave_sum(s) * (1.f / DM) + EPS) * oscale;
#pragma unroll
            for (int j = 0; j < 2; ++j) { const int c0 = (lane + 64 * j) * 8;
#pragma unroll
                for (int hh = 0; hh < 2; ++hh) { const f32x4 fn = fnv[j][hh]; f32x4 o;
#pragma unroll
                    for (int i = 0; i < 4; ++i) o[i] = v[j * 8 + hh * 4 + i] * rstd * fn[i];
                    *(f32x4*)(outp + (size_t)row * DM + c0 + 4 * hh) = o; } } }
    }
}
typedef short s16x4_t __attribute__((ext_vector_type(4)));
constexpr int S_BS = 0, S_BT = 32768, S_CS = 65536, S_XT = 98304, S_HB = 114688, S_YS = 131072, S_YS_W = 2304, S_SM = S_YS + 8 * S_YS_W;
static_assert(S_SM + 1536 <= LDSCTL_OFF, "ssd LDS map");
DEVI int ssd_sw(int row, int colbyte) { return row * 256 + (colbyte ^ ((row & 15) << 4)); }
DEVI bf16x8 ssd_frag(const LAS unsigned char* tile, int row, int ks, int q) { return *(const LAS bf16x8*)(tile + ssd_sw(row, 64 * ks + 16 * q)); }
DEVI float fast_exp(float x) { return __expf(x); }
DEVI void ssd_weight_load(const Ptrs& P, int item, int lane, float (&v)[8]) {
    const int kb = item & 63, nb = (item >> 6) & 15, half = (item >> 10) & 1, e = item >> 11;
    const float* W = (half ? P.w_eu : P.w_eg) + (size_t)e * DM * DE + (size_t)(kb * 16 + (lane >> 5)) * DE + nb * 32 + (lane & 31);
#pragma unroll
    for (int i = 0; i < 8; ++i) v[i] = __builtin_nontemporal_load(W + (size_t)(2 * i) * DE);
}
DEVI void ssd_weight_store(const Ptrs& P, int item, int lane, const float (&v)[8], LAS float* scr) {
    const int kb = item & 63, nb = (item >> 6) & 15, half = (item >> 10) & 1, e = item >> 11, n0 = nb * 32;
    asm volatile("" ::: "memory");
#pragma unroll
    for (int i = 0; i < 8; ++i) scr[(2 * i + (lane >> 5)) * 33 + (lane & 31)] = v[i];
    LDS_WAIT(); asm volatile("" ::: "memory");
    const int n = lane >> 1, hf = lane & 1; const LAS float* sp = scr + (8 * hf) * 33 + n;
    u32x2 o; o.x = pk4_fp8(32.f * sp[0], 32.f * sp[33], 32.f * sp[2 * 33], 32.f * sp[3 * 33]); o.y = pk4_fp8(32.f * sp[4 * 33], 32.f * sp[5 * 33], 32.f * sp[6 * 33], 32.f * sp[7 * 33]);
    unsigned char* WT = (unsigned char*)(P.ws + WS_WUP) + ((size_t)e * 1024 + (n0 >> 7) * 256 + half * 128 + (n0 & 127) + n) * DM + kb * 16 + 8 * hf;
    *(u32x2*)WT = o;
    LDS_WAIT(); asm volatile("" ::: "memory");
}
#ifndef SSD_STAMP
#define SSD_STAMP 0
#define SSD_STAMP_WAVE 0
#endif
DEVI void phase_ssd(const Ptrs& P, const Frame& F) {
    LAS unsigned char* L = F.lds;
    LAS float* acs = (LAS float*)(L + S_SM); LAS float* dtj = acs + 128; LAS float* wj = acs + 256;
    const int w = F.wave;
    const bf16* xbc = (const bf16*)(P.ws + WS_XC); const float* dtv = (const float*)(P.ws + WS_DTV);
    for (int id = F.vcu; id < 256; id += F.G) {
    const int dir = id & 1, h = (id >> 1) & 15, b = id >> 5, g = h >> 2;
    bf16* yout = (bf16*)(P.ws + (dir ? WS_YB : WS_YF));
    const float Aneg = -__expf(P.a_log[dir * 16 + h]); const float Dsk = dir == 0 ? P.d_skip[h] : 0.f;
    const int jt = (w < 4) ? 2 * w : 15 - 2 * w;
    const bool light = jt < 4; const int li = w < 2 ? w : w - 4;
    f32x4 acc_h[2][4];
#pragma unroll
    for (int nt = 0; nt < 2; ++nt)
#pragma unroll
        for (int pt = 0; pt < 4; ++pt) acc_h[nt][pt] = (f32x4){0.f, 0.f, 0.f, 0.f};
    float dA, dB; unsigned raw[5][8];
#define SSD_GEOM(stp) const bool isx = (stp) >= 2; const int len = isx ? SEQ : CTX; const size_t rbase = isx ? (size_t)b * SEQ : (size_t)TL + (size_t)b * CTX; \
        const int t0 = 128 * (isx ? (dir ? 31 - ((stp) - 2) : (stp) - 2) : (dir ? 1 - (stp) : (stp)));
#define SSD_ISSUE(stp, i_lo, i_hi, with_dt) do { SSD_GEOM(stp) int ln = F.lane; asm volatile("" : "+v"(ln)); \
        if (with_dt) { const int tA = t0 + (dir ? 127 - ln : ln), tB = t0 + (dir ? 63 - ln : 64 + ln); dA = dtv[(rbase + tA) * 32 + dir * 16 + h]; dB = dtv[(rbase + tB) * 32 + dir * 16 + h]; } \
        _Pragma("unroll") for (int i5 = (i_lo); i5 < (i_hi); ++i5) { const int kind = i5 < 2 ? 0 : (i5 < 3 ? 2 : 1); const int tg = kind == 2 ? 2 * w + (ln >> 5) : (w + 8 * (i5 & 1)); \
            const int ch = kind == 0 ? 1024 + g * 128 + 2 * ln : (kind == 1 ? 1536 + g * 128 + 2 * ln : h * 64 + 2 * (ln & 31)); \
            const bf16* src = xbc + (rbase + t0 + 8 * tg) * 2048 + ch; \
            _Pragma("unroll") for (int i = 0; i < 8; ++i) raw[i5][i] = kind == 2 ? __builtin_nontemporal_load((const unsigned*)(src + (size_t)i * 2048)) : *(const unsigned*)(src + (size_t)i * 2048); } } while (0)
    __syncthreads();
    SSD_ISSUE(0, 0, 5, true);
    unsigned long long tacc0 = 0, tacc1 = 0, tacc2 = 0, tsub0 = 0, tsub1 = 0, tsub2 = 0;
    for (int stp = 0; stp < 34; ++stp) {
        const unsigned long long tm0 = (SSD_STAMP) ? __builtin_amdgcn_s_memtime() : 0ull;
        SSD_GEOM(stp)
        int lane = F.lane; asm volatile("" : "+v"(lane));
        const int c = lane & 15, q = lane >> 4, cq4 = (q ^ c) << 4;
        float a_tot;
        { float sA = dA * Aneg, sB = dB * Aneg;
#define SSD_DPP_ADD(v, sh) v += __builtin_bit_cast(float, __builtin_amdgcn_update_dpp(0, __builtin_bit_cast(int, v), 0x110 + (sh), 0xf, 0xf, true))
          SSD_DPP_ADD(sA, 1); SSD_DPP_ADD(sB, 1); SSD_DPP_ADD(sA, 2); SSD_DPP_ADD(sB, 2); SSD_DPP_ADD(sA, 4); SSD_DPP_ADD(sB, 4); SSD_DPP_ADD(sA, 8); SSD_DPP_ADD(sB, 8);
#undef SSD_DPP_ADD
#define RDL(v, l) __builtin_bit_cast(float, __builtin_amdgcn_readlane(__builtin_bit_cast(int, v), l))
          { const float a0 = RDL(sA, 15), a1 = RDL(sA, 31), a2 = RDL(sA, 47), a3 = RDL(sA, 63);
            const float b0 = RDL(sB, 15), b1 = RDL(sB, 31), b2 = RDL(sB, 47), b3 = RDL(sB, 63);
            const int rw = lane >> 4; const float totA = ((a0 + a1) + a2) + a3;
            sA += rw == 0 ? 0.f : (rw == 1 ? a0 : (rw == 2 ? a0 + a1 : (a0 + a1) + a2));
            sB += totA + (rw == 0 ? 0.f : (rw == 1 ? b0 : (rw == 2 ? b0 + b1 : (b0 + b1) + b2)));
            a_tot = totA + (((b0 + b1) + b2) + b3); }
#undef RDL
          acs[lane] = sA; acs[64 + lane] = sB; dtj[lane] = dA; dtj[64 + lane] = dB; wj[lane] = fast_exp(a_tot - sA); wj[64 + lane] = fast_exp(a_tot - sB); }
        LDS_WAIT(); asm volatile("" ::: "memory");
#pragma unroll
        for (int i5 = 0; i5 < 5; ++i5) {
            const int kind = i5 < 2 ? 0 : (i5 < 3 ? 2 : 1);
            const int tg = kind == 2 ? 2 * w + (lane >> 5) : (w + 8 * (i5 & 1));
            if (kind == 1 && !isx) continue;
            float v[8][2];
#pragma unroll
            for (int o = 0; o < 8; ++o) { v[o][0] = __uint_as_float(raw[i5][o] << 16); v[o][1] = __uint_as_float(raw[i5][o] & 0xffff0000u); }
            const int jg = dir ? 15 - tg : tg;
            if (kind < 2) { LAS unsigned char* rm = L + (kind == 0 ? S_BS : S_CS);
#pragma unroll
                for (int o = 0; o < 8; ++o) { const int j = dir ? 127 - (8 * tg + o) : 8 * tg + o; *(LAS unsigned*)(rm + ssd_sw(j, 4 * lane)) = raw[i5][o]; } }
            if (kind != 1) { const f32x4 s0 = *(const LAS f32x4*)((kind == 0 ? wj : dtj) + 8 * jg), s1 = *(const LAS f32x4*)((kind == 0 ? wj : dtj) + 8 * jg + 4);
                const float sc[8] = {s0[0], s0[1], s0[2], s0[3], s1[0], s1[1], s1[2], s1[3]};
                LAS unsigned char* tt = L + (kind == 0 ? S_BT : S_XT); const int r0 = kind == 0 ? 2 * lane : 2 * (lane & 31);
#pragma unroll
                for (int cc = 0; cc < 2; ++cc) { float e[8];
#pragma unroll
                    for (int ee = 0; ee < 8; ++ee) e[ee] = (dir ? v[7 - ee][cc] : v[ee][cc]) * sc[ee];
                    v4u o4; o4.x = pk2(e[0], e[1]); o4.y = pk2(e[2], e[3]); o4.z = pk2(e[4], e[5]); o4.w = pk2(e[6], e[7]);
                    *(LAS v4u*)(tt + ssd_sw(r0 + cc, 16 * jg)) = o4; } }
        }
        const unsigned long long tm1 = (SSD_STAMP) ? __builtin_amdgcn_s_memtime() : 0ull;
        __syncthreads();
        const unsigned long long tm2 = (SSD_STAMP) ? __builtin_amdgcn_s_memtime() : 0ull;
        const float e_tot = fast_exp(a_tot);
        if (stp + 1 < 34) SSD_ISSUE(stp + 1, 0, 2, true);
#define SSD_FRAG(tile_off, rowt, ks) (*(const LAS bf16x8*)(L + (tile_off) + (16 * (rowt) + c) * 256 + ((64 * (ks)) ^ cq4)))
        if (isx) {
            bf16x8 cf[4];
#pragma unroll
            for (int ks = 0; ks < 4; ++ks) cf[ks] = SSD_FRAG(S_CS, jt, ks);
            const int npair = (jt >> 1) + 1;
            bf16x8 bs0[4], bs1[4]; f32x4 as0, as1;
#define SSD_LOADPAIR(t_) do { const int st0_ = 2 * (t_), st1_ = (2 * (t_) + 1 <= jt) ? 2 * (t_) + 1 : 2 * (t_); \
                _Pragma("unroll") for (int ks = 0; ks < 4; ++ks) { bs0[ks] = SSD_FRAG(S_BS, st0_, ks); bs1[ks] = SSD_FRAG(S_BS, st1_, ks); } \
                as0 = *(const LAS f32x4*)(acs + 16 * st0_ + 4 * q); as1 = *(const LAS f32x4*)(acs + 16 * st1_ + 4 * q); } while (0)
            SSD_LOADPAIR(0);
            f32x4 acc_y[4];
            { f32x4 acc_o[4]; bf16x8 hb[4][4];
#pragma unroll
              for (int ks = 0; ks < 4; ++ks)
#pragma unroll
                for (int pt = 0; pt < 4; ++pt) hb[ks][pt] = SSD_FRAG(S_HB, pt, ks);
              const f32x4 aj = *(const LAS f32x4*)(acs + 16 * jt + 4 * q);
#pragma unroll
              for (int pt = 0; pt < 4; ++pt) acc_o[pt] = (f32x4){0.f, 0.f, 0.f, 0.f};
#pragma unroll
              for (int ks = 0; ks < 4; ++ks)
#pragma unroll
                for (int pt = 0; pt < 4; ++pt) acc_o[pt] = __builtin_amdgcn_mfma_f32_16x16x32_bf16(cf[ks], hb[ks][pt], acc_o[pt], 0, 0, 0);
#pragma unroll
              for (int r = 0; r < 4; ++r) { const float ej = fast_exp(aj[r]);
#pragma unroll
                for (int pt = 0; pt < 4; ++pt) acc_y[pt][r] = ej * acc_o[pt][r]; } }
            const unsigned long long tmA = (SSD_STAMP) ? __builtin_amdgcn_s_memtime() : 0ull;
            const float acs_j = acs[16 * jt + c]; const float dsk_j = Dsk * __builtin_amdgcn_rcpf(dtj[16 * jt + c]);
            for (int t = 0; t < npair; ++t) {
                const int st0 = 2 * t, st1 = 2 * t + 1; const bool has1 = st1 <= jt;
                s16x4_t xb[4][2];
#pragma unroll
                for (int pt = 0; pt < 4; ++pt) { const int p = 16 * pt + c; xb[pt][0] = *(const LAS s16x4_t*)(L + S_XT + ssd_sw(p, 64 * t + 8 * q)); xb[pt][1] = *(const LAS s16x4_t*)(L + S_XT + ssd_sw(p, 64 * t + 32 + 8 * q)); }
                f32x4 X0 = (f32x4){0.f, 0.f, 0.f, 0.f}, X1 = (f32x4){0.f, 0.f, 0.f, 0.f};
#pragma unroll
                for (int ks = 0; ks < 4; ++ks) { X0 = __builtin_amdgcn_mfma_f32_16x16x32_bf16(bs0[ks], cf[ks], X0, 0, 0, 0); X1 = __builtin_amdgcn_mfma_f32_16x16x32_bf16(bs1[ks], cf[ks], X1, 0, 0, 0); }
                const f32x4 a0v = as0, a1v = as1;
                { const int tn = t + 1 < npair ? t + 1 : t; SSD_LOADPAIR(tn); }
#pragma unroll
                for (int r = 0; r < 4; ++r) { const int sl = 4 * q + r;
                    const float d0 = fast_exp(fminf(acs_j - a0v[r], 0.f)), d1 = fast_exp(fminf(acs_j - a1v[r], 0.f));
                    float x0 = X0[r] * d0, x1 = X1[r] * d1;
                    if (st0 == jt) { x0 = sl < c ? x0 : (sl == c ? x0 + dsk_j : 0.f); }
                    if (st1 == jt) { x1 = sl < c ? x1 : (sl == c ? x1 + dsk_j : 0.f); }
                    if (!has1) x1 = 0.f;
                    X0[r] = x0; X1[r] = x1; }
                bf16x8 af; { const unsigned a0 = pk2(X0[0], X0[1]), a1 = pk2(X0[2], X0[3]), a2 = pk2(X1[0], X1[1]), a3 = pk2(X1[2], X1[3]);
                    af = (bf16x8){(short)(a0 & 0xffff), (short)(a0 >> 16), (short)(a1 & 0xffff), (short)(a1 >> 16), (short)(a2 & 0xffff), (short)(a2 >> 16), (short)(a3 & 0xffff), (short)(a3 >> 16)}; }
#pragma unroll
                for (int pt = 0; pt < 4; ++pt) { const bf16x8 bfr = (bf16x8){xb[pt][0][0], xb[pt][0][1], xb[pt][0][2], xb[pt][0][3], xb[pt][1][0], xb[pt][1][1], xb[pt][1][2], xb[pt][1][3]};
                    acc_y[pt] = __builtin_amdgcn_mfma_f32_16x16x32_bf16(af, bfr, acc_y[pt], 0, 0, 0); }
            }
#undef SSD_LOADPAIR
            const unsigned long long tmB = (SSD_STAMP) ? __builtin_amdgcn_s_memtime() : 0ull;
            { LAS unsigned char* ys = L + S_YS + w * S_YS_W;
#pragma unroll
              for (int r = 0; r < 4; ++r)
#pragma unroll
                for (int pt = 0; pt < 4; ++pt) *(LAS bf16*)(ys + (4 * q + r) * 144 + (16 * pt + c) * 2) = (bf16)f2bf(acc_y[pt][r]);
              LDS_WAIT(); asm volatile("" ::: "memory");
              const int row = lane >> 2, cbk = (lane & 3) * 32; const v4u o0 = *(const LAS v4u*)(ys + row * 144 + cbk), o1 = *(const LAS v4u*)(ys + row * 144 + cbk + 16);
              const int j = 16 * jt + row; const int tk = t0 + (dir ? 127 - j : j);
              bf16* dst = yout + (rbase + tk) * 1024 + h * 64 + (lane & 3) * 16; *(v4u*)dst = o0; *(v4u*)(dst + 8) = o1; }
            if (SSD_STAMP) { const unsigned long long tmC = __builtin_amdgcn_s_memtime(); tsub0 += tmA - tm2; tsub1 += tmB - tmA; tsub2 += tmC - tmB; }
        }
        if (stp + 1 < 34) SSD_ISSUE(stp + 1, 2, 5, false);
        float wv0[8], wv1[8]; const int witem = ((stp * 256 + id) * 4 + li) * 2;
        if (light && witem < 65536) { ssd_weight_load(P, witem, lane, wv0); ssd_weight_load(P, witem + 1, lane, wv1); }
        if (light) {
#pragma unroll
            for (int nt = 0; nt < 2; ++nt)
#pragma unroll
                for (int pt = 0; pt < 4; ++pt) acc_h[nt][pt] = acc_h[nt][pt] * e_tot;
            bf16x8 xt[4][4];
#pragma unroll
            for (int ks = 0; ks < 4; ++ks)
#pragma unroll
                for (int pt = 0; pt < 4; ++pt) xt[ks][pt] = SSD_FRAG(S_XT, pt, ks);
#pragma unroll
            for (int nt = 0; nt < 2; ++nt) { bf16x8 bt[4];
#pragma unroll
                for (int ks = 0; ks < 4; ++ks) bt[ks] = SSD_FRAG(S_BT, 2 * li + nt, ks);
#pragma unroll
                for (int ks = 0; ks < 4; ++ks)
#pragma unroll
                    for (int pt = 0; pt < 4; ++pt) acc_h[nt][pt] = __builtin_amdgcn_mfma_f32_16x16x32_bf16(bt[ks], xt[ks][pt], acc_h[nt][pt], 0, 0, 0); }
            if (witem < 65536) { LAS float* scr = (LAS float*)(L + S_YS + w * S_YS_W); ssd_weight_store(P, witem, lane, wv0, scr); ssd_weight_store(P, witem + 1, lane, wv1, scr); } }
        const unsigned long long tm3 = (SSD_STAMP) ? __builtin_amdgcn_s_memtime() : 0ull;
        __syncthreads();
        if (SSD_STAMP) { const unsigned long long tm4 = __builtin_amdgcn_s_memtime(); tacc0 += tm1 - tm0; tacc1 += (tm2 - tm1) + (tm4 - tm3); tacc2 += tm3 - tm2; }
        if (light) {
#pragma unroll
            for (int nt = 0; nt < 2; ++nt)
#pragma unroll
                for (int pt = 0; pt < 4; ++pt) { u32x2 hv; hv.x = pk2(acc_h[nt][pt][0], acc_h[nt][pt][1]); hv.y = pk2(acc_h[nt][pt][2], acc_h[nt][pt][3]); *(LAS u32x2*)(L + S_HB + ssd_sw(16 * pt + c, 32 * (2 * li + nt) + 8 * q)) = hv; } }
    }
    __syncthreads();
    if ((SSD_STAMP) && blockIdx.x == 0 && F.tid == (SSD_STAMP_WAVE) * 64) { const float tot = (float)(tacc0 + tacc1 + tacc2); const float sel = (SSD_STAMP) == 1 ? (float)tacc0 : ((SSD_STAMP) == 2 ? (float)tacc1 : ((SSD_STAMP) == 3 ? (float)tacc2 : ((SSD_STAMP) == 4 ? (float)tsub0 : ((SSD_STAMP) == 5 ? (float)tsub1 : (float)tsub2))));
        __hip_atomic_store((float*)(P.ws + WS_CTL) + 64, floorf(sel / tot * 25.f + 0.5f) * 0.04f, RLX_AGENT); }
    }
#undef SSD_GEOM
#undef SSD_ISSUE
#undef SSD_FRAG
}
constexpr size_t WS_T1 = 1 * MiB + 512 * 1024;
constexpr int FT_ROWB = 288, FT_TILE = 128 * FT_ROWB;
DEVI int four_rho(int k) { const int kk = k >> 5, gq = (k >> 3) & 3, jj = k & 7; return 32 * kk + 16 * (jj >> 2) + 4 * gq + (jj & 3); }
DEVI void phase_four_tables(const Ptrs& P, const Frame& F) {
    const int gt = F.vcu * 512 + F.tid, NT = F.G * 512;
    bf16* T1 = (bf16*)(P.ws + WS_T1); bf16* T3 = T1 + 128 * 128;
    for (int o = gt; o < 128 * 128 + 64 * 128; o += NT) {
        if (o < 128 * 128) { const int i = o >> 7, k = o & 127, ks = k >> 5, kq = (k >> 3) & 3, kj = k & 7, ro = i >> 6, k1 = i & 63, ri = ks >> 1, l1 = 16 * (2 * (ks & 1) + (kj >> 2)) + 4 * kq + (kj & 3);
            const float ang = (float)((k1 * l1) & 63) * (2.0f / 64.0f), c = cospif(ang), s = sinpif(ang);
            const float v = ro == 0 ? (ri == 0 ? c : s) : (ri == 0 ? -s : c); T1[o] = (bf16)f2bf(v * 0.125f); }
        else { const int o2 = o - 128 * 128, k2 = o2 >> 7, k = o2 & 127, rho = four_rho(k), ri = rho >> 6, l2 = rho & 63;
            const float ang = (float)((k2 * l2) & 63) * (2.0f / 64.0f); T3[o2] = (bf16)f2bf((ri == 0 ? cospif(ang) : sinpif(ang)) * (0.125f / 16.f)); }
    }
}
DEVI void four_load_T(const bf16* T, int rows, LAS unsigned char* dst, int tid) {
    for (int cid = tid; cid < rows * 16; cid += 512) { const int r = cid >> 4, ch = cid & 15; *(LAS v4u*)(dst + r * 256 + ((ch ^ (r & 15)) << 4)) = *(const v4u*)(T + r * 128 + ch * 8); }
}
DEVI bf16x8 four_Afrag(const LAS unsigned char* T, int it, int ks, int lane) { const int r = 16 * it + (lane & 15), ch = 4 * ks + (lane >> 4); return *(const LAS bf16x8*)(T + r * 256 + ((ch ^ (r & 15)) << 4)); }
DEVI bf16x8 four_Bfrag(const LAS unsigned char* tile, int dt, int ks, int lane) {
    const int gq = lane >> 4, qq = (lane & 15) >> 2, pp = lane & 3;
    const LAS unsigned char* p = tile + (32 * ks + 4 * gq + qq) * FT_ROWB + (16 * dt + 4 * pp) * 2;
    const s16x4 a = __builtin_amdgcn_ds_read_tr16_b64_v4i16((LAS s16x4*)p), b = __builtin_amdgcn_ds_read_tr16_b64_v4i16((LAS s16x4*)(p + 16 * FT_ROWB));
    return (bf16x8){a[0], a[1], a[2], a[3], b[0], b[1], b[2], b[3]};
}
DEVI void phase_four1(const Ptrs& P, const Frame& F) {
    LAS unsigned char* T = F.lds; LAS unsigned char* WcL = F.lds + 32768; LAS unsigned char* buf0 = F.lds + 98304;
    const int g = F.vcu & 3;
    __syncthreads();
    four_load_T((const bf16*)(P.ws + WS_T1), 128, T, F.tid);
    four_load_T((const bf16*)(P.ws + WS_WC) + (size_t)g * 256 * 128, 256, WcL, F.tid);
    const bf16* Fz = (const bf16*)(P.ws + WS_YZ); bf16* AP = (bf16*)(P.ws + WS_AP);
    const int w = F.wave, lane = F.lane, c = lane & 15, q = lane >> 4;
    v4u stA[2], stB[2];
#define F1_ISSUE(ST, u_) do { const int l2_ = ((u_) >> 2) & 63, b_ = (u_) >> 8; \
        _Pragma("unroll") for (int i = 0; i < 2; ++i) { const int cid = F.tid + 512 * i, l1 = cid >> 4, ch = cid & 15; ST[i] = __builtin_nontemporal_load((const v4u*)(Fz + ((size_t)b_ * SEQ + 64 * l1 + l2_) * 512 + g * 128 + ch * 8)); } } while (0)
#define F1_COMMIT(ST, buf_) do { _Pragma("unroll") for (int i = 0; i < 2; ++i) { const int cid = F.tid + 512 * i, l1 = cid >> 4, ch = cid & 15; *(LAS v4u*)((buf_) + l1 * 256 + ((ch ^ (l1 & 15)) << 4)) = ST[i]; } } while (0)
    auto compute = [&](int u, const LAS unsigned char* tile) { const int l2 = (u >> 2) & 63, b = u >> 8;
        f32x4 z[2][4];
#pragma unroll
        for (int ri = 0; ri < 2; ++ri)
#pragma unroll
            for (int it = 0; it < 4; ++it) z[ri][it] = (f32x4){0.f, 0.f, 0.f, 0.f};
#pragma unroll
        for (int ks = 0; ks < 4; ++ks) { const bf16x8 w0 = four_Afrag(WcL, w, ks, lane), w1 = four_Afrag(WcL, 8 + w, ks, lane);
#pragma unroll
            for (int it = 0; it < 4; ++it) { const bf16x8 ff = four_Afrag(tile, it, ks, lane);
                z[0][it] = __builtin_amdgcn_mfma_f32_16x16x32_bf16(ff, w0, z[0][it], 0, 0, 0); z[1][it] = __builtin_amdgcn_mfma_f32_16x16x32_bf16(ff, w1, z[1][it], 0, 0, 0); } }
        bf16x8 zb[4];
#pragma unroll
        for (int s4 = 0; s4 < 4; ++s4) { const f32x4 za = z[s4 >> 1][2 * (s4 & 1)], zc = z[s4 >> 1][2 * (s4 & 1) + 1];
            const unsigned a0 = pk2(za[0], za[1]), a1 = pk2(za[2], za[3]), a2 = pk2(zc[0], zc[1]), a3 = pk2(zc[2], zc[3]);
            zb[s4] = (bf16x8){(short)(a0 & 0xffff), (short)(a0 >> 16), (short)(a1 & 0xffff), (short)(a1 >> 16), (short)(a2 & 0xffff), (short)(a2 >> 16), (short)(a3 & 0xffff), (short)(a3 >> 16)}; }
        f32x4 acc[8];
#pragma unroll
        for (int it = 0; it < 8; ++it) acc[it] = (f32x4){0.f, 0.f, 0.f, 0.f};
#pragma unroll
        for (int ks = 0; ks < 4; ++ks)
#pragma unroll
            for (int it = 0; it < 8; ++it) acc[it] = __builtin_amdgcn_mfma_f32_16x16x32_bf16(four_Afrag(T, it, ks, lane), zb[ks], acc[it], 0, 0, 0);
#pragma unroll
        for (int it = 0; it < 4; ++it)
#pragma unroll
            for (int r = 0; r < 4; ++r) { const int k1 = 16 * it + 4 * q + r; const float ang = (float)((l2 * k1) & 4095) * (1.0f / 4096.0f);
                const float ct = __builtin_amdgcn_cosf(ang), sn = __builtin_amdgcn_sinf(ang); const float ar = acc[it][r], ai = acc[it + 4][r];
                unsigned char* dst = (unsigned char*)AP + (((((size_t)b * 4 + g) * 64 + k1) * 2) * 64 + l2) * 128 + 16 * w + c;
                const int pr = __builtin_amdgcn_cvt_pk_fp8_f32(16.f * (ar * ct + ai * sn), 16.f * (ai * ct - ar * sn), 0, false);
                dst[0] = (unsigned char)(pr & 0xff); dst[64 * 128] = (unsigned char)((pr >> 8) & 0xff); }
    };
    int u = F.vcu;
    if (u < 2048) { F1_ISSUE(stA, u); F1_COMMIT(stA, buf0); }
    if (u + F.G < 2048) F1_ISSUE(stB, u + F.G);
    __syncthreads();
    for (; u < 2048; u += 2 * F.G) {
        const int u1 = u + F.G, u2 = u + 2 * F.G, u3 = u + 3 * F.G;
        if (u2 < 2048) F1_ISSUE(stA, u2);
        compute(u, buf0);
        if (u1 < 2048) F1_COMMIT(stB, buf0 + 16384);
        __syncthreads();
        if (u1 >= 2048) break;
        if (u3 < 2048) F1_ISSUE(stB, u3);
        compute(u1, buf0 + 16384);
        if (u2 < 2048) F1_COMMIT(stA, buf0);
        __syncthreads();
    }
#undef F1_ISSUE
#undef F1_COMMIT
}
DEVI void phase_four3(const Ptrs& P, const Frame& F) {
    LAS unsigned char* T = F.lds; LAS unsigned char* buf0 = F.lds + 32768;
    __syncthreads();
    four_load_T((const bf16*)(P.ws + WS_T1) + 128 * 128, 64, T, F.tid);
    const bf16* AP = (const bf16*)(P.ws + WS_AP); bf16* mix = (bf16*)(P.ws + WS_MIX);
    const int w = F.wave, lane = F.lane, c = lane & 15, q = lane >> 4;
    v4u stA[2], stB[2];
#define F3_ISSUE(ST, u_) do { const int g_ = (u_) & 3, k1_ = ((u_) >> 2) & 63, b_ = (u_) >> 8; const unsigned char* src_ = (const unsigned char*)AP + ((((size_t)b_ * 4 + g_) * 64 + k1_) * 128) * 128; \
        _Pragma("unroll") for (int i = 0; i < 2; ++i) ST[i] = __builtin_nontemporal_load((const v4u*)(src_ + (size_t)(F.tid + 512 * i) * 16)); } while (0)
#define F3_COMMIT(ST, buf_) do { _Pragma("unroll") for (int i = 0; i < 2; ++i) { const int cid = F.tid + 512 * i, rho = cid >> 3, ch = 2 * (cid & 7); v4u lo_, hi_; \
        { const auto a0 = __builtin_amdgcn_cvt_pk_f32_fp8((int)ST[i].x, false), a1 = __builtin_amdgcn_cvt_pk_f32_fp8((int)ST[i].x, true), a2 = __builtin_amdgcn_cvt_pk_f32_fp8((int)ST[i].y, false), a3 = __builtin_amdgcn_cvt_pk_f32_fp8((int)ST[i].y, true); \
          lo_.x = pk2(a0[0], a0[1]); lo_.y = pk2(a1[0], a1[1]); lo_.z = pk2(a2[0], a2[1]); lo_.w = pk2(a3[0], a3[1]); } \
        { const auto a0 = __builtin_amdgcn_cvt_pk_f32_fp8((int)ST[i].z, false), a1 = __builtin_amdgcn_cvt_pk_f32_fp8((int)ST[i].z, true), a2 = __builtin_amdgcn_cvt_pk_f32_fp8((int)ST[i].w, false), a3 = __builtin_amdgcn_cvt_pk_f32_fp8((int)ST[i].w, true); \
          hi_.x = pk2(a0[0], a0[1]); hi_.y = pk2(a1[0], a1[1]); hi_.z = pk2(a2[0], a2[1]); hi_.w = pk2(a3[0], a3[1]); } \
        *(LAS v4u*)((buf_) + rho * FT_ROWB + ch * 16) = lo_; *(LAS v4u*)((buf_) + rho * FT_ROWB + ch * 16 + 16) = hi_; } } while (0)
#define F3_COMPUTE(u_, tile_) do { const int g = (u_) & 3, k1 = ((u_) >> 2) & 63, b = (u_) >> 8; f32x4 acc[4]; \
        _Pragma("unroll") for (int it = 0; it < 4; ++it) acc[it] = (f32x4){0.f, 0.f, 0.f, 0.f}; \
        _Pragma("unroll") for (int ks = 0; ks < 4; ++ks) { const bf16x8 bf = four_Bfrag((tile_), w, ks, lane); \
            _Pragma("unroll") for (int it = 0; it < 4; ++it) acc[it] = __builtin_amdgcn_mfma_f32_16x16x32_bf16(four_Afrag(T, it, ks, lane), bf, acc[it], 0, 0, 0); } \
        _Pragma("unroll") for (int it = 0; it < 4; ++it) _Pragma("unroll") for (int r = 0; r < 4; ++r) { const int k2 = 16 * it + 4 * q + r; mix[((size_t)b * SEQ + k1 + 64 * k2) * MIXLD + 512 + g * 128 + 16 * w + c] = (bf16)f2bf(acc[it][r]); } } while (0)
    int u = F.vcu;
    if (u < 2048) { F3_ISSUE(stA, u); F3_COMMIT(stA, buf0); }
    if (u + F.G < 2048) F3_ISSUE(stB, u + F.G);
    __syncthreads();
    for (; u < 2048; u += 2 * F.G) {
        const int u1 = u + F.G, u2 = u + 2 * F.G, u3 = u + 3 * F.G;
        if (u2 < 2048) F3_ISSUE(stA, u2);
        F3_COMPUTE(u, buf0);
        if (u1 < 2048) F3_COMMIT(stB, buf0 + FT_TILE);
        __syncthreads();
        if (u1 >= 2048) break;
        if (u3 < 2048) F3_ISSUE(stB, u3);
        F3_COMPUTE(u1, buf0 + FT_TILE);
        if (u2 < 2048) F3_COMMIT(stA, buf0);
        __syncthreads();
    }
#undef F3_ISSUE
#undef F3_COMMIT
#undef F3_COMPUTE
}
#ifndef MK_N_LAUNCHES
#define MK_N_LAUNCHES 1
#endif
constexpr int NPHASE = 11;
#ifndef DUPMASK
#define DUPMASK 0
#endif
#ifndef PG8_STAMP_PHASE
#define PG8_STAMP_PHASE 2
#endif
#ifndef STAMPK
#define STAMPK -1
#endif
#define DUP(k) for (int _d = 0; _d < (((DUPMASK) >> (k)) & 1) + 1; ++_d)
DEVI unsigned long long rfl64(unsigned long long v) { const unsigned lo = __builtin_amdgcn_readfirstlane((unsigned)v), hi = __builtin_amdgcn_readfirstlane((unsigned)(v >> 32)); return ((unsigned long long)hi << 32) | lo; }
DEVI void store_ptrs(const Ptrs& A, LAS unsigned long long* lp) { lp[0] = (unsigned long long)A.x; lp[1] = (unsigned long long)A.c; lp[2] = (unsigned long long)A.ctx; lp[3] = (unsigned long long)A.c_ctx; lp[4] = (unsigned long long)A.w_mod; lp[5] = (unsigned long long)A.b_mod; lp[6] = (unsigned long long)A.norm1; lp[7] = (unsigned long long)A.w_in; lp[8] = (unsigned long long)A.conv_w; lp[9] = (unsigned long long)A.conv_b; lp[10] = (unsigned long long)A.dt_bias; lp[11] = (unsigned long long)A.a_log; lp[12] = (unsigned long long)A.d_skip; lp[13] = (unsigned long long)A.ssd_norm; lp[14] = (unsigned long long)A.w_four; lp[15] = (unsigned long long)A.w_out; lp[16] = (unsigned long long)A.norm2; lp[17] = (unsigned long long)A.w_rg; lp[18] = (unsigned long long)A.b_rg; lp[19] = (unsigned long long)A.w_re; lp[20] = (unsigned long long)A.b_re; lp[21] = (unsigned long long)A.w_eg; lp[22] = (unsigned long long)A.w_eu; lp[23] = (unsigned long long)A.w_ed; lp[24] = (unsigned long long)A.final_norm; lp[25] = (unsigned long long)A.out; lp[26] = (unsigned long long)A.ws; }
DEVI void load_ptrs(Ptrs& P, const LAS unsigned long long* lp) { P.x = (const float*)(const GAS float*)rfl64(lp[0]); P.c = (const float*)(const GAS float*)rfl64(lp[1]); P.ctx = (const float*)(const GAS float*)rfl64(lp[2]); P.c_ctx = (const float*)(const GAS float*)rfl64(lp[3]); P.w_mod = (const float*)(const GAS float*)rfl64(lp[4]); P.b_mod = (const float*)(const GAS float*)rfl64(lp[5]); P.norm1 = (const float*)(const GAS float*)rfl64(lp[6]); P.w_in = (const float*)(const GAS float*)rfl64(lp[7]); P.conv_w = (const float*)(const GAS float*)rfl64(lp[8]); P.conv_b = (const float*)(const GAS float*)rfl64(lp[9]); P.dt_bias = (const float*)(const GAS float*)rfl64(lp[10]); P.a_log = (const float*)(const GAS float*)rfl64(lp[11]); P.d_skip = (const float*)(const GAS float*)rfl64(lp[12]); P.ssd_norm = (const float*)(const GAS float*)rfl64(lp[13]); P.w_four = (const float*)(const GAS float*)rfl64(lp[14]); P.w_out = (const float*)(const GAS float*)rfl64(lp[15]); P.norm2 = (const float*)(const GAS float*)rfl64(lp[16]); P.w_rg = (const float*)(const GAS float*)rfl64(lp[17]); P.b_rg = (const float*)(const GAS float*)rfl64(lp[18]); P.w_re = (const float*)(const GAS float*)rfl64(lp[19]); P.b_re = (const float*)(const GAS float*)rfl64(lp[20]); P.w_eg = (const float*)(const GAS float*)rfl64(lp[21]); P.w_eu = (const float*)(const GAS float*)rfl64(lp[22]); P.w_ed = (const float*)(const GAS float*)rfl64(lp[23]); P.final_norm = (const float*)(const GAS float*)rfl64(lp[24]); P.out = (float*)(GAS float*)rfl64(lp[25]); P.ws = (unsigned char*)(GAS unsigned char*)rfl64(lp[26]); }
struct Args { Ptrs P; int ph_lo, ph_hi; };
__global__ void __launch_bounds__(NWAVES * 64, 2) fwd_megakernel(Args args) {
    extern __shared__ __attribute__((aligned(16))) unsigned char lds_raw[];
    Frame F; F.lds = (LAS unsigned char*)lds_raw;
    F.tid = threadIdx.x; F.lane = F.tid & 63; F.wave = __builtin_amdgcn_readfirstlane(F.tid >> 6);
    F.G = gridDim.x; { const int bx = blockIdx.x; F.vcu = (F.G % 8 == 0) ? (bx % 8) * (F.G / 8) + bx / 8 : bx; }
    for (int u = F.tid; u < (LDS_BYTES - LDSCTL_OFF) / 4; u += NWAVES * 64) ((LAS unsigned*)(F.lds + LDSCTL_OFF))[u] = 0u;
    __syncthreads();
    LAS unsigned long long* lp = (LAS unsigned long long*)(F.lds + LDSCTL_OFF + LC_PTR);
    if (F.tid == 0) store_ptrs(args.P, lp);
    unsigned char* const ws0 = args.P.ws;
    __syncthreads();
#define LOADP Ptrs P; load_ptrs(P, lp); asm volatile("" : "+v"(F.tid) :: "memory"); F.lane = F.tid & 63
    XcdBarrier bar; bar.bar = (unsigned*)(ws0 + WS_CTL) + CW_BAR; bar.x = 0; bar.st = nullptr;
    const bool one = (args.ph_hi - args.ph_lo) > 1;
    if (one) bar = xcd_barrier_post((unsigned*)(ws0 + WS_CTL) + CW_BAR, (volatile LAS unsigned*)(F.lds + LDSCTL_OFF + LC_MISC) + 8);
    const int lo = args.ph_lo, hi = args.ph_hi;
    if (STAMPK >= 0 && blockIdx.x == 0 && F.tid == 0) ((LAS unsigned long long*)(F.lds + LDSCTL_OFF + LC_TS))[0] = __builtin_amdgcn_s_memrealtime();
#define IN(k) (lo <= (k) && (k) < hi)
#define SEAM(k) do { if (IN(k) && IN((k) + 1)) { if (STAMPK >= 0 && (k) == 10 && blockIdx.x == 0 && F.tid == 0) { const unsigned long long tn = __builtin_amdgcn_s_memrealtime(); LAS unsigned long long* tsl = (LAS unsigned long long*)(F.lds + LDSCTL_OFF + LC_TS); \
            const float tot = (float)(tn - tsl[0]); const float tk = STAMPK == 10 ? (float)(tn - tsl[10]) : (float)(tsl[STAMPK + 1] - tsl[STAMPK]); __hip_atomic_store((float*)(ws0 + WS_CTL) + 64, floorf(tk / tot * 50.f + 0.5f) * 0.02f, RLX_AGENT); }     \
        xcd_barrier(bar); if ((DUPMASK >> 14) & 1) xcd_barrier(bar); \
        if (STAMPK >= 0 && blockIdx.x == 0 && F.tid == 0) ((LAS unsigned long long*)(F.lds + LDSCTL_OFF + LC_TS))[(k) + 1] = __builtin_amdgcn_s_memrealtime(); } } while (0)
    if (IN(0)) { LOADP; DUP(0) { phase0a(P, F); phase_four_tables(P, F); } } SEAM(0);
    if (IN(1)) { LOADP; DUP(1) phase0b(P, F); } SEAM(1);
    if (IN(2)) { LOADP;
        pg8::Gemm g{(const bf16*)(P.ws + WS_XN), (const bf16*)(P.ws + WS_WIN), TA, NIN, DM / 2}; if ((PG8_STAMP) && (PG8_STAMP_PHASE) == 2) g.stamp = (float*)(ws0 + WS_CTL) + 64; pg8::InProjOrder S{F.G, (int)blockIdx.x};
        LAS float* stab = (LAS float*)(F.lds + pg8::STAGE_BYTES);
        { pg8::Unit su; __syncthreads(); for (int i = 0; i < 8 && S.next(i, su); ++i) stab[i * 512 + F.tid] = F.tid < 256 ? ((const float*)(P.ws + WS_SAI))[su.pm * 256 + F.tid] : ((const float*)(P.ws + WS_SBI))[su.pn * 256 + F.tid - 256]; __syncthreads(); }
        pg8::EpiInProjI8 E{(bf16*)(P.ws + WS_ZS), (bf16*)(P.ws + WS_XBC), (bf16*)(P.ws + WS_YZ), (float*)(P.ws + WS_DTV), P.dt_bias, (const float*)(P.ws + WS_SAI), (const float*)(P.ws + WS_SBI), (const LAS float*)stab, 0};
        if ((DUPMASK >> 2) & 1) { pg8::gemm_phase<pg8::EpiInProjI8, pg8::InProjOrder, true, true, false, false, true>(F.lds, g, S, E); __syncthreads(); asm volatile("" : "+v"(F.tid) :: "memory"); }
        pg8::gemm_phase<pg8::EpiInProjI8, pg8::InProjOrder, true, true, false, false, true>(F.lds, g, S, E);
    } SEAM(2);
    if (IN(3)) { LOADP; DUP(11) phase_conv(P, F); asm volatile("" : "+v"(F.tid) :: "memory"); F.lane = F.tid & 63; DUP(4) phase_four1(P, F); } SEAM(3);
    if (IN(4)) { LOADP; DUP(3) phase_ssd(P, F); } SEAM(4);
    if (IN(5)) { LOADP; DUP(4) phase_four3(P, F); if ((DUPMASK >> 5) & 1) { phase_combine<((DUPMASK >> 15) & 1) != 0>(P, F); asm volatile("" : "+v"(F.tid) :: "memory"); F.lane = F.tid & 63; } phase_combine(P, F); } SEAM(5);
    if (IN(6)) { LOADP;
        int ko = MIXLD, k8 = 8; asm volatile("" : "+s"(ko), "+s"(k8));
        pg8::Gemm g{(const bf16*)(P.ws + WS_MIX), (const bf16*)(P.ws + WS_WOUT), TL, DM, ko, nullptr, 0x7f7f7f7f, 0x7f7f7f7f, k8, (const float*)(P.ws + WS_SAO)}; pg8::StaticOrder S; S.init(TL, DM, F.G, (int)blockIdx.x);
        LAS float* gtab = (LAS float*)(F.lds + pg8::STAGE_BYTES + 8192);
        { pg8::Unit su; __syncthreads(); for (int i = 0; i < 8 && S.next(i, su); ++i) if (F.tid < 256) gtab[i * 256 + F.tid] = ((const float*)(P.ws + WS_MOD))[(size_t)(su.pm >> 4) * 6144 + 2048 + su.pn * 256 + F.tid] * ((const float*)(P.ws + WS_SBO))[su.pn * 256 + F.tid]; __syncthreads(); }
        pg8::EpiOutProj E{P.x, (bf16*)(P.ws + WS_X1), (const float*)(P.ws + WS_MOD), (const float*)(P.ws + WS_SBO), (const LAS float*)gtab, 0};
        if ((DUPMASK >> 6) & 1) { pg8::gemm_phase<pg8::EpiOutProj, pg8::StaticOrder, true, true, false, false, false, true>(F.lds, g, S, E); __syncthreads(); asm volatile("" : "+v"(F.tid) :: "memory"); }
        pg8::gemm_phase<pg8::EpiOutProj, pg8::StaticOrder, true, true, false, false, false, true>(F.lds, g, S, E);
    } SEAM(6);
    if (IN(7)) { LOADP; if ((DUPMASK >> 12) & 1) phase_route(P, F, true); phase_route(P, F, false); } SEAM(7);
    if (IN(9)) { LOADP;
        const int nt = build_tile_table(P, F);
        pg8::MoeOrder S{(const LAS int*)(F.lds + LDSCTL_OFF + LC_TILE), nt, F.G, (int)blockIdx.x};
        { pg8::Unit su; for (int i = 0; S.next(i, su); ++i) tile_rows(P, F, su.pm); asm volatile("s_waitcnt vmcnt(0)" ::: "memory"); __syncthreads(); }
        pg8::Gemm g{(const bf16*)(P.ws + WS_HPERM), (const bf16*)(P.ws + WS_WUP), RPAD, NE * 1024, DM / 2, (const int*)(P.ws + WS_ROUTE + 3 * 262144), 0x7f7f7f7f, 0x7a7a7a7a};
        pg8::EpiUp E{(unsigned char*)(P.ws + WS_ACT)};
        if ((DUPMASK >> 9) & 1) { pg8::gemm_phase<pg8::EpiUp, pg8::MoeOrder, true, true, true, true>(F.lds, g, S, E); __syncthreads(); asm volatile("" : "+v"(F.tid) :: "memory"); }
        pg8::gemm_phase<pg8::EpiUp, pg8::MoeOrder, true, true, true, true>(F.lds, g, S, E);
        {
          constexpr int I_DN = 32 * 256, PER_WG = 64;
          const int nwg = nt * 4, R = (nwg + F.G - 1) / F.G, first_idle = nwg - (R - 1) * F.G, n_idle = R * F.G - nwg, c = (int)blockIdx.x;
          const int n_tail = n_idle * PER_WG < I_DN ? n_idle * PER_WG : I_DN;
          __syncthreads();
          if (n_idle > 0 && c >= first_idle) phase_expert_weights(P, F, 0, n_tail, (c - first_idle) * NWAVES + F.wave, n_idle * NWAVES);
          if (n_tail < I_DN) phase_expert_weights(P, F, n_tail, I_DN, F.vcu * NWAVES + F.wave, F.G * NWAVES); }
    } SEAM(9);
    if (IN(10)) { LOADP;
        const int nt = build_tile_table(P, F);
        pg8::MoeOrder S{(const LAS int*)(F.lds + LDSCTL_OFF + LC_TILE), nt, F.G, (int)blockIdx.x};
        int kd = DE / 2; asm volatile("" : "+s"(kd));
        pg8::Gemm g{(const bf16*)(P.ws + WS_ACT), (const bf16*)(P.ws + WS_WDN), RPAD, NE * 1024, kd, nullptr, 0x7d7d7d7d, 0x7a7a7a7a};
        LAS int* dtab = (LAS int*)(F.lds + pg8::STAGE_BYTES);
        { pg8::Unit su; __syncthreads(); for (int i = 0; i < 8 && S.next(i, su); ++i) dtab[i * 512 + F.tid] = ((const int*)(P.ws + WS_ROUTE + 3 * 262144))[(F.tid < 256 ? 0 : RPAD - 256) + su.pm * 256 + F.tid]; __syncthreads(); }
        pg8::EpiDown E{(bf16*)(P.ws + WS_YBUF), (const int*)(P.ws + WS_ROUTE + 3 * 262144), (const float*)(P.ws + WS_ROUTE + 3 * 262144 + 4 * RPAD), (const LAS int*)dtab, 0};
        DUP(10) pg8::gemm_phase<pg8::EpiDown, pg8::MoeOrder, true, true, false, true>(F.lds, g, S, E);
    } SEAM(10);
    if (IN(11)) { LOADP; if ((DUPMASK >> 13) & 1) phase_final(P, F, (float*)(P.ws + WS_XC), 1.f); phase_final(P, F, P.out, (STAMPK >= 0 || (SSD_STAMP) || (PG8_STAMP)) ? 1.f + __hip_atomic_load((float*)(ws0 + WS_CTL) + 64, RLX_AGENT) : 1.f); }
#undef IN
#undef SEAM
}

extern "C" void kernel_launch(void* const* d_in, const int* in_sizes, int n_in, void* d_out, int out_size, void* d_ws, size_t ws_size, hipStream_t stream) {
    static int grid = 0;
    if (grid == 0) {
        if (n_in != 25 || in_sizes[0] != TL * DM || out_size != TL * DM || ws_size < WS_END) { fprintf(stderr, "kernel_launch: unexpected shapes (n_in %d, ws %zu)\n", n_in, ws_size); grid = -1; return; }
        int dev = 0, cus = 0, per_cu = 0;
        if (hipGetDevice(&dev) != hipSuccess || hipDeviceGetAttribute(&cus, hipDeviceAttributeMultiprocessorCount, dev) != hipSuccess) { grid = -1; return; }
        if (hipFuncSetAttribute((const void*)fwd_megakernel, hipFuncAttributeMaxDynamicSharedMemorySize, LDS_BYTES) != hipSuccess) { fprintf(stderr, "kernel_launch: hipFuncSetAttribute failed\n"); grid = -1; return; }
        if (hipOccupancyMaxActiveBlocksPerMultiprocessor(&per_cu, (const void*)fwd_megakernel, NWAVES * 64, LDS_BYTES) != hipSuccess || per_cu < 1) fprintf(stderr, "kernel_launch: occupancy query reports %d\n", per_cu);
        (void)hipGetLastError();
        grid = cus;
        if (grid != 256) fprintf(stderr, "kernel_launch: built for 256 CUs, got %d\n", grid);
    }
    if (grid < 0) return;
    (void)hipMemsetAsync((char*)d_ws + WS_CTL, 0, CTL_ZERO_BYTES, stream);
    Args a{};
    const float** pp = (const float**)&a.P;
    for (int i = 0; i < 25; ++i) pp[i] = (const float*)d_in[i];
    a.P.out = (float*)d_out; a.P.ws = (unsigned char*)d_ws;
#if MK_N_LAUNCHES == 1
    a.ph_lo = 0; a.ph_hi = NPHASE + 1;
    hipLaunchKernelGGL(fwd_megakernel, dim3(grid), dim3(NWAVES * 64), LDS_BYTES, stream, a);
#else
    for (int ph = 0; ph <= NPHASE; ++ph) { a.ph_lo = ph; a.ph_hi = ph + 1; hipLaunchKernelGGL(fwd_megakernel, dim3(grid), dim3(NWAVES * 64), LDS_BYTES, stream, a); }
#endif
}
```
